# Optimizing an MI355X kernel written in HIP

```python
import math
import jax
import jax.numpy as jnp
from jax import lax
import numpy as np

D_MODEL = 1024
BATCH = 8
SEQ = 4096
DEPTH = 4

GRID_W = 64
CTX_LEN = 256

POOL_WIDTH = 512
POOL_GROUPS = 4
POOL_GROUP_DIM = POOL_WIDTH // POOL_GROUPS
POOL_WINDOWS = (2, 4, 8, 16)

SSM_WIDTH = 512
SSM_GROUP_DIM = 16
SSM_GROUPS = SSM_WIDTH // SSM_GROUP_DIM
SSM_STATE = 64
N_DIRECTIONS = 2

N_BRANCHES = 2
IN_WIDTH = POOL_WIDTH + SSM_WIDTH + N_BRANCHES * D_MODEL
N_MOD = 6

N_EXPERTS = 16
N_EXPERT_GROUPS = 4
EXPERTS_PER_GROUP = N_EXPERTS // N_EXPERT_GROUPS
GROUP_SCORE_K = 2
TOP_K = 2
D_EXPERT = 512

RMS_EPS = 1e-6
DT_MIN = 1e-3
DT_MAX = 1e-1

kernel_name = "hybrid_pool_s5_moe_prefix_dit"


def _rms_norm(x, g):
    xf = x.astype(jnp.float32)
    y = xf * lax.rsqrt(jnp.mean(xf * xf, axis=-1, keepdims=True) + RMS_EPS)
    return (y * g.astype(jnp.float32)).astype(x.dtype)


def _modulate(h, shift, scale):
    return h * (1.0 + scale) + shift


def _adaln_params(s, w, b):
    m = s @ w + b
    return jnp.split(m[:, None, :], N_MOD, axis=-1)


def _split_in(z):
    u_pool = z[..., :POOL_WIDTH]
    u_ssm = z[..., POOL_WIDTH:POOL_WIDTH + SSM_WIDTH]
    g_pool = z[..., POOL_WIDTH + SSM_WIDTH:POOL_WIDTH + SSM_WIDTH + D_MODEL]
    g_ssm = z[..., POOL_WIDTH + SSM_WIDTH + D_MODEL:]
    return u_pool, u_ssm, g_pool, g_ssm


def _box_mean(v, w, axis):
    n = v.shape[axis]
    vf = v.astype(jnp.float32)
    cs = jnp.cumsum(vf, axis=axis)
    pad_shape = list(vf.shape)
    pad_shape[axis] = 1
    cs = jnp.concatenate([jnp.zeros(pad_shape, jnp.float32), cs], axis=axis)
    t = np.arange(n)
    lo = np.clip(t - w // 2, 0, n)
    hi = np.clip(t - w // 2 + w, 0, n)
    total = jnp.take(cs, hi, axis=axis) - jnp.take(cs, lo, axis=axis)
    cnt_shape = [1] * vf.ndim
    cnt_shape[axis] = n
    cnt = jnp.asarray((hi - lo).reshape(cnt_shape), jnp.float32)
    return total / cnt


def _pool_mixer(u, pool_w, pool_scale, grid_rows):
    b, n, _ = u.shape
    ug = u.reshape(b, n, POOL_GROUPS, POOL_GROUP_DIM)
    outs = []
    for gi, w in enumerate(POOL_WINDOWS):
        v = ug[:, :, gi]
        if grid_rows is not None:
            v2 = v.reshape(b, grid_rows, GRID_W, POOL_GROUP_DIM)
            m = _box_mean(_box_mean(v2, w, 1), w, 2).reshape(b, n, POOL_GROUP_DIM)
        else:
            m = _box_mean(v, w, 1)
        outs.append(m - v.astype(jnp.float32))
    p = jnp.stack(outs, axis=2).astype(u.dtype)
    y = jnp.einsum('blgc,gcd->blgd', p, pool_w).reshape(b, n, POOL_WIDTH)
    return y * pool_scale


def _zoh(a_re, a_im, log_dt, b_re, b_im):
    a_re = a_re.astype(jnp.float32)
    a_im = a_im.astype(jnp.float32)
    b_re = b_re.astype(jnp.float32)
    b_im = b_im.astype(jnp.float32)
    dt = jnp.exp(log_dt.astype(jnp.float32))[:, None]
    mag = jnp.exp(a_re * dt)
    abar_re = mag * jnp.cos(a_im * dt)
    abar_im = mag * jnp.sin(a_im * dt)
    nr = abar_re - 1.0
    ni = abar_im
    den = a_re * a_re + a_im * a_im
    f_re = (nr * a_re + ni * a_im) / den
    f_im = (ni * a_re - nr * a_im) / den
    bbar_re = f_re[..., None] * b_re - f_im[..., None] * b_im
    bbar_im = f_re[..., None] * b_im + f_im[..., None] * b_re
    return abar_re, abar_im, bbar_re, bbar_im


def _complex_affine_combine(e1, e2):
    a1r, a1i, b1r, b1i = e1
    a2r, a2i, b2r, b2i = e2
    ar = a1r * a2r - a1i * a2i
    ai = a1r * a2i + a1i * a2r
    br = a2r * b1r - a2i * b1i + b2r
    bi = a2r * b1i + a2i * b1r + b2i
    return ar, ai, br, bi


def _ssm_scan(u_g, abar_re, abar_im, bbar_re, bbar_im, h0_re, h0_im, reverse):
    bu_re = jnp.einsum('blgj,gpj->lbgp', u_g, bbar_re)
    bu_im = jnp.einsum('blgj,gpj->lbgp', u_g, bbar_im)
    if reverse:
        bu_re = bu_re[::-1]
        bu_im = bu_im[::-1]
    bu_re = bu_re.at[0].add(abar_re * h0_re - abar_im * h0_im)
    bu_im = bu_im.at[0].add(abar_re * h0_im + abar_im * h0_re)
    n = bu_re.shape[0]
    a_re_t = jnp.broadcast_to(abar_re, (n, 1) + abar_re.shape)
    a_im_t = jnp.broadcast_to(abar_im, (n, 1) + abar_im.shape)
    _, _, s_re, s_im = lax.associative_scan(
        _complex_affine_combine, (a_re_t, a_im_t, bu_re, bu_im), axis=0)
    fin_re = s_re[-1]
    fin_im = s_im[-1]
    if reverse:
        s_re = s_re[::-1]
        s_im = s_im[::-1]
    return s_re, s_im, fin_re, fin_im


def _readout(s_re, s_im, c_re, c_im):
    c_re = c_re.astype(jnp.float32)
    c_im = c_im.astype(jnp.float32)
    return (jnp.einsum('lbgp,gjp->blgj', s_re, c_re)
            - jnp.einsum('lbgp,gjp->blgj', s_im, c_im))


def _s5_glu(y, glu_w, glu_b):
    b, n = y.shape[0], y.shape[1]
    g = jax.nn.gelu(y.reshape(b, n, SSM_WIDTH))
    return g * jax.nn.sigmoid(g @ glu_w + glu_b)


def _s5_mixer(u_lat, u_ctx, need_ctx, a_re, a_im, log_dt, b_re, b_im, c_re, c_im,
              d_skip, glu_w, glu_b):
    bsz, n_lat, _ = u_lat.shape
    n_ctx = u_ctx.shape[1]
    ug_lat = u_lat.astype(jnp.float32).reshape(bsz, n_lat, SSM_GROUPS, SSM_GROUP_DIM)
    ug_ctx = u_ctx.astype(jnp.float32).reshape(bsz, n_ctx, SSM_GROUPS, SSM_GROUP_DIM)
    d_g = d_skip.astype(jnp.float32).reshape(SSM_GROUPS, SSM_GROUP_DIM)
    y_lat = ug_lat * d_g
    y_ctx = ug_ctx * d_g if need_ctx else None
    zero = jnp.zeros((bsz, SSM_GROUPS, SSM_STATE), jnp.float32)
    for direction in range(N_DIRECTIONS):
        rev = direction == 1
        abar_re, abar_im, bbar_re, bbar_im = _zoh(
            a_re[direction], a_im[direction], log_dt[direction], b_re[direction], b_im[direction])
        sc_re, sc_im, fin_re, fin_im = _ssm_scan(
            ug_ctx, abar_re, abar_im, bbar_re, bbar_im, zero, zero, rev)
        sl_re, sl_im, _, _ = _ssm_scan(
            ug_lat, abar_re, abar_im, bbar_re, bbar_im, fin_re, fin_im, rev)
        y_lat = y_lat + _readout(sl_re, sl_im, c_re[direction], c_im[direction])
        if need_ctx:
            y_ctx = y_ctx + _readout(sc_re, sc_im, c_re[direction], c_im[direction])
    out_lat = _s5_glu(y_lat, glu_w, glu_b).astype(u_lat.dtype)
    out_ctx = _s5_glu(y_ctx, glu_w, glu_b).astype(u_ctx.dtype) if need_ctx else None
    return out_lat, out_ctx


def _merge(p, s, g_pool, g_ssm, w_bpool, w_bssm, w_out):
    m = jax.nn.sigmoid(g_pool) * (p @ w_bpool) + jax.nn.sigmoid(g_ssm) * (s @ w_bssm)
    return m @ w_out


def _token_mixer(h_lat, h_ctx, need_ctx, w_in, pool_w, pool_scale, a_re, a_im, log_dt,
                 b_re, b_im, c_re, c_im, d_skip, glu_w, glu_b, w_bpool, w_bssm, w_out):
    rows = h_lat.shape[1] // GRID_W
    u_pool, u_ssm, g_pool, g_ssm = _split_in(h_lat @ w_in)
    if need_ctx:
        cu_pool, cu_ssm, cg_pool, cg_ssm = _split_in(h_ctx @ w_in)
    else:
        cu_ssm = h_ctx @ w_in[:, POOL_WIDTH:POOL_WIDTH + SSM_WIDTH]
    s_lat, s_ctx = _s5_mixer(u_ssm, cu_ssm, need_ctx, a_re, a_im, log_dt, b_re, b_im,
                             c_re, c_im, d_skip, glu_w, glu_b)
    p_lat = _pool_mixer(u_pool, pool_w, pool_scale, rows)
    out_lat = _merge(p_lat, s_lat, g_pool, g_ssm, w_bpool, w_bssm, w_out).astype(h_lat.dtype)
    out_ctx = None
    if need_ctx:
        p_ctx = _pool_mixer(cu_pool, pool_w, pool_scale, None)
        out_ctx = _merge(p_ctx, s_ctx, cg_pool, cg_ssm, w_bpool, w_bssm, w_out).astype(h_ctx.dtype)
    return out_lat, out_ctx


def _moe(h, router_w, router_b, w1, w3, w2):
    b, n, d = h.shape
    t = h.reshape(b * n, d)
    scores = jax.nn.sigmoid((t @ router_w).astype(jnp.float32))
    biased = scores + router_b.astype(jnp.float32)
    grouped = biased.reshape(-1, N_EXPERT_GROUPS, EXPERTS_PER_GROUP)
    group_score = jnp.sum(lax.top_k(grouped, GROUP_SCORE_K)[0], axis=-1)
    best_group = jnp.argmax(group_score, axis=-1)
    expert_group = jnp.arange(N_EXPERTS) // EXPERTS_PER_GROUP
    in_group = expert_group[None, :] == best_group[:, None]
    masked = jnp.where(in_group, biased, -jnp.inf)
    _, idx = lax.top_k(masked, TOP_K)
    w_sel = jnp.take_along_axis(scores, idx, axis=-1)
    w_sel = w_sel / jnp.sum(w_sel, axis=-1, keepdims=True)
    gates = jnp.sum(jax.nn.one_hot(idx, N_EXPERTS, dtype=jnp.float32) * w_sel[..., None], axis=1)
    gates = gates.astype(t.dtype)
    out = jnp.zeros_like(t)
    for e in range(N_EXPERTS):
        y = (jax.nn.silu(t @ w1[e]) * (t @ w3[e])) @ w2[e]
        out = out + gates[:, e:e + 1] * y
    return out.reshape(b, n, d)


def setup_inputs(seed: int = 0) -> dict:
    key = jax.random.key(seed)
    ks = jax.random.split(key, 32)
    f32 = jnp.float32

    def nrm(k, shape, scale):
        return jax.random.normal(k, shape, f32) * scale

    n_idx = jnp.arange(SSM_STATE, dtype=f32)
    ssm_shape = (DEPTH, N_DIRECTIONS, SSM_GROUPS, SSM_STATE)
    return {
        "x": nrm(ks[0], (BATCH, SEQ, D_MODEL), 1.0),
        "c": nrm(ks[1], (BATCH, D_MODEL), 1.0),
        "ctx": nrm(ks[2], (BATCH, CTX_LEN, D_MODEL), 1.0),
        "c_ctx": nrm(ks[3], (D_MODEL,), 1.0),
        "w_mod": nrm(ks[4], (DEPTH, D_MODEL, N_MOD * D_MODEL), 0.5 * D_MODEL ** -0.5),
        "b_mod": nrm(ks[5], (DEPTH, N_MOD * D_MODEL), 0.02),
        "norm1_g": 1.0 + nrm(ks[6], (DEPTH, D_MODEL), 0.02),
        "norm2_g": 1.0 + nrm(ks[7], (DEPTH, D_MODEL), 0.02),
        "w_in": nrm(ks[8], (DEPTH, D_MODEL, IN_WIDTH), D_MODEL ** -0.5),
        "pool_w": nrm(ks[9], (DEPTH, POOL_GROUPS, POOL_GROUP_DIM, POOL_GROUP_DIM), POOL_GROUP_DIM ** -0.5),
        "pool_scale": 1.0 + nrm(ks[10], (DEPTH, POOL_WIDTH), 0.1),
        "ssm_a_re": -0.5 + nrm(ks[11], ssm_shape, 0.01),
        "ssm_a_im": math.pi * n_idx + nrm(ks[12], ssm_shape, 0.01),
        "ssm_log_dt": jax.random.uniform(ks[13], (DEPTH, N_DIRECTIONS, SSM_GROUPS), f32,
                                         math.log(DT_MIN), math.log(DT_MAX)),
        "ssm_b_re": nrm(ks[14], ssm_shape + (SSM_GROUP_DIM,), (2 * SSM_GROUP_DIM) ** -0.5),
        "ssm_b_im": nrm(ks[15], ssm_shape + (SSM_GROUP_DIM,), (2 * SSM_GROUP_DIM) ** -0.5),
        "ssm_c_re": nrm(ks[16], (DEPTH, N_DIRECTIONS, SSM_GROUPS, SSM_GROUP_DIM, SSM_STATE), SSM_STATE ** -0.5),
        "ssm_c_im": nrm(ks[17], (DEPTH, N_DIRECTIONS, SSM_GROUPS, SSM_GROUP_DIM, SSM_STATE), SSM_STATE ** -0.5),
        "ssm_d": nrm(ks[18], (DEPTH, SSM_WIDTH), 1.0),
        "glu_w": nrm(ks[19], (DEPTH, SSM_WIDTH, SSM_WIDTH), SSM_WIDTH ** -0.5),
        "glu_b": nrm(ks[20], (DEPTH, SSM_WIDTH), 0.02),
        "w_branch_pool": nrm(ks[21], (DEPTH, POOL_WIDTH, D_MODEL), POOL_WIDTH ** -0.5),
        "w_branch_ssm": nrm(ks[22], (DEPTH, SSM_WIDTH, D_MODEL), SSM_WIDTH ** -0.5),
        "w_out": nrm(ks[23], (DEPTH, D_MODEL, D_MODEL), D_MODEL ** -0.5),
        "router_w": nrm(ks[24], (D_MODEL, N_EXPERTS), D_MODEL ** -0.5),
        "router_b": nrm(ks[25], (N_EXPERTS,), 0.01),
        "expert_w1": nrm(ks[26], (DEPTH, N_EXPERTS, D_MODEL, D_EXPERT), D_MODEL ** -0.5),
        "expert_w3": nrm(ks[27], (DEPTH, N_EXPERTS, D_MODEL, D_EXPERT), D_MODEL ** -0.5),
        "expert_w2": nrm(ks[28], (DEPTH, N_EXPERTS, D_EXPERT, D_MODEL), D_EXPERT ** -0.5),
        "final_g": 1.0 + nrm(ks[29], (D_MODEL,), 0.02),
    }


def reference(x, c, ctx, c_ctx, w_mod, b_mod, norm1_g, norm2_g, w_in, pool_w, pool_scale,
              ssm_a_re, ssm_a_im, ssm_log_dt, ssm_b_re, ssm_b_im, ssm_c_re, ssm_c_im, ssm_d,
              glu_w, glu_b, w_branch_pool, w_branch_ssm, w_out, router_w, router_b,
              expert_w1, expert_w3, expert_w2, final_g):
    ctx_s = ctx
    silu_c = jax.nn.silu(c)
    silu_cc = jax.nn.silu(c_ctx)[None, :]
    for i in range(DEPTH):
        last = i == DEPTH - 1
        sh1, sc1, g1, sh2, sc2, g2 = _adaln_params(silu_c, w_mod[i], b_mod[i])
        csh1, csc1, cg1, csh2, csc2, cg2 = _adaln_params(silu_cc, w_mod[i], b_mod[i])
        h_lat = _modulate(_rms_norm(x, norm1_g[i]), sh1, sc1)
        h_ctx = _modulate(_rms_norm(ctx_s, norm1_g[i]), csh1, csc1)
        mix_lat, mix_ctx = _token_mixer(
            h_lat, h_ctx, not last, w_in[i], pool_w[i], pool_scale[i],
            ssm_a_re[i], ssm_a_im[i], ssm_log_dt[i], ssm_b_re[i], ssm_b_im[i],
            ssm_c_re[i], ssm_c_im[i], ssm_d[i], glu_w[i], glu_b[i],
            w_branch_pool[i], w_branch_ssm[i], w_out[i])
        x = x + g1 * mix_lat
        h_lat = _modulate(_rms_norm(x, norm2_g[i]), sh2, sc2)
        x = x + g2 * _moe(h_lat, router_w, router_b, expert_w1[i], expert_w3[i], expert_w2[i])
        if not last:
            ctx_s = ctx_s + cg1 * mix_ctx
            h_ctx = _modulate(_rms_norm(ctx_s, norm2_g[i]), csh2, csc2)
            ctx_s = ctx_s + cg2 * _moe(h_ctx, router_w, router_b, expert_w1[i], expert_w3[i], expert_w2[i])
    return _rms_norm(x, final_g)
```

```cpp
#include <hip/hip_runtime.h>
#include <cstdio>

#ifndef MK_MULTI
#define MK_MULTI 0
#endif
#ifndef MK_SELFTEST
#ifndef MK_DBL
#define MK_DBL 0
#endif
#define MK_SELFTEST 0
#endif
#define MK_DIAG_ZERO 0

#define LAS __attribute__((address_space(3)))
#define GAS __attribute__((address_space(1)))
typedef unsigned short bf16_t;
typedef short bf16x8 __attribute__((ext_vector_type(8)));
typedef float f32x2 __attribute__((ext_vector_type(2)));
typedef float f32x4 __attribute__((ext_vector_type(4)));
typedef float f32x16 __attribute__((ext_vector_type(16)));
typedef unsigned u32x2 __attribute__((ext_vector_type(2)));
typedef unsigned u32x4 __attribute__((ext_vector_type(4)));

constexpr int D = 1024, NB = 8, SEQ = 4096, CTXL = 256, DEPTH = 4;
constexpr int TL = NB * SEQ, TC = NB * CTXL, T = TL + TC;
constexpr int NZ = 3072, NMOD = 6 * D;
constexpr int NE = 16, DE = 512;
constexpr int LCAP = 2 * T;
constexpr int HM_ROWS = 2 * T + NE * 256;
constexpr float RMS_EPS = 1e-6f;
constexpr int NCH = 68;
constexpr int IMG_STRIDE = 336;

constexpr size_t MiB = 1u << 20;
constexpr size_t WS_CTL = 0, CTL_ZERO_BYTES = 2 * MiB;
constexpr size_t WS_MODS = 2 * MiB;
constexpr size_t WS_AB = 3 * MiB;
constexpr size_t WS_BF = 4 * MiB;
constexpr size_t WS_CF = 5 * MiB;
constexpr size_t WS_LIST = 7 * MiB;
constexpr size_t WS_GW = 12 * MiB;
constexpr size_t WS_XCTX = 13 * MiB;
constexpr size_t WS_CAR = 21 * MiB;
constexpr size_t WS_W = 39 * MiB;
constexpr size_t WO_WIN = 0, WO_WC = 6 * MiB, WO_WBS = 7 * MiB, WO_WOUT = 8 * MiB, WO_GLU = 10 * MiB, WO_W13 = 11 * MiB, WO_W2 = 43 * MiB;
constexpr size_t WS_H = 98 * MiB;
constexpr size_t WS_YG = 166 * MiB;
constexpr size_t WS_HMID = 200 * MiB;
constexpr size_t WS_Z = 272 * MiB;
constexpr size_t WS_XB = 476 * MiB;
constexpr size_t WS_W2ND = 544 * MiB;
constexpr size_t WS_CAR2 = 604 * MiB;
constexpr size_t WS_S3T = 621 * MiB;
constexpr size_t WS_U = 631 * MiB;
constexpr size_t WS_END = 665 * MiB;
static_assert((size_t)HM_ROWS * 512 * 2 <= 72 * MiB && (size_t)T * NZ * 2 <= 204 * MiB && (size_t)T * D * 2 == 68 * MiB, "ws map");
constexpr int CW_TMO = 0, CW_BAR = 4096, CW_CNT = 16384;

__device__ __forceinline__ unsigned f2bf(float f) { unsigned u = __builtin_bit_cast(unsigned, f); return (u + 0x7fffu + ((u >> 16) & 1u)) >> 16; }
typedef __bf16 bf16v2 __attribute__((ext_vector_type(2)));
__device__ __forceinline__ unsigned pk2(float lo, float hi) { const f32x2 v = {lo, hi}; const bf16v2 b = __builtin_convertvector(v, bf16v2); return __builtin_bit_cast(unsigned, b); }
__device__ __forceinline__ float bflo(unsigned w) { return __builtin_bit_cast(float, w << 16); }
__device__ __forceinline__ float bfhi(unsigned w) { return __builtin_bit_cast(float, w & 0xffff0000u); }
__device__ __forceinline__ float sigm(float x) { return __builtin_amdgcn_rcpf(1.0f + __builtin_amdgcn_exp2f(-1.44269504f * x)); }
__device__ __forceinline__ float gelu_t(float x) { const float u = 1.5957691216f * (x + 0.044715f * x * x * x); return x * sigm(u); }
__device__ __forceinline__ int lane_id_v() { int l; asm volatile("v_mbcnt_lo_u32_b32 %0, -1, 0\n\tv_mbcnt_hi_u32_b32 %0, -1, %0" : "=v"(l)); return l; }
__device__ __forceinline__ int hw_key() { return (int)(__builtin_amdgcn_s_getreg((5 << 11) | 4) & 0x3fu); }
__device__ __forceinline__ float shflx(float v, int o, int lane) { return __builtin_bit_cast(float, __builtin_amdgcn_ds_bpermute((lane ^ o) << 2, __builtin_bit_cast(int, v))); }
__device__ __forceinline__ float wave_sum(float v, int lane) {
#pragma unroll
    for (int o = 1; o < 64; o <<= 1) v += shflx(v, o, lane);
    return v;
}
__device__ __forceinline__ f32x4 ld_bf4(const bf16_t* p) { const u32x2 w = *(const u32x2*)p; return (f32x4){bflo(w.x), bfhi(w.x), bflo(w.y), bfhi(w.y)}; }
__device__ __forceinline__ void st_bf4(bf16_t* p, f32x4 v) { u32x2 w; w.x = pk2(v[0], v[1]); w.y = pk2(v[2], v[3]); *(u32x2*)p = w; }
#define LDS_WAIT() asm volatile("s_waitcnt lgkmcnt(0)" ::: "memory")
#define VM_WAIT() asm volatile("s_waitcnt vmcnt(0)" ::: "memory")

namespace pg8 {
constexpr int BM = 256, BK = 64, HALF = 128, HTB = HALF * BK * 2, STAGE_BYTES = 8 * HTB, NXCD = 8, WGM = 8;
__host__ __device__ __forceinline__ int lds_byte(int r, int c) { const int st = (r >> 4) * 2 + (c >> 5), rr = r & 15, cc = c & 31, ob = rr * 64 + cc * 2; return st * 1024 + (ob ^ (((ob >> 9) & 1) << 5)); }
__host__ __device__ __forceinline__ void stage_rc(int b, int& R, int& C) { const int st = b / 1024, sb = b % 1024, swz = sb ^ (((sb >> 9) & 1) << 5); R = (st >> 1) * 16 + swz / 64; C = (st & 1) * 32 + (swz % 64) / 2; }
__host__ __device__ __forceinline__ int perm32(int rho) { const int n = rho >> 4, i = rho & 15; return 8 * (i >> 2) + 4 * n + (i & 3); }

struct Unit { int pm, pn, e, pnl; };

struct StaticOrder {
    int nM, nN, nwg, G, c;
    __device__ void init(int M, int N, int G_, int c_) { nM = M / BM; nN = N / BM; nwg = nM * nN; G = G_; c = c_; }
    __device__ bool next(int i, Unit& u) const {
        const long L = (long)i * G + c; if (L >= nwg) return false;
        int wgid = (int)L; { const int q = nwg / NXCD, r = nwg % NXCD, xcd = wgid % NXCD, off = wgid / NXCD; wgid = (xcd < r ? xcd * (q + 1) : r * (q + 1) + (xcd - r) * q) + off; }
        const int nig = WGM * nN, gid = wgid / nig, fm = gid * WGM, gsz = (nM - fm) < WGM ? (nM - fm) : WGM;
        u.pm = fm + ((wgid % nig) % gsz); u.pn = (wgid % nig) / gsz; u.pnl = u.pn; u.e = 0; return true;
    }
    __device__ __forceinline__ int arow(const Unit&, int) const { return 0; }
};
struct ComboOrder {
    int G, c;
    __device__ bool next(int i, Unit& u) const {
        const int L = i * G + c; constexpr int NM = (T / BM) * 4, NG = (T / BM) * 2;
        if (L >= NM + NG) return false;
        if (L < NM) { u.pm = L >> 2; u.pn = L & 3; u.pnl = L & 3; u.e = 0; }
        else { const int q = L - NM; u.pm = (q >> 1) + (int)((WS_YG - WS_H) / ((size_t)BM * 1024)); u.pn = (q & 1) + (int)((WO_GLU - WO_WC) / ((size_t)BM * 1024)); u.pnl = q & 1; u.e = 1; }
        return true;
    }
    __device__ __forceinline__ int arow(const Unit&, int) const { return 0; }
};
struct PairOrder {
    StaticOrder so;
    __device__ bool next(int i, Unit& u) const {
        if (!so.next(i >> 1, u)) return false;
        u.e = i & 1; u.pnl = u.pn;
        if (u.e == 0) { u.pm += T / BM; u.pn += 4; }
        return true;
    }
    __device__ __forceinline__ int arow(const Unit&, int) const { return 0; }
};
struct MoeOrder {
    const LAS int* cum; const LAS int* cnt; const int* list; int G, c;
    __device__ bool next(int i, Unit& u) const {
        const int ntot = cum[NE]; int L;
        if ((G & 7) == 0) { const int x = c & 7, k = i * (G >> 3) + (c >> 3); const int rt = x + 8 * (k >> 2); if (rt >= ntot) return false; L = rt * 4 + (k & 3); }
        else { L = i * G + c; if (L >= ntot * 4) return false; }
        const int rtg = L >> 2; int e = 0;
#pragma unroll
        for (int k = 1; k < NE; ++k) e += (rtg >= cum[k]) ? 1 : 0;
        u.pm = rtg; u.e = e; u.pnl = L & 3; u.pn = e * 4 + (L & 3); return true;
    }
    __device__ __forceinline__ int arow(const Unit& u, int rl) const {
        const int pos = (u.pm - cum[u.e]) * BM + rl;
        int tok = 0; if (pos < cnt[u.e]) tok = list[u.e * LCAP + pos] >> 1;
        return tok;
    }
};

template <class Epi, class Sched, bool GATHER, bool AGRP = false>
__device__ __forceinline__ void gemm_phase(LAS unsigned char* lds, const int tid_in, const bf16_t* A, const bf16_t* Bt, const int K, const Sched& S, const Epi& E) {
    const int tid = tid_in, wid = __builtin_amdgcn_readfirstlane(tid >> 6), lane = tid & 63, wr = wid >> 2, wc = wid & 3, fr = lane & 15, fq = lane >> 4;
    const int nt = K / BK;
    unsigned voffB[2];
#pragma unroll
    for (int i = 0; i < 2; ++i) { int R, C; stage_rc(tid * 16 + i * 8192, R, C); const int Rb = Epi::PERM ? ((R & ~31) + perm32(R & 31)) : R; voffB[i] = (unsigned)(Rb * K + C) * 2u; }
    const size_t kstep = (size_t)(BK * 2);
    const size_t kstepA = AGRP ? (size_t)(BK / 16) * T * 32 : kstep;
    const size_t hstep = (size_t)HALF * K * 2;
    const size_t tstep = 2 * hstep;
    const unsigned ldsw = (unsigned)wid * 1024u;
    const int aoff = lds_byte(wr * 64 + fr, fq * 8), boff = lds_byte(wc * 32 + fr, fq * 8);
#define PG8_SA(b, h) (((b) * 2 + (h)) * HTB)
#define PG8_SB(b, h) ((4 + (b) * 2 + (h)) * HTB)
#define PG8_STAGE(bufoff, gbase, voff) do { _Pragma("unroll") for (int _i = 0; _i < 2; ++_i) \
        __builtin_amdgcn_global_load_lds((const unsigned*)((const char*)(gbase) + (voff)[_i]), (LAS unsigned*)(lds + (bufoff) + ldsw + _i * 8192), 16, 0, 0); } while (0)
#define PG8_STAGEA(bufoff, kt, o0, o1) do { const char* _g = (const char*)A + (size_t)(kt) * kstepA; \
        __builtin_amdgcn_global_load_lds((const unsigned*)(_g + (o0)), (LAS unsigned*)(lds + (bufoff) + ldsw), 16, 0, 0); \
        __builtin_amdgcn_global_load_lds((const unsigned*)(_g + (o1)), (LAS unsigned*)(lds + (bufoff) + ldsw + 8192), 16, 0, 0); } while (0)
#define PG8_LDA(dst, b, h) do { _Pragma("unroll") for (int m = 0; m < 4; ++m) _Pragma("unroll") for (int k = 0; k < 2; ++k) dst[m][k] = *(const LAS bf16x8*)(lds + PG8_SA(b, h) + aoff + m * 2048 + k * 1024); } while (0)
#define PG8_LDB(dst, b, h) do { _Pragma("unroll") for (int n = 0; n < 2; ++n) _Pragma("unroll") for (int k = 0; k < 2; ++k) dst[n][k] = *(const LAS bf16x8*)(lds + PG8_SB(b, h) + boff + n * 2048 + k * 1024); } while (0)
#define PG8_MMA(ai, bj, At, Bt_) do { __builtin_amdgcn_s_setprio(1); _Pragma("unroll") for (int m = 0; m < 4; ++m) _Pragma("unroll") for (int n = 0; n < 2; ++n) _Pragma("unroll") for (int k = 0; k < 2; ++k) \
        acc[ai][bj][m][n] = __builtin_amdgcn_mfma_f32_16x16x32_bf16(Bt_[n][k], At[m][k], acc[ai][bj][m][n], 0, 0, 0); __builtin_amdgcn_s_setprio(0); } while (0)
#define PG8_WAIT_V(n) asm volatile("s_waitcnt vmcnt(" #n ")" ::: "memory")
#define PG8_WAIT_L(n) asm volatile("s_waitcnt lgkmcnt(" #n ")" ::: "memory")
#define PG8_BAR __builtin_amdgcn_s_barrier()
#define PG8_SCHED __builtin_amdgcn_sched_barrier(0)
#define PG8_CALC_OFF(dst, U) do { _Pragma("unroll") for (int _h = 0; _h < 2; ++_h) _Pragma("unroll") for (int _i = 0; _i < 2; ++_i) { int _R, _C; stage_rc(tid * 16 + _i * 8192, _R, _C); const int _rl = _h * HALF + _R; \
        const unsigned _row = GATHER ? (unsigned)S.arow((U), _rl) : (unsigned)((U).pm * BM + _rl); dst[_h * 2 + _i] = AGRP ? (((unsigned)(_C >> 4) * (unsigned)T + _row) * 32u + (unsigned)((_C & 15) * 2)) : _row * (unsigned)(K * 2) + (unsigned)(_C * 2); } } while (0)
    Unit cur, nxt; int ui = 0;
    if (!S.next(0, cur)) return;
    f32x4 acc[2][2][4][2];
#pragma unroll
    for (int a = 0; a < 2; ++a)
#pragma unroll
        for (int b = 0; b < 2; ++b)
#pragma unroll
            for (int m = 0; m < 4; ++m)
#pragma unroll
                for (int n = 0; n < 2; ++n) acc[a][b][m][n] = (f32x4){0.f, 0.f, 0.f, 0.f};
    bf16x8 At[4][2], B0[2][2], B1[2][2];
    unsigned oc[4], on[4];
    PG8_CALC_OFF(oc, cur);
    const char* cB = (const char*)Bt + (size_t)cur.pn * tstep;
    PG8_STAGE(PG8_SB(0, 0), cB, voffB); PG8_STAGE(PG8_SB(0, 1), cB + hstep, voffB); PG8_STAGEA(PG8_SA(0, 0), 0, oc[0], oc[1]); PG8_STAGEA(PG8_SA(0, 1), 0, oc[2], oc[3]);
    if (wr == 1) PG8_BAR;
    PG8_WAIT_V(2); PG8_BAR;
    PG8_STAGE(PG8_SB(1, 0), cB + kstep, voffB); PG8_STAGEA(PG8_SA(1, 0), 1, oc[0], oc[1]); PG8_STAGE(PG8_SB(1, 1), cB + hstep + kstep, voffB);
    PG8_WAIT_V(6); PG8_BAR;
    for (;;) {
        const bool has_next = S.next(ui + 1, nxt);
        if (has_next) { PG8_CALC_OFF(on, nxt); } else {
#pragma unroll
            for (int q = 0; q < 4; ++q) on[q] = oc[q]; }
        const char* nB = has_next ? (const char*)Bt + (size_t)nxt.pn * tstep : cB;
        for (int t = 0; t < nt; t += 2) {
            const bool last = (t == nt - 2);
            const int k2 = last ? 0 : t + 2, k3 = k2 + 1;
            const unsigned s0 = last ? on[0] : oc[0], s1 = last ? on[1] : oc[1], s2 = last ? on[2] : oc[2], s3 = last ? on[3] : oc[3];
            const char* b2 = last ? nB : cB + (size_t)(t + 2) * kstep; const char* b3 = b2 + kstep;
            PG8_LDB(B0, 0, 0); PG8_LDB(B1, 0, 1); PG8_SCHED; PG8_LDA(At, 0, 0); PG8_STAGEA(PG8_SA(1, 1), t + 1, oc[2], oc[3]);
            PG8_WAIT_V(8); PG8_WAIT_L(0); PG8_BAR; PG8_MMA(0, 0, At, B0); PG8_MMA(0, 1, At, B1); PG8_BAR; PG8_SCHED;
            PG8_LDA(At, 0, 1); PG8_STAGE(PG8_SB(0, 0), b2, voffB); PG8_STAGE(PG8_SB(0, 1), b2 + hstep, voffB); PG8_STAGEA(PG8_SA(0, 0), k2, s0, s1);
            PG8_WAIT_V(8); PG8_WAIT_L(0); PG8_BAR; PG8_MMA(1, 0, At, B0); PG8_MMA(1, 1, At, B1); PG8_BAR; PG8_SCHED;
            PG8_LDB(B0, 1, 0); PG8_LDB(B1, 1, 1); PG8_SCHED; PG8_LDA(At, 1, 0); PG8_STAGEA(PG8_SA(0, 1), k2, s2, s3);
            PG8_WAIT_V(8); PG8_WAIT_L(0); PG8_BAR; PG8_MMA(0, 0, At, B0); PG8_MMA(0, 1, At, B1); PG8_BAR; PG8_SCHED;
            PG8_LDA(At, 1, 1); PG8_STAGE(PG8_SB(1, 0), b3, voffB); PG8_STAGE(PG8_SB(1, 1), b3 + hstep, voffB); PG8_STAGEA(PG8_SA(1, 0), k3, s0, s1);
            PG8_WAIT_V(8); PG8_WAIT_L(0); PG8_BAR; PG8_MMA(1, 0, At, B0); PG8_MMA(1, 1, At, B1); PG8_BAR; PG8_SCHED;
        }
        if (wr == 0) PG8_BAR;
        bool keep = false;
        if constexpr (Epi::KEEPS) keep = E.apply(acc, cur, wr, wc, fr, fq); else E(acc, cur, wr, wc, fr, fq);
        if (!has_next) break;
        if (!keep) {
#pragma unroll
        for (int a = 0; a < 2; ++a)
#pragma unroll
            for (int b = 0; b < 2; ++b)
#pragma unroll
                for (int m = 0; m < 4; ++m)
#pragma unroll
                    for (int n = 0; n < 2; ++n) acc[a][b][m][n] = (f32x4){0.f, 0.f, 0.f, 0.f};
        }
        cur = nxt; cB = nB; ++ui;
#pragma unroll
        for (int q = 0; q < 4; ++q) oc[q] = on[q];
        if (wr == 1) PG8_BAR;
    }
    PG8_WAIT_V(0);
    PG8_BAR;
#undef PG8_SA
#undef PG8_SB
#undef PG8_STAGE
#undef PG8_STAGEA
#undef PG8_LDA
#undef PG8_LDB
#undef PG8_MMA
#undef PG8_WAIT_V
#undef PG8_WAIT_L
#undef PG8_BAR
#undef PG8_SCHED
#undef PG8_CALC_OFF
}

typedef const f32x4 (&AccRef)[2][2][4][2];
__device__ __forceinline__ u32x4 pack8(f32x4 v0, f32x4 v1) { u32x4 w; w.x = pk2(v0[0], v0[1]); w.y = pk2(v0[2], v0[3]); w.z = pk2(v1[0], v1[1]); w.w = pk2(v1[2], v1[3]); return w; }
__device__ __forceinline__ void unpack8(u32x4 w, f32x4& v0, f32x4& v1) { v0 = (f32x4){bflo(w.x), bfhi(w.x), bflo(w.y), bfhi(w.y)}; v1 = (f32x4){bflo(w.z), bfhi(w.z), bflo(w.w), bfhi(w.w)}; }
__device__ __forceinline__ f32x4 sigm4(f32x4 v) { return (f32x4){sigm(v[0]), sigm(v[1]), sigm(v[2]), sigm(v[3])}; }

struct EpiIn {
    static constexpr bool PERM = true, KEEPS = false; bf16_t* Z; bf16_t* U;
    __device__ __forceinline__ void operator()(AccRef acc, const Unit& u, int wr, int wc, int fr, int fq) const {
        const int row0 = u.pm * BM + wr * 64 + fr; const bool gate = u.pnl >= 4;
        const int col0 = gate ? 1024 + (u.pnl - 4) * HALF + wc * 32 + 8 * fq : u.pnl * BM + wc * 32 + 8 * fq, cstep = gate ? 1024 : HALF;
#pragma unroll
        for (int ai = 0; ai < 2; ++ai)
#pragma unroll
            for (int m = 0; m < 4; ++m) { bf16_t* rowp = Z + (size_t)(row0 + ai * HALF + m * 16) * NZ + col0;
                f32x4 v0 = acc[ai][0][m][0], v1 = acc[ai][0][m][1], w0 = acc[ai][1][m][0], w1 = acc[ai][1][m][1];
                u32x4 pa = pack8(v0, v1);
                if (gate) { pa = pack8(sigm4(v0), sigm4(v1)); f32x4 p0, p1; unpack8(pa, p0, p1); w0 = sigm4(w0); w1 = sigm4(w1);
#pragma unroll
                    for (int k = 0; k < 4; ++k) { w0[k] *= __builtin_amdgcn_rcpf(fmaxf(p0[k], 1e-30f)); w1[k] *= __builtin_amdgcn_rcpf(fmaxf(p1[k], 1e-30f)); } }
                if (u.pnl == 2 || u.pnl == 3) {
                    const int uc = (u.pnl - 2) * BM + wc * 32 + 8 * fq; const size_t tok = (size_t)(row0 + ai * HALF + m * 16);
                    *(u32x4*)(U + ((size_t)(uc >> 4) * T + tok) * 16 + (uc & 8)) = pa; *(u32x4*)(U + ((size_t)((uc + HALF) >> 4) * T + tok) * 16 + (uc & 8)) = pack8(w0, w1);
                } else { *(u32x4*)rowp = pa; *(u32x4*)(rowp + cstep) = pack8(w0, w1); } }
    }
};
struct EpiGlu {
    static constexpr bool PERM = true, KEEPS = false; const bf16_t* YG; bf16_t* S; const float* gb;
    __device__ __forceinline__ void operator()(AccRef acc, const Unit& u, int wr, int wc, int fr, int fq) const {
        const int row0 = u.pm * BM + wr * 64 + fr, col0 = u.pnl * BM + wc * 32 + 8 * fq;
        f32x4 bv[2][2];
#pragma unroll
        for (int bj = 0; bj < 2; ++bj)
#pragma unroll
            for (int n = 0; n < 2; ++n) bv[bj][n] = *(const f32x4*)(gb + col0 + bj * HALF + 4 * n);
        u32x4 yv[2][4][2];
#pragma unroll
        for (int ai = 0; ai < 2; ++ai)
#pragma unroll
            for (int m = 0; m < 4; ++m)
#pragma unroll
                for (int bj = 0; bj < 2; ++bj) yv[ai][m][bj] = *(const u32x4*)(YG + ((size_t)((col0 + bj * HALF) >> 4) * T + (row0 + ai * HALF + m * 16)) * 16 + ((col0 + bj * HALF) & 8));
        __builtin_amdgcn_sched_barrier(0);
#pragma unroll
        for (int ai = 0; ai < 2; ++ai)
#pragma unroll
            for (int m = 0; m < 4; ++m) { const size_t off = (size_t)(row0 + ai * HALF + m * 16) * 512 + col0;
#pragma unroll
                for (int bj = 0; bj < 2; ++bj) { f32x4 y0, y1; unpack8(yv[ai][m][bj], y0, y1);
                    const f32x4 v0 = y0 * sigm4(acc[ai][bj][m][0] + bv[bj][0]), v1 = y1 * sigm4(acc[ai][bj][m][1] + bv[bj][1]);
                    *(u32x4*)(S + off + bj * HALF) = pack8(v0, v1); } }
    }
};
template <int MODE> struct EpiMerge {
    static constexpr bool PERM = true, KEEPS = false; bf16_t* Z; bf16_t* M;
    __device__ __forceinline__ void operator()(AccRef acc, const Unit& u, int wr, int wc, int fr, int fq) const {
        const int row0 = u.pm * BM + wr * 64 + fr, col0 = u.pnl * BM + wc * 32 + 8 * fq;
#pragma unroll
        for (int ai = 0; ai < 2; ++ai)
#pragma unroll
            for (int m = 0; m < 4; ++m) { bf16_t* rowp = Z + (size_t)(row0 + ai * HALF + m * 16) * NZ + col0;
#pragma unroll
                for (int bj = 0; bj < 2; ++bj) {
                    if (MODE == 0) { f32x4 g0, g1; unpack8(*(const u32x4*)(rowp + 1024 + bj * HALF), g0, g1);
                        *(u32x4*)(rowp + 1024 + bj * HALF) = pack8(g0 * acc[ai][bj][m][0], g1 * acc[ai][bj][m][1]); }
                    else { f32x4 g0, g1, t0, t1; unpack8(*(const u32x4*)(rowp + 2048 + bj * HALF), g0, g1); unpack8(*(const u32x4*)(rowp + 1024 + bj * HALF), t0, t1);
                        *(u32x4*)(M + (size_t)(row0 + ai * HALF + m * 16) * D + col0 + bj * HALF) = pack8(t0 + g0 * acc[ai][bj][m][0], t1 + g1 * acc[ai][bj][m][1]); } } }
    }
};
struct EpiM12 {
    static constexpr bool PERM = true, KEEPS = true; const bf16_t* Z; bf16_t* M;
    __device__ __forceinline__ bool apply(f32x4 (&acc)[2][2][4][2], const Unit& u, int wr, int wc, int fr, int fq) const {
        const int pmr = u.e == 0 ? u.pm - T / BM : u.pm; const int row0_ = pmr * BM + wr * 64 + fr, col0 = u.pnl * BM + wc * 32 + 8 * fq;
        if (u.e == 0) {
            const int row0 = row0_;
            u32x4 qv[2][4][2];
#pragma unroll
            for (int ai = 0; ai < 2; ++ai)
#pragma unroll
                for (int m = 0; m < 4; ++m)
#pragma unroll
                    for (int bj = 0; bj < 2; ++bj) qv[ai][m][bj] = *(const u32x4*)(Z + (size_t)(row0 + ai * HALF + m * 16) * NZ + col0 + bj * HALF + 2048);
            __builtin_amdgcn_sched_barrier(0);
#pragma unroll
            for (int ai = 0; ai < 2; ++ai)
#pragma unroll
                for (int m = 0; m < 4; ++m)
#pragma unroll
                    for (int bj = 0; bj < 2; ++bj) { f32x4 q0, q1; unpack8(qv[ai][m][bj], q0, q1); acc[ai][bj][m][0] *= q0; acc[ai][bj][m][1] *= q1; }
        } else {
            const int row0 = row0_;
            u32x4 pv[2][4][2];
#pragma unroll
            for (int ai = 0; ai < 2; ++ai)
#pragma unroll
                for (int m = 0; m < 4; ++m)
#pragma unroll
                    for (int bj = 0; bj < 2; ++bj) pv[ai][m][bj] = *(const u32x4*)(Z + (size_t)(row0 + ai * HALF + m * 16) * NZ + col0 + bj * HALF + 1024);
            __builtin_amdgcn_sched_barrier(0);
#pragma unroll
            for (int ai = 0; ai < 2; ++ai)
#pragma unroll
                for (int m = 0; m < 4; ++m)
#pragma unroll
                    for (int bj = 0; bj < 2; ++bj) { f32x4 p0, p1; unpack8(pv[ai][m][bj], p0, p1);
                        *(u32x4*)(M + (size_t)(row0 + ai * HALF + m * 16) * D + col0 + bj * HALF) = pack8(acc[ai][bj][m][0] * p0, acc[ai][bj][m][1] * p1); }
        }
        return u.e == 0;
    }
};
struct EpiCombo {
    static constexpr bool PERM = true, KEEPS = false; EpiMerge<0> em; EpiGlu eg;
    __device__ __forceinline__ void operator()(AccRef acc, const Unit& u, int wr, int wc, int fr, int fq) const {
        if (u.e == 0) em(acc, u, wr, wc, fr, fq);
        else { Unit v = u; v.pm = u.pm - (int)((WS_YG - WS_H) / ((size_t)BM * 1024)); eg(acc, v, wr, wc, fr, fq); }
    }
};
struct EpiOut {
    static constexpr bool PERM = false, KEEPS = false; bf16_t* XB; const float* g1; bf16_t* XBW;
    __device__ __forceinline__ void operator()(AccRef acc, const Unit& u, int wr, int wc, int fr, int fq) const {
        const bool lat = u.pm < TL / BM; const int brow = lat ? (u.pm >> 4) : 8;
        bf16_t* xb = XB + (size_t)u.pm * BM * D; bf16_t* xw = XBW + (size_t)u.pm * BM * D;
        const int row0 = wr * 64 + fr, col0 = u.pnl * BM + wc * 32 + 4 * fq;
        f32x4 gv[2][2];
#pragma unroll
        for (int bj = 0; bj < 2; ++bj)
#pragma unroll
            for (int n = 0; n < 2; ++n) gv[bj][n] = *(const f32x4*)(g1 + (size_t)brow * NMOD + col0 + bj * HALF + n * 16);
#pragma unroll
        for (int ai = 0; ai < 2; ++ai) { u32x2 xv[4][2][2];
#pragma unroll
            for (int m = 0; m < 4; ++m)
#pragma unroll
                for (int bj = 0; bj < 2; ++bj)
#pragma unroll
                    for (int n = 0; n < 2; ++n) xv[m][bj][n] = *(const u32x2*)(xb + (size_t)(row0 + ai * HALF + m * 16) * D + col0 + bj * HALF + n * 16);
            __builtin_amdgcn_sched_barrier(0);
#pragma unroll
            for (int m = 0; m < 4; ++m)
#pragma unroll
                for (int bj = 0; bj < 2; ++bj)
#pragma unroll
                    for (int n = 0; n < 2; ++n) { const u32x2 w = xv[m][bj][n]; const f32x4 xo = {bflo(w.x), bfhi(w.x), bflo(w.y), bfhi(w.y)};
                        st_bf4(xw + (size_t)(row0 + ai * HALF + m * 16) * D + col0 + bj * HALF + n * 16, xo + gv[bj][n] * acc[ai][bj][m][n]); } }
    }
};
struct EpiUp {
    static constexpr bool PERM = true, KEEPS = false; bf16_t* HM;
    __device__ __forceinline__ void operator()(AccRef acc, const Unit& u, int wr, int wc, int fr, int fq) const {
        const int row0 = u.pm * BM + wr * 64 + fr, col0 = u.pnl * HALF + wc * 32 + 8 * fq;
#pragma unroll
        for (int ai = 0; ai < 2; ++ai)
#pragma unroll
            for (int m = 0; m < 4; ++m) { f32x4 a0 = acc[ai][0][m][0], a1 = acc[ai][0][m][1]; const f32x4 b0 = acc[ai][1][m][0], b1 = acc[ai][1][m][1];
                a0 = a0 * sigm4(a0) * b0; a1 = a1 * sigm4(a1) * b1;
                *(u32x4*)(HM + (size_t)(row0 + ai * HALF + m * 16) * DE + col0) = pack8(a0, a1); }
    }
};
struct EpiDown {
    static constexpr bool PERM = true, KEEPS = false; bf16_t* SL; const int* list; const float* gw; const LAS int* cum; const LAS int* cnt;
    __device__ __forceinline__ void operator()(AccRef acc, const Unit& u, int wr, int wc, int fr, int fq) const {
        const int col0 = u.pnl * BM + wc * 32 + 8 * fq; const int pos0 = (u.pm - cum[u.e]) * BM + wr * 64 + fr, n_e = cnt[u.e];
        int ent[2][4]; float w[2][4];
#pragma unroll
        for (int ai = 0; ai < 2; ++ai)
#pragma unroll
            for (int m = 0; m < 4; ++m) { const int pos = pos0 + ai * HALF + m * 16; ent[ai][m] = pos < n_e ? list[u.e * LCAP + pos] : -1; }
#pragma unroll
        for (int ai = 0; ai < 2; ++ai)
#pragma unroll
            for (int m = 0; m < 4; ++m) w[ai][m] = ent[ai][m] >= 0 ? gw[ent[ai][m]] : 0.f;
#pragma unroll
        for (int ai = 0; ai < 2; ++ai)
#pragma unroll
            for (int m = 0; m < 4; ++m) asm volatile("" : "+v"(w[ai][m]));
#pragma unroll
        for (int ai = 0; ai < 2; ++ai)
#pragma unroll
            for (int m = 0; m < 4; ++m) if (ent[ai][m] >= 0) { bf16_t* rowp = SL + (size_t)ent[ai][m] * D + col0;
#pragma unroll
                for (int bj = 0; bj < 2; ++bj) *(u32x4*)(rowp + bj * HALF) = pack8(acc[ai][bj][m][0] * w[ai][m], acc[ai][bj][m][1] * w[ai][m]); }
    }
};
}

#define XB_TMO      128
#define XB_XCNT(j)  (256  + 64 * (j))
#define XB_XSUB(j)  (1280 + 64 * (j))
#define XB_XGEN(j)  (2304 + 64 * (j))
#define XB_TOP      3328
#define XB_TOPGEN   3392
#define XCD_BAR_WORDS 3456
#define XB_SPIN_CAP (1u << 22)

__device__ __forceinline__ unsigned xb_ld(unsigned* p)              { return __hip_atomic_load(p, __ATOMIC_RELAXED, __HIP_MEMORY_SCOPE_AGENT); }
__device__ __forceinline__ unsigned xb_add(unsigned* p, unsigned v) { return __hip_atomic_fetch_add(p, v, __ATOMIC_RELAXED, __HIP_MEMORY_SCOPE_AGENT); }
__device__ __forceinline__ unsigned xb_xcc_id() { return (unsigned)__builtin_amdgcn_s_getreg((3 << 11) | 20) & 0xFu; }
#define XB_SPIN(cond, bar) do { unsigned _sp = 0; while (cond) { __builtin_amdgcn_s_sleep(1); \
    if ((++_sp & 255u) == 0u) { if (xb_ld(&(bar)[XB_TMO])) break; if (_sp > XB_SPIN_CAP) { atomicAdd(&(bar)[XB_TMO], 1u); break; } } } } while (0)

struct XcdBarrier { unsigned* bar; unsigned x; volatile LAS unsigned* st; };
__device__ __forceinline__ XcdBarrier xcd_barrier_post(unsigned* bar, volatile LAS unsigned* st) {
    XcdBarrier b; b.bar = bar; b.x = xb_xcc_id(); b.st = st;
    if (threadIdx.x == 0) (void)xb_add(&bar[XB_XCNT(b.x)], 1u);
    return b;
}
__device__ __forceinline__ void xcd_barrier_complete(unsigned* bar, unsigned x_in, unsigned& nloc, unsigned& nx) {
    unsigned x = x_in;
    const unsigned G = gridDim.x * gridDim.y * gridDim.z;
    asm volatile("" : "+s"(x));
    unsigned sum, cnt, mine, sp = 0u;
    for (;;) {
        sum = 0u; cnt = 0u; mine = 0u;
#pragma unroll
        for (unsigned j = 0; j < 16; ++j) { const unsigned c = xb_ld(&bar[XB_XCNT(j)]); sum += c; cnt += (c > 0u) ? 1u : 0u; mine = (j == x) ? c : mine; }
        if (sum == G) break;
        __builtin_amdgcn_s_sleep(1);
        if ((++sp & 255u) == 0u) { if (xb_ld(&bar[XB_TMO])) break; if (sp > XB_SPIN_CAP) { atomicAdd(&bar[XB_TMO], 1u); break; } }
    }
    nloc = mine > 0u ? mine : 1u; nx = cnt > 0u ? cnt : 1u;
}
__device__ __forceinline__ void xcd_barrier(const XcdBarrier& b, const int tid) {
    asm volatile("s_waitcnt vmcnt(0)" ::: "memory");
    __syncthreads();
    if (tid == 0) {
        unsigned* bar = b.bar;
        __builtin_amdgcn_s_waitcnt(0);
        unsigned nloc = b.st[0], nx = b.st[1];
        if (nloc == 0u) { xcd_barrier_complete(bar, b.x, nloc, nx); b.st[0] = nloc; b.st[1] = nx; }
        const unsigned old = xb_add(&bar[XB_XSUB(b.x)], 1u);
        const unsigned gen = old / nloc;
        if (old + 1u == (gen + 1u) * nloc) {
            __builtin_amdgcn_fence(__ATOMIC_RELEASE, "agent");
            asm volatile("s_waitcnt vmcnt(0)" ::: "memory");
            const unsigned og = xb_add(&bar[XB_TOP], 1u);
            const unsigned tg = og / nx;
            if (og + 1u == (tg + 1u) * nx) xb_add(&bar[XB_TOPGEN], 1u);
            else XB_SPIN(xb_ld(&bar[XB_TOPGEN]) == tg, bar);
            __builtin_amdgcn_fence(__ATOMIC_ACQUIRE, "agent");
            xb_add(&bar[XB_XGEN(b.x)], 1u);
            asm volatile("s_waitcnt vmcnt(0)" ::: "memory");
        } else {
            XB_SPIN(xb_ld(&bar[XB_XGEN(b.x)]) == gen, bar);
            __builtin_amdgcn_fence(__ATOMIC_ACQUIRE, "agent");
            asm volatile("s_waitcnt vmcnt(0)" ::: "memory");
        }
    }
    __syncthreads();
}

constexpr int NWAVES = 8, NTHREADS = 512;
constexpr int RING_BYTES = 131072, MISC_OFF = RING_BYTES, LDS_BYTES = 163840;

struct KArgs {
    const float* in[30]; float* out; unsigned char* ws; int lo, hi;
};
constexpr int PTAB = 3072, WTAB = 3200;
constexpr int PTAB_DUMMY = 0;
struct Args {
    volatile LAS int* tab;
    __device__ __forceinline__ unsigned long long ld(int k) const { const unsigned lo = (unsigned)__builtin_amdgcn_readfirstlane(tab[2 * k]), hi = (unsigned)__builtin_amdgcn_readfirstlane(tab[2 * k + 1]); return ((unsigned long long)hi << 32) | lo; }
    __device__ __forceinline__ const float* in(int k) const { return (const float*)(const GAS float*)ld(k); }
    __device__ __forceinline__ float* out() const { return (float*)(GAS float*)ld(30); }
    __device__ __forceinline__ unsigned char* ws() const { return (unsigned char*)(GAS unsigned char*)ld(31); }
};

struct Ctx {
    LAS unsigned char* lds; volatile LAS int* misc;
    int tid, lane, wave, G, bid;
    unsigned char* ws;
};

__device__ __forceinline__ const float* xrow_in(const Args& a, int row) { return row < TL ? a.in(0) + (size_t)row * D : a.in(2) + (size_t)(row - TL) * D; }
__device__ __forceinline__ int brow_of(int row) { return row < TL ? (row >> 12) : 8; }

__device__ __forceinline__ void zoh(const Args& a, int idx  , float& abr, float& abi, float& fr_, float& fi_) {
    const float are = a.in(11)[idx], aim = a.in(12)[idx]; const float dt = expf(a.in(13)[idx >> 6]);
    const float mag = expf(are * dt); abr = mag * cosf(aim * dt); abi = mag * sinf(aim * dt);
    const float nr = abr - 1.0f, ni = abi, den = are * are + aim * aim;
    fr_ = (nr * are + ni * aim) / den; fi_ = (ni * are - nr * aim) / den;
}
__device__ __forceinline__ void zoh_fast(const Args& a, int idx, float& abr, float& abi, float& fr_, float& fi_) {
    const float are = a.in(11)[idx], aim = a.in(12)[idx]; const float dt = __expf(a.in(13)[idx >> 6]);
    const float mag = __expf(are * dt); abr = mag * __cosf(aim * dt); abi = mag * __sinf(aim * dt);
    const float nr = abr - 1.0f, ni = abi, den = __builtin_amdgcn_rcpf(are * are + aim * aim);
    fr_ = (nr * are + ni * aim) * den; fi_ = (ni * are - nr * aim) * den;
}
__device__ __forceinline__ void phase_p0(const Args& a, Ctx& c) {
    LAS float* sl = (LAS float*)c.lds;
    LAS float* part = (LAS float*)(c.lds + 9 * 1024 * 4);
    for (int i = c.tid; i < 9 * 1024; i += NTHREADS) { const float v = i < 8 * 1024 ? a.in(1)[i] : a.in(3)[i - 8 * 1024]; sl[i] = v * sigm(v); }
    __syncthreads();
    float* mods = (float*)(c.ws + WS_MODS);
    for (int it = c.bid; it < DEPTH * 96; it += c.G) {
        const int l = it / 96, col = (it % 96) * 64 + c.lane;
        const float* w = a.in(4) + (size_t)l * D * NMOD + col;
        float acc[9];
#pragma unroll
        for (int r = 0; r < 9; ++r) acc[r] = 0.f;
#pragma unroll 8
        for (int kk = 0; kk < 128; ++kk) { const int k = c.wave * 128 + kk; const float wv = w[(size_t)k * NMOD];
#pragma unroll
            for (int r = 0; r < 9; ++r) acc[r] += sl[r * 1024 + k] * wv; }
#pragma unroll
        for (int r = 0; r < 9; ++r) part[(c.wave * 9 + r) * 64 + c.lane] = acc[r];
        __syncthreads();
        for (int o = c.tid; o < 9 * 64; o += NTHREADS) { float s = 0.f;
#pragma unroll
            for (int w8 = 0; w8 < 8; ++w8) s += part[w8 * 576 + o];
            const int r = o >> 6, cc = (it % 96) * 64 + (o & 63); mods[((size_t)l * 9 + r) * NMOD + cc] = s + a.in(5)[(size_t)l * NMOD + cc]; }
        __syncthreads();
    }
    const int gt = c.bid * NTHREADS + c.tid, GT = c.G * NTHREADS;
    f32x2* AB = (f32x2*)(c.ws + WS_AB);
    for (int i = gt; i < DEPTH * 2 * 32 * 64; i += GT) { float abr, abi, fr_, fi_; zoh(a, i, abr, abi, fr_, fi_); AB[i] = (f32x2){abr, abi}; }
    u32x4* BF = (u32x4*)(c.ws + WS_BF);
    for (int i = gt; i < DEPTH * 2 * 32 * 4 * 64; i += GT) {
        const int ln = i & 63, f = (i >> 6) & 3, ldg = i >> 8; const int ri = f >> 1, tile = f & 1, p = tile * 32 + (ln & 31), hh = ln >> 5;
        float abr, abi, fr_, fi_; zoh(a, ldg * 64 + p, abr, abi, fr_, fi_);
        const float* bre = a.in(14) + ((size_t)ldg * 64 + p) * 16 + 8 * hh; const float* bim = a.in(15) + ((size_t)ldg * 64 + p) * 16 + 8 * hh;
        float v[8];
#pragma unroll
        for (int j = 0; j < 8; ++j) v[j] = ri == 0 ? fr_ * bre[j] - fi_ * bim[j] : fr_ * bim[j] + fi_ * bre[j];
        u32x4 o; o.x = f2bf(v[0]) | (f2bf(v[1]) << 16); o.y = f2bf(v[2]) | (f2bf(v[3]) << 16); o.z = f2bf(v[4]) | (f2bf(v[5]) << 16); o.w = f2bf(v[6]) | (f2bf(v[7]) << 16);
        BF[i] = o;
    }
    u32x4* CF = (u32x4*)(c.ws + WS_CF);
    for (int i = gt; i < DEPTH * 2 * 32 * 5 * 64; i += GT) {
        const int ln = i & 63, ks = (i >> 6) % 5, ldg = (i >> 6) / 5; const int j = ln & 15, q = ln >> 4; const int l = ldg >> 6, g = ldg & 31;
        const float* cre = a.in(16) + ((size_t)ldg * 16 + j) * 64; const float* cim = a.in(17) + ((size_t)ldg * 16 + j) * 64;
        float v[8];
#pragma unroll
        for (int e = 0; e < 8; ++e) { const int k = 32 * ks + 8 * q + e; float x;
            if (k < 128) { const int n = k >> 2, cm = k & 3; x = cm == 0 ? cre[n] : cm == 1 ? -cim[n] : cm == 2 ? cre[n + 32] : -cim[n + 32]; }
            else { const int jj = k - 128; x = (jj == j) ? a.in(18)[l * 512 + g * 16 + j] : 0.f; }
            v[e] = x; }
        u32x4 o; o.x = f2bf(v[0]) | (f2bf(v[1]) << 16); o.y = f2bf(v[2]) | (f2bf(v[3]) << 16); o.z = f2bf(v[4]) | (f2bf(v[5]) << 16); o.w = f2bf(v[6]) | (f2bf(v[7]) << 16);
        CF[i] = o;
    }
}

__device__ __forceinline__ void s3_tables(const Args& a, Ctx& c, const int wi, const int nw) {
    u32x4* TB = (u32x4*)(c.ws + WS_S3T);
    __syncthreads();
    LAS float* sC = (LAS float*)c.lds;
    LAS float* sB = sC + 2 * 16 * 65;
    LAS float* sA = sB + 2048;
    LAS float* sK = sA + 256;
    for (int ldg = wi; ldg < DEPTH * 2 * 32; ldg += nw) {
        const int l = ldg >> 6, dir = (ldg >> 5) & 1, g = ldg & 31;
        __syncthreads();
        for (int i = c.tid; i < 1024; i += NTHREADS) { const int o = i >> 6, n = i & 63; sC[o * 65 + n] = a.in(16)[(size_t)ldg * 1024 + i]; sC[16 * 65 + o * 65 + n] = a.in(17)[(size_t)ldg * 1024 + i]; }
        if (c.tid < 64) { float abr, abi, fr_, fi_; zoh(a, ldg * 64 + c.tid, abr, abi, fr_, fi_); sA[4 * c.tid] = abr; sA[4 * c.tid + 1] = abi; sA[4 * c.tid + 2] = fr_; sA[4 * c.tid + 3] = fi_; }
        __syncthreads();
        for (int i = c.tid; i < 1024; i += NTHREADS) { const int n = i >> 4; const float br = a.in(14)[(size_t)ldg * 1024 + i], bi = a.in(15)[(size_t)ldg * 1024 + i], fr_ = sA[4 * n + 2], fi_ = sA[4 * n + 3];
            sB[i] = fr_ * br - fi_ * bi; sB[1024 + i] = fr_ * bi + fi_ * br; }
        __syncthreads();
        for (int idx = c.tid; idx < 1024; idx += NTHREADS) { const int dd = idx >> 8, o = (idx >> 4) & 15, j = idx & 15; float acc = 0.f;
#pragma unroll 1
            for (int n0 = 0; n0 < 64; n0 += 8) {
                f32x4 ab[8]; float cr[8], ci[8], br[8], bi[8];
#pragma unroll
                for (int q = 0; q < 8; ++q) { const int n = n0 + q; ab[q] = *(const LAS f32x4*)(sA + 4 * n); cr[q] = sC[o * 65 + n]; ci[q] = sC[16 * 65 + o * 65 + n]; br[q] = sB[n * 16 + j]; bi[q] = sB[1024 + n * 16 + j]; }
                __builtin_amdgcn_sched_barrier(0);
#pragma unroll
                for (int q = 0; q < 8; ++q) { float pr = 1.f, pi = 0.f;
#pragma unroll
                    for (int e = 0; e < 3; ++e) if (e < dd) { const float t = pr * ab[q][0] - pi * ab[q][1], u = pr * ab[q][1] + pi * ab[q][0]; pr = t; pi = u; }
                    const float Gr = cr[q] * pr - ci[q] * pi, Gi = cr[q] * pi + ci[q] * pr; acc += Gr * br[q] - Gi * bi[q]; } }
            sK[idx] = acc; }
        __syncthreads();
        for (int en = c.tid; en < 40 * 64; en += NTHREADS) {
        const int ln = en & 63, f = en >> 6; const int col = ln & 31, kh = ln >> 5;
        float v[8];
#pragma unroll
        for (int j = 0; j < 8; ++j) v[j] = 0.f;
        if (f < 24) { const int ks = f / 6, nb = f % 6;
            if (nb < 4) { const int pst = (nb & 1) * 32 + col, comp = nb >> 1; const f32x4 ab = *(const LAS f32x4*)(sA + 4 * pst);
                const f32x4 br0 = *(const LAS f32x4*)(sB + pst * 16 + 8 * kh), br1 = *(const LAS f32x4*)(sB + pst * 16 + 8 * kh + 4), bi0 = *(const LAS f32x4*)(sB + 1024 + pst * 16 + 8 * kh), bi1 = *(const LAS f32x4*)(sB + 1024 + pst * 16 + 8 * kh + 4);
                float pr = 1.f, pi = 0.f; for (int e = 0; e < 3 - ks; ++e) { const float t = pr * ab[0] - pi * ab[1], u = pr * ab[1] + pi * ab[0]; pr = t; pi = u; }
#pragma unroll
                for (int j = 0; j < 4; ++j) { v[j] = comp == 0 ? pr * br0[j] - pi * bi0[j] : pr * bi0[j] + pi * br0[j]; v[4 + j] = comp == 0 ? pr * br1[j] - pi * bi1[j] : pr * bi1[j] + pi * br1[j]; }
            } else { const int sp = 2 * (nb - 4) + (col >> 4), o = col & 15, s1 = dir == 0 ? sp : 3 - sp;
                const int dd = s1 - ks;
                if (dd >= 0) { const f32x4 k0 = *(const LAS f32x4*)(sK + (dd * 16 + o) * 16 + 8 * kh), k1 = *(const LAS f32x4*)(sK + (dd * 16 + o) * 16 + 8 * kh + 4);
#pragma unroll
                    for (int j = 0; j < 4; ++j) { v[j] = k0[j]; v[4 + j] = k1[j]; } }
                if (dir == 0 && dd == 0) {
#pragma unroll
                    for (int j = 0; j < 8; ++j) if (8 * kh + j == o) v[j] += a.in(18)[l * 512 + g * 16 + o]; } }
        } else { const int kk = (f - 24) >> 1, nb = (f - 24) & 1; const int sp = 2 * nb + (col >> 4), o = col & 15, s1 = dir == 0 ? sp : 3 - sp;
            f32x4 ab[4]; float cr[4], ci[4];
#pragma unroll
            for (int q = 0; q < 4; ++q) { const int n = 8 * kk + 4 * kh + q; ab[q] = *(const LAS f32x4*)(sA + 4 * n); cr[q] = sC[o * 65 + n]; ci[q] = sC[16 * 65 + o * 65 + n]; }
            __builtin_amdgcn_sched_barrier(0);
#pragma unroll
            for (int q = 0; q < 4; ++q) { float pr = ab[q][0], pi = ab[q][1];
#pragma unroll
                for (int e = 0; e < 3; ++e) if (e < s1) { const float t = pr * ab[q][0] - pi * ab[q][1], u = pr * ab[q][1] + pi * ab[q][0]; pr = t; pi = u; }
                const float Gr = cr[q] * pr - ci[q] * pi, Gi = cr[q] * pi + ci[q] * pr; v[2 * q] = Gr; v[2 * q + 1] = -Gi; } }
        u32x4 o4; o4.x = f2bf(v[0]) | (f2bf(v[1]) << 16); o4.y = f2bf(v[2]) | (f2bf(v[3]) << 16); o4.z = f2bf(v[4]) | (f2bf(v[5]) << 16); o4.w = f2bf(v[6]) | (f2bf(v[7]) << 16);
        TB[(size_t)ldg * 2560 + en] = o4;
        }
    }
    __syncthreads();
}

template <class RowMap>
__device__ __forceinline__ void tr_item(const float* W, int ldn, int K, bf16_t* WT, const RowMap& rm, LAS bf16_t* scr, int kb, int nb, int lane) {
    const int k0 = 64 * kb, n0 = 64 * nb;
    f32x4 x[16];
#pragma unroll
    for (int i = 0; i < 16; ++i) x[i] = __builtin_nontemporal_load((const f32x4*)(W + (size_t)(k0 + 4 * i + (lane >> 4)) * ldn + n0 + (lane & 15) * 4));
#pragma unroll
    for (int i = 0; i < 16; ++i) { u32x2 w; w.x = pk2(x[i][0], x[i][1]); w.y = pk2(x[i][2], x[i][3]); *(LAS u32x2*)(scr + (4 * i + (lane >> 4)) * 72 + (lane & 15) * 4) = w; }
    LDS_WAIT(); asm volatile("" ::: "memory");
    const int cch = lane & 7;
#pragma unroll
    for (int j = 0; j < 8; ++j) { const int n = (lane >> 3) + 8 * j; const LAS bf16_t* sp = scr + (8 * cch) * 72 + n;
        u32x4 o; o.x = (unsigned)sp[0] | ((unsigned)sp[72] << 16); o.y = (unsigned)sp[2 * 72] | ((unsigned)sp[3 * 72] << 16); o.z = (unsigned)sp[4 * 72] | ((unsigned)sp[5 * 72] << 16); o.w = (unsigned)sp[6 * 72] | ((unsigned)sp[7 * 72] << 16);
        *(u32x4*)(WT + (size_t)rm(n0 + n) * K + k0 + 8 * cch) = o; }
    LDS_WAIT(); asm volatile("" ::: "memory");
}
struct RmId { int off; __device__ __forceinline__ int operator()(int n) const { return off + n; } };
struct RmW13 { int off; __device__ __forceinline__ int operator()(int n) const { return off + 256 * (n >> 7) + (n & 127); } };

__device__ __forceinline__ void norm_row(const Args& a, Ctx& c, int l, int row, int which  , f32x4 (&v)[4]) {
    float s = 0.f;
#pragma unroll
    for (int j = 0; j < 4; ++j) s += (v[j][0] * v[j][0] + v[j][1] * v[j][1]) + (v[j][2] * v[j][2] + v[j][3] * v[j][3]);
    const float rstd = 1.0f / sqrtf(wave_sum(s, c.lane) * (1.0f / D) + RMS_EPS);
    const float* gn = a.in(which ? 7 : 6) + (size_t)l * D; const float* md = (const float*)(c.ws + WS_MODS) + ((size_t)l * 9 + brow_of(row)) * NMOD + (which ? 3 * D : 0);
#pragma unroll
    for (int j = 0; j < 4; ++j) { const int col = 4 * c.lane + 256 * j; const f32x4 g = *(const f32x4*)(gn + col), sh = *(const f32x4*)(md + col), sc = *(const f32x4*)(md + D + col);
        v[j] = v[j] * rstd * g * (1.0f + sc) + sh; }
}
__device__ __forceinline__ void store_row_bf16(bf16_t* dst, int lane, const f32x4 (&v)[4]) {
#pragma unroll
    for (int j = 0; j < 4; ++j) { u32x2 w; w.x = pk2(v[j][0], v[j][1]); w.y = pk2(v[j][2], v[j][3]); *(u32x2*)(dst + 4 * lane + 256 * j) = w; }
}
__device__ __forceinline__ void load_x_row(const Args& a, Ctx& c, int l, int row, f32x4 (&v)[4]) {
    if (l == 0) { const float* xs = xrow_in(a, row); bf16_t* xb = (bf16_t*)(c.ws + WS_XB) + (size_t)row * D;
#pragma unroll
        for (int j = 0; j < 4; ++j) { v[j] = *(const f32x4*)(xs + 4 * c.lane + 256 * j); st_bf4(xb + 4 * c.lane + 256 * j, v[j]); }
    } else {
        bf16_t* xb = (bf16_t*)(c.ws + WS_XB) + (size_t)row * D;
        const bf16_t* sl = (const bf16_t*)(c.ws + WS_Z) + (size_t)row * 2 * D; const float* g2 = (const float*)(c.ws + WS_MODS) + ((size_t)(l - 1) * 9 + brow_of(row)) * NMOD + 5 * D;
#pragma unroll
        for (int j = 0; j < 4; ++j) { const int col = 4 * c.lane + 256 * j; const f32x4 g = *(const f32x4*)(g2 + col);
            v[j] = ld_bf4(xb + col) + g * (ld_bf4(sl + col) + ld_bf4(sl + D + col)); }
#pragma unroll
        for (int j = 0; j < 4; ++j) st_bf4(xb + 4 * c.lane + 256 * j, v[j]);
    }
}
constexpr int TR_I_IN = 16 * 48, TR_I_BS = 8 * 16, TR_I_OUT = 16 * 16, TR_I_GLU = 8 * 8, TR_I_W1 = 16 * 16 * 8, TR_I_W3 = TR_I_W1, TR_I_W2 = 16 * 8 * 16, TR_I_WC = 512;
constexpr int TR_NITEMS = TR_I_IN + TR_I_BS + TR_I_OUT + TR_I_GLU + TR_I_W1 + TR_I_W3 + TR_I_W2 + TR_I_WC;
struct RmGen { int off, w13; __device__ __forceinline__ int operator()(int n) const { return off + (w13 == 1 ? 256 * (n >> 7) + (n & 127) : (w13 == 2 && n >= 1024) ? 1024 + 256 * (((n - 1024) & 1023) >> 7) + 128 * ((n - 1024) >> 10) + (n & 127) : n); } };
__device__ __forceinline__ size_t wbuf_off(int l) { return (l & 1) ? WS_W2ND : WS_W; }
__device__ __forceinline__ void tr_one(const Args& a, Ctx& c, int l, int it, LAS bf16_t* scr) {
    bf16_t* WB = (bf16_t*)(c.ws + wbuf_off(l));
    int r = it;
    if (r < TR_NITEMS - TR_I_WC) {
        const float* src; int ldn, K, kb, nb; bf16_t* dst; RmGen rm{0, 0};
        if (r < TR_I_IN) { src = a.in(8) + (size_t)l * D * NZ; ldn = NZ; K = D; dst = WB + WO_WIN / 2; rm = RmGen{0, 2}; kb = r % 16; nb = r / 16; }
        else if ((r -= TR_I_IN) < TR_I_BS) { src = a.in(22) + (size_t)l * 512 * D; ldn = D; K = 512; dst = WB + WO_WBS / 2; kb = r % 8; nb = r / 8; }
        else if ((r -= TR_I_BS) < TR_I_OUT) { src = a.in(23) + (size_t)l * D * D; ldn = D; K = D; dst = WB + WO_WOUT / 2; kb = r % 16; nb = r / 16; }
        else if ((r -= TR_I_OUT) < TR_I_GLU) { src = a.in(19) + (size_t)l * 512 * 512; ldn = 512; K = 512; dst = WB + WO_GLU / 2; kb = r % 8; nb = r / 8; }
        else if ((r -= TR_I_GLU) < TR_I_W1) { const int e = r >> 7, q = r & 127; src = a.in(26) + ((size_t)l * NE + e) * D * DE; ldn = DE; K = D; dst = WB + WO_W13 / 2; rm = RmGen{e * 1024, 1}; kb = q % 16; nb = q / 16; }
        else if ((r -= TR_I_W1) < TR_I_W3) { const int e = r >> 7, q = r & 127; src = a.in(27) + ((size_t)l * NE + e) * D * DE; ldn = DE; K = D; dst = WB + WO_W13 / 2; rm = RmGen{e * 1024 + 128, 1}; kb = q % 16; nb = q / 16; }
        else { r -= TR_I_W3; const int e = r >> 7, q = r & 127; src = a.in(28) + ((size_t)l * NE + e) * DE * D; ldn = D; K = DE; dst = WB + WO_W2 / 2; rm = RmGen{e * 1024, 0}; kb = q % 8; nb = q / 8; }
        tr_item(src, ldn, K, dst, rm, scr, kb, nb, c.lane);
    } else {
        r -= TR_NITEMS - TR_I_WC;
        {
            const int g = r >> 7, cb = (r >> 4) & 7, db = r & 15, d = db * 64 + c.lane;
            const float* pw = a.in(9) + ((size_t)l * 4 + g) * 128 * 128 + (size_t)(cb * 16) * 128; const float* ps = a.in(10) + (size_t)l * 512 + g * 128;
            const float* wb = a.in(21) + ((size_t)l * 512 + g * 128) * D + d;
            LAS float* pl = (LAS float*)scr;
#pragma unroll
            for (int i = 0; i < 8; ++i) { const int e = i * 256 + c.lane * 4, q = e >> 7, c2 = e & 127; const f32x4 x = *(const f32x4*)(pw + e), sc4 = *(const f32x4*)(ps + c2);
                pl[(c2 + 0) * 16 + q] = x[0] * sc4[0]; pl[(c2 + 1) * 16 + q] = x[1] * sc4[1]; pl[(c2 + 2) * 16 + q] = x[2] * sc4[2]; pl[(c2 + 3) * 16 + q] = x[3] * sc4[3]; }
            LDS_WAIT(); asm volatile("" ::: "memory");
            float acc[16];
#pragma unroll
            for (int q = 0; q < 16; ++q) acc[q] = 0.f;
#pragma unroll 8
            for (int c2 = 0; c2 < 128; ++c2) { const float x = wb[(size_t)c2 * D]; const LAS f32x4* p4 = (const LAS f32x4*)(pl + c2 * 16);
#pragma unroll
                for (int q4 = 0; q4 < 4; ++q4) { const f32x4 w4 = p4[q4]; acc[q4 * 4 + 0] += w4[0] * x; acc[q4 * 4 + 1] += w4[1] * x; acc[q4 * 4 + 2] += w4[2] * x; acc[q4 * 4 + 3] += w4[3] * x; } }
            u32x4 o0, o1; o0.x = pk2(acc[0], acc[1]); o0.y = pk2(acc[2], acc[3]); o0.z = pk2(acc[4], acc[5]); o0.w = pk2(acc[6], acc[7]);
            o1.x = pk2(acc[8], acc[9]); o1.y = pk2(acc[10], acc[11]); o1.z = pk2(acc[12], acc[13]); o1.w = pk2(acc[14], acc[15]);
            bf16_t* dst = WB + WO_WC / 2 + (size_t)d * 512 + g * 128 + cb * 16; *(u32x4*)dst = o0; *(u32x4*)(dst + 8) = o1;
            LDS_WAIT(); asm volatile("" ::: "memory");
        }
    }
}
__device__ __forceinline__ void tr_range(const Args& a, Ctx& c, int l, int first, int last, int w, int nw) {
    LAS bf16_t* scr = (LAS bf16_t*)(c.lds + c.wave * 16384);
#pragma unroll 1
    for (int it = first + w; it < last; it += nw) tr_one(a, c, l, it, scr);
}
constexpr int TR_SPLIT = 3000, TR_SPLIT2 = 5500;
__device__ __forceinline__ void phase_a(const Args& a, Ctx& c, int l, const bool dummy = false) {
    const int gw = c.bid * NWAVES + c.wave, NGW = c.G * NWAVES;
    bf16_t* H = (bf16_t*)(c.ws + (dummy ? WS_HMID : WS_H)); bf16_t* XB = (bf16_t*)(c.ws + WS_XB); bf16_t* XBW = (bf16_t*)(c.ws + (dummy ? WS_HMID : WS_XB));
    const int rpb = (T + c.G - 1) / c.G, rbeg = c.bid * rpb + c.wave, rend = (c.bid + 1) * rpb < T ? (c.bid + 1) * rpb : T;
    f32x4 pg[4], psh[4], pg2[4]; int cur_b = -1; u32x2 nx[4], ns0[4], ns1[4];
    for (int row = rbeg; row < rend; row += NWAVES) {
        const int br = brow_of(row);
        if (br != cur_b) { cur_b = br;
            const float* gn = a.in(6) + (size_t)l * D; const float* md = (const float*)(c.ws + WS_MODS) + ((size_t)l * 9 + br) * NMOD;
            const float* g2 = (const float*)(c.ws + WS_MODS) + ((size_t)(l > 0 ? l - 1 : 0) * 9 + br) * NMOD + 5 * D;
#pragma unroll
            for (int j = 0; j < 4; ++j) { const int col = 4 * c.lane + 256 * j; pg[j] = *(const f32x4*)(gn + col) * (1.0f + *(const f32x4*)(md + D + col)); psh[j] = *(const f32x4*)(md + col); pg2[j] = *(const f32x4*)(g2 + col); } }
        f32x4 v[4];
        if (l == 0) { const float* xs = xrow_in(a, row);
#pragma unroll
            for (int j = 0; j < 4; ++j) v[j] = *(const f32x4*)(xs + 4 * c.lane + 256 * j);
        } else {
            if (row == rbeg) { const bf16_t* xb = XB + (size_t)row * D; const bf16_t* sl = (const bf16_t*)(c.ws + WS_Z) + (size_t)row * 2 * D;
#pragma unroll
                for (int j = 0; j < 4; ++j) { const int col = 4 * c.lane + 256 * j; nx[j] = *(const u32x2*)(xb + col); ns0[j] = *(const u32x2*)(sl + col); ns1[j] = *(const u32x2*)(sl + D + col); } }
            u32x2 cx[4], cs0[4], cs1[4];
#pragma unroll
            for (int j = 0; j < 4; ++j) { cx[j] = nx[j]; cs0[j] = ns0[j]; cs1[j] = ns1[j]; }
            if (row + NWAVES < rend) { const bf16_t* xb = XB + (size_t)(row + NWAVES) * D; const bf16_t* sl = (const bf16_t*)(c.ws + WS_Z) + (size_t)(row + NWAVES) * 2 * D;
#pragma unroll
                for (int j = 0; j < 4; ++j) { const int col = 4 * c.lane + 256 * j; nx[j] = *(const u32x2*)(xb + col); ns0[j] = *(const u32x2*)(sl + col); ns1[j] = *(const u32x2*)(sl + D + col); } }
#pragma unroll
            for (int j = 0; j < 4; ++j) { const f32x4 xv = {bflo(cx[j].x), bfhi(cx[j].x), bflo(cx[j].y), bfhi(cx[j].y)};
                const f32x4 y = {bflo(cs0[j].x) + bflo(cs1[j].x), bfhi(cs0[j].x) + bfhi(cs1[j].x), bflo(cs0[j].y) + bflo(cs1[j].y), bfhi(cs0[j].y) + bfhi(cs1[j].y)};
                v[j] = xv + pg2[j] * y; } }
        float ss = 0.f;
#pragma unroll
        for (int j = 0; j < 4; ++j) { st_bf4(XBW + (size_t)row * D + 4 * c.lane + 256 * j, v[j]); ss += (v[j][0] * v[j][0] + v[j][1] * v[j][1]) + (v[j][2] * v[j][2] + v[j][3] * v[j][3]); }
        const float rstd = 1.0f / sqrtf(wave_sum(ss, c.lane) * (1.0f / D) + RMS_EPS);
#pragma unroll
        for (int j = 0; j < 4; ++j) v[j] = v[j] * rstd * pg[j] + psh[j];
        store_row_bf16(H + (size_t)row * D, c.lane, v);
    }
}

__device__ __forceinline__ float fma_v(float a, float b, float c) { float d; asm("v_fma_f32 %0, %1, %2, %3" : "=v"(d) : "v"(a), "v"(b), "v"(c)); return d; }
__device__ __forceinline__ int tok_row(int b, int tc, int i) { return tc < 4 ? TL + b * CTXL + tc * 64 + i : b * SEQ + (tc - 4) * 64 + i; }
__device__ __forceinline__ int scan_chunk(int tc, int dir) { return dir == 0 ? tc : (tc < 4 ? 3 - tc : 71 - tc); }
__device__ __forceinline__ size_t car_idx(int b, int g, int dir, int cc, int n) { return ((((size_t)b * 32 + g) * 2 + dir) * NCH + cc) * 32 + n; }

#define S5_TILE(READ, dirv, tau)                                                                                                               \
    {                                                                                                                                          \
        const int r_ = lane & 31, sq_ = (r_ >> 2) & 1, stp_ = (r_ & 3) + 4 * (r_ >> 3);                                                        \
        const int ti_ = (dirv) == 0 ? 16 * (tau) + stp_ : 16 * (tau) + 15 - stp_;                                                              \
        const bf16x8 af_ = *(const bf16x8*)(Z + (size_t)tok_row(2 * bp + sq_, tc, ti_) * NZ + 512 + 16 * g + 8 * hh);                          \
        __builtin_amdgcn_sched_barrier(0);                                                                                                     \
        const f32x16 z16_ = {0.f, 0.f, 0.f, 0.f, 0.f, 0.f, 0.f, 0.f, 0.f, 0.f, 0.f, 0.f, 0.f, 0.f, 0.f, 0.f};                                  \
        f32x16 ur0_ = __builtin_amdgcn_mfma_f32_32x32x16_bf16(af_, bfr[0], z16_, 0, 0, 0);                                               \
        f32x16 ur1_ = __builtin_amdgcn_mfma_f32_32x32x16_bf16(af_, bfr[1], z16_, 0, 0, 0);                                               \
        f32x16 ui0_ = __builtin_amdgcn_mfma_f32_32x32x16_bf16(af_, bfr[2], z16_, 0, 0, 0);                                               \
        f32x16 ui1_ = __builtin_amdgcn_mfma_f32_32x32x16_bf16(af_, bfr[3], z16_, 0, 0, 0);                                                     \
        __builtin_amdgcn_sched_barrier(0);                                                                                                     \
        asm volatile("s_nop 15\n\ts_nop 15" : "+v"(ur0_), "+v"(ur1_), "+v"(ui0_), "+v"(ui1_) : "v"(af_), "v"(bfr[0]), "v"(bfr[1]), "v"(bfr[2]), "v"(bfr[3]));   \
        __builtin_amdgcn_sched_barrier(0);                                                                                                     \
        _Pragma("unroll") for (int i_ = 0; i_ < 16; ++i_) {                                                                                    \
              \
            const float n0_ = fma_v(ar0, hr0, fma_v(nai0, hi0, ur0_[i_])), m0_ = fma_v(ar0, hi0, fma_v(ai0, hr0, ui0_[i_]));                    \
            const float n1_ = fma_v(ar1, hr1, fma_v(nai1, hi1, ur1_[i_])), m1_ = fma_v(ar1, hi1, fma_v(ai1, hr1, ui1_[i_]));                    \
            hr0 = n0_; hi0 = m0_; hr1 = n1_; hi1 = m1_;                                                                                        \
            if (READ) { u32x2 w_; w_.x = pk2(hr0, hi0); w_.y = pk2(hr1, hi1); *(LAS u32x2*)(img + (hh * 16 + i_) * IMG_STRIDE + (lane & 31) * 8) = w_; } \
        }                                                                                                                                      \
        if (READ && (dirv) == 0) *(LAS bf16x8*)(img + (sq_ * 16 + stp_) * IMG_STRIDE + 256 + hh * 16) = af_;                                   \
    }

#define S5_TILEP(READ, dirv, tau, afv)                                                                                                               \
    {                                                                                                                                          \
        const int r_ = lane & 31, sq_ = (r_ >> 2) & 1, stp_ = (r_ & 3) + 4 * (r_ >> 3);                                                        \
        const int ti_ = (dirv) == 0 ? 16 * (tau) + stp_ : 16 * (tau) + 15 - stp_;                                                              \
        const bf16x8 af_ = (afv);                          \
        __builtin_amdgcn_sched_barrier(0);                                                                                                     \
        const f32x16 z16_ = {0.f, 0.f, 0.f, 0.f, 0.f, 0.f, 0.f, 0.f, 0.f, 0.f, 0.f, 0.f, 0.f, 0.f, 0.f, 0.f};                                  \
        f32x16 ur0_ = __builtin_amdgcn_mfma_f32_32x32x16_bf16(af_, bfr[0], z16_, 0, 0, 0);                                               \
        f32x16 ur1_ = __builtin_amdgcn_mfma_f32_32x32x16_bf16(af_, bfr[1], z16_, 0, 0, 0);                                               \
        f32x16 ui0_ = __builtin_amdgcn_mfma_f32_32x32x16_bf16(af_, bfr[2], z16_, 0, 0, 0);                                               \
        f32x16 ui1_ = __builtin_amdgcn_mfma_f32_32x32x16_bf16(af_, bfr[3], z16_, 0, 0, 0);                                                     \
        __builtin_amdgcn_sched_barrier(0);                                                                                                     \
        asm volatile("s_nop 15\n\ts_nop 15" : "+v"(ur0_), "+v"(ur1_), "+v"(ui0_), "+v"(ui1_) : "v"(af_), "v"(bfr[0]), "v"(bfr[1]), "v"(bfr[2]), "v"(bfr[3]));   \
        __builtin_amdgcn_sched_barrier(0);                                                                                                     \
        _Pragma("unroll") for (int i_ = 0; i_ < 16; ++i_) {                                                                                    \
              \
            const float n0_ = fma_v(ar0, hr0, fma_v(nai0, hi0, ur0_[i_])), m0_ = fma_v(ar0, hi0, fma_v(ai0, hr0, ui0_[i_]));                    \
            const float n1_ = fma_v(ar1, hr1, fma_v(nai1, hi1, ur1_[i_])), m1_ = fma_v(ar1, hi1, fma_v(ai1, hr1, ui1_[i_]));                    \
            hr0 = n0_; hi0 = m0_; hr1 = n1_; hi1 = m1_;                                                                                        \
            if (READ) { u32x2 w_; w_.x = pk2(hr0, hi0); w_.y = pk2(hr1, hi1); *(LAS u32x2*)(img + (hh * 16 + i_) * IMG_STRIDE + (lane & 31) * 8) = w_; } \
        }                                                                                                                                      \
        if (READ && (dirv) == 0) *(LAS bf16x8*)(img + (sq_ * 16 + stp_) * IMG_STRIDE + 256 + hh * 16) = af_;                                   \
    }

__device__ __forceinline__ bf16x8 s5_afrag(const bf16_t* Z, int bp, int tc, int g, int dir, int tau, int lane) {
    const int r = lane & 31, sq = (r >> 2) & 1, stp = (r & 3) + 4 * (r >> 3), hh = lane >> 5;
    const int ti = dir == 0 ? 16 * tau + stp : 16 * tau + 15 - stp;
    return *(const bf16x8*)(Z + ((size_t)g * T + tok_row(2 * bp + sq, tc, ti)) * 16 + 8 * hh);
}
__device__ __forceinline__ bf16x8 s1_afrag(const bf16_t* Z, int bp, int tc, int g, int dir, int ks, int lane) {
    const int r = lane & 31, sq = (r >> 2) & 1, b4 = (r & 3) + 4 * (r >> 3), hh = lane >> 5;
    const int sg = 4 * b4 + ks, ti = dir == 0 ? sg : 63 - sg;
    return *(const bf16x8*)(Z + ((size_t)g * T + tok_row(2 * bp + sq, tc, ti)) * 16 + 8 * hh);
}
__device__ __forceinline__ void phase_s1(const Args& a, Ctx& c, int l, size_t dst_off = WS_CAR) {
    const bf16_t* Z = (const bf16_t*)(c.ws + WS_U); f32x4* CAR = (f32x4*)(c.ws + dst_off);
    const f32x2* AB = (const f32x2*)(c.ws + WS_AB); const bf16x8* BF = (const bf16x8*)(c.ws + WS_BF);
    const int lane = c.lane, hh = lane >> 5;
    constexpr int NT1 = 4 * NCH * 8;
    const int dir = c.wave & 1;
    int cur_ldg = -1; float qr0 = 0.f, qi0 = 0.f, qr1 = 0.f, qi1 = 0.f, nqi0 = 0.f, nqi1 = 0.f; bf16x8 W[4][4], afc[4], afn[4];
#pragma unroll
    for (int f = 0; f < 4; ++f) { afc[f] = (bf16x8){0, 0, 0, 0, 0, 0, 0, 0}; afn[f] = afc[f];
#pragma unroll
        for (int k = 0; k < 4; ++k) W[k][f] = afc[f]; }
    if (c.bid < NT1) { const int bt = c.bid, rest = bt >> 3, tc = rest % NCH, bp = rest / NCH, g = (bt & 7) * 4 + (c.wave >> 1);
#pragma unroll
        for (int ks = 0; ks < 4; ++ks) afc[ks] = s1_afrag(Z, bp, tc, g, dir, ks, lane); }
    for (int bt = c.bid; bt < NT1; bt += c.G) {
        const int gq = bt & 7, rest = bt >> 3, tc = rest % NCH, bp = rest / NCH; const int g = gq * 4 + (c.wave >> 1);
        const int ldg = (l * 2 + dir) * 32 + g;
        if (ldg != cur_ldg) { cur_ldg = ldg;
            const f32x2 a0 = AB[ldg * 64 + (lane & 31)], a1 = AB[ldg * 64 + 32 + (lane & 31)];
            u32x4 bw[4];
#pragma unroll
            for (int f = 0; f < 4; ++f) bw[f] = __builtin_bit_cast(u32x4, BF[(ldg * 4 + f) * 64 + lane]);
            f32x4 br0a, br0b, br1a, br1b, bi0a, bi0b, bi1a, bi1b; pg8::unpack8(bw[0], br0a, br0b); pg8::unpack8(bw[1], br1a, br1b); pg8::unpack8(bw[2], bi0a, bi0b); pg8::unpack8(bw[3], bi1a, bi1b);
            float pr0 = 1.f, pi0 = 0.f, pr1 = 1.f, pi1 = 0.f;
#pragma unroll
            for (int ks = 3; ks >= 0; --ks) {
                W[ks][0] = __builtin_bit_cast(bf16x8, pg8::pack8(br0a * pr0 - bi0a * pi0, br0b * pr0 - bi0b * pi0));
                W[ks][1] = __builtin_bit_cast(bf16x8, pg8::pack8(br1a * pr1 - bi1a * pi1, br1b * pr1 - bi1b * pi1));
                W[ks][2] = __builtin_bit_cast(bf16x8, pg8::pack8(bi0a * pr0 + br0a * pi0, bi0b * pr0 + br0b * pi0));
                W[ks][3] = __builtin_bit_cast(bf16x8, pg8::pack8(bi1a * pr1 + br1a * pi1, bi1b * pr1 + br1b * pi1));
                const float t0 = pr0 * a0.x - pi0 * a0.y, u0 = pr0 * a0.y + pi0 * a0.x, t1 = pr1 * a1.x - pi1 * a1.y, u1 = pr1 * a1.y + pi1 * a1.x; pr0 = t0; pi0 = u0; pr1 = t1; pi1 = u1; }
            qr0 = pr0; qi0 = pi0; nqi0 = -pi0; qr1 = pr1; qi1 = pi1; nqi1 = -pi1; }
        const int nb = bt + c.G;
        if (nb < NT1) { const int nrest = nb >> 3, ntc = nrest % NCH, nbp = nrest / NCH, ng = (nb & 7) * 4 + (c.wave >> 1);
#pragma unroll
            for (int ks = 0; ks < 4; ++ks) afn[ks] = s1_afrag(Z, nbp, ntc, ng, dir, ks, lane); }
        const f32x16 z16 = {0.f, 0.f, 0.f, 0.f, 0.f, 0.f, 0.f, 0.f, 0.f, 0.f, 0.f, 0.f, 0.f, 0.f, 0.f, 0.f};
        f32x16 cr0 = z16, cr1 = z16, ci0 = z16, ci1 = z16;
        __builtin_amdgcn_sched_barrier(0);
#pragma unroll
        for (int ks = 0; ks < 4; ++ks) {
            cr0 = __builtin_amdgcn_mfma_f32_32x32x16_bf16(afc[ks], W[ks][0], cr0, 0, 0, 0);
            cr1 = __builtin_amdgcn_mfma_f32_32x32x16_bf16(afc[ks], W[ks][1], cr1, 0, 0, 0);
            ci0 = __builtin_amdgcn_mfma_f32_32x32x16_bf16(afc[ks], W[ks][2], ci0, 0, 0, 0);
            ci1 = __builtin_amdgcn_mfma_f32_32x32x16_bf16(afc[ks], W[ks][3], ci1, 0, 0, 0); }
        __builtin_amdgcn_sched_barrier(0);
        asm volatile("s_nop 15\n\ts_nop 15" : "+v"(cr0), "+v"(cr1), "+v"(ci0), "+v"(ci1) : "v"(afc[0]), "v"(afc[1]), "v"(afc[2]), "v"(afc[3]));
        __builtin_amdgcn_sched_barrier(0);
        float hr0 = 0.f, hi0 = 0.f, hr1 = 0.f, hi1 = 0.f;
#pragma unroll
        for (int i = 0; i < 16; ++i) {
            const float n0 = fma_v(qr0, hr0, fma_v(nqi0, hi0, cr0[i])), m0 = fma_v(qr0, hi0, fma_v(qi0, hr0, ci0[i]));
            const float n1 = fma_v(qr1, hr1, fma_v(nqi1, hi1, cr1[i])), m1 = fma_v(qr1, hi1, fma_v(qi1, hr1, ci1[i]));
            hr0 = n0; hi0 = m0; hr1 = n1; hi1 = m1; }
#pragma unroll
        for (int ks = 0; ks < 4; ++ks) afc[ks] = afn[ks];
        CAR[car_idx(2 * bp + hh, g, dir, scan_chunk(tc, dir), lane & 31)] = (f32x4){hr0, hi0, hr1, hi1};
    }
}
__device__ __forceinline__ void phase_s2(const Args& a, Ctx& c, int l) {
    if (c.tid >= 128) return;
    for (int gid = c.bid * 128 + c.tid; gid < NB * 32 * 2 * 32 * 2; gid += c.G * 128) {
    const int tile = gid & 1, n = (gid >> 1) & 31, dir = (gid >> 6) & 1, g = (gid >> 7) & 31, b = gid >> 12;
    const f32x2* AB = (const f32x2*)(c.ws + WS_AB); const f32x2* __restrict__ E = (const f32x2*)(c.ws + WS_CAR); f32x2* __restrict__ HIN = (f32x2*)(c.ws + WS_CAR2);
    f32x2 p = AB[((l * 2 + dir) * 32 + g) * 64 + tile * 32 + n];
#pragma unroll
    for (int s = 0; s < 6; ++s) { const float pr = p.x * p.x - p.y * p.y, pi = 2.0f * p.x * p.y; p.x = pr; p.y = pi; }
    float hr = 0.f, hi = 0.f; const size_t base = car_idx(b, g, dir, 0, n) * 2 + tile;
#pragma unroll 1
    for (int c0 = 0; c0 < NCH; c0 += 17) {
        f32x2 e[17];
#pragma unroll
        for (int k = 0; k < 17; ++k) e[k] = E[base + (size_t)(c0 + k) * 64];
#pragma unroll
        for (int k = 0; k < 17; ++k) { HIN[base + (size_t)(c0 + k) * 64] = (f32x2){hr, hi};
            const float nr = p.x * hr - p.y * hi + e[k].x, ni = p.x * hi + p.y * hr + e[k].y; hr = nr; hi = ni; }
    }
    }
}
__device__ __forceinline__ bf16x8 s3_afrag(const bf16_t* Z, int bp, int tc, int g, int dir, int ks, int lane) {
    const int r = lane & 31, sq = (r >> 2) & 1, i = (r & 3) + 4 * (r >> 3), hh = lane >> 5;
    const int ti = dir == 0 ? 4 * i + ks : 4 * i + 3 - ks;
    return *(const bf16x8*)(Z + ((size_t)g * T + tok_row(2 * bp + sq, tc, ti)) * 16 + 8 * hh);
}
constexpr int S3_IMG = 272;
__device__ __forceinline__ constexpr int s3_skip(int dir, int f) { return f == (dir == 0 ? 16 : 17) || f == (dir == 0 ? 22 : 23); }
__device__ __forceinline__ constexpr int s3_pidx(int dir, int f) { return f - (f > (dir == 0 ? 16 : 17) ? 1 : 0) - (f > (dir == 0 ? 22 : 23) ? 1 : 0); }
constexpr int S3_TB = 38 * 1024;
__device__ __forceinline__ void phase_s3(const Args& a, Ctx& c, int l) {
    const bf16_t* Z = (const bf16_t*)(c.ws + WS_U); const f32x4* CAR = (const f32x4*)(c.ws + WS_CAR2); bf16_t* YG = (bf16_t*)(c.ws + WS_YG);
    const f32x2* AB = (const f32x2*)(c.ws + WS_AB); const u32x4* TB = (const u32x4*)(c.ws + WS_S3T);
    const int lane = c.lane, hh = lane >> 5, col = lane & 31;
    LAS unsigned char* tbl = c.lds;
    LAS unsigned char* img = c.lds + (c.wave < 6 ? 2 * S3_TB + c.wave * (32 * S3_IMG) : c.wave == 6 ? MISC_OFF + 1024 : LDS_BYTES - 16384);
    const int tc0 = (l == DEPTH - 1) ? 4 : 0, ntc = NCH - tc0, ncombo = 4 * ntc, ngrp = (ncombo + 7) >> 3;
    int cur_g = -1;
    const f32x16 z16 = {0.f, 0.f, 0.f, 0.f, 0.f, 0.f, 0.f, 0.f, 0.f, 0.f, 0.f, 0.f, 0.f, 0.f, 0.f, 0.f};
    float qq[2][6];
    bf16x8 af[2][4]; f32x4 hc[2];
#pragma unroll
    for (int d = 0; d < 2; ++d) { hc[d] = (f32x4){0.f, 0.f, 0.f, 0.f};
#pragma unroll
        for (int k = 0; k < 6; ++k) qq[d][k] = 0.f;
#pragma unroll
        for (int ks = 0; ks < 4; ++ks) af[d][ks] = (bf16x8){0, 0, 0, 0, 0, 0, 0, 0}; }
    const bool worker = true;
    for (int wt = c.bid; wt < 32 * ngrp; wt += c.G) {
        const int g = ((wt >> 3) & 3) | ((wt & 7) << 2), grp = wt >> 5;
        if (g != cur_g) { cur_g = g; __syncthreads();
            for (int i = c.tid; i < 2 * 40 * 64; i += NTHREADS) { const int d = i / 2560, r = i - d * 2560, f = r >> 6; if (!s3_skip(d, f)) *(LAS u32x4*)(tbl + d * S3_TB + (s3_pidx(d, f) * 64 + (r & 63)) * 16) = TB[(size_t)((l * 2 + d) * 32 + g) * 2560 + r]; }
#pragma unroll
            for (int d = 0; d < 2; ++d) { const int ldg = (l * 2 + d) * 32 + g; const f32x2 a0 = AB[ldg * 64 + col], a1 = AB[ldg * 64 + 32 + col];
                const float s0r = a0.x * a0.x - a0.y * a0.y, s0i = 2.0f * a0.x * a0.y, s1r = a1.x * a1.x - a1.y * a1.y, s1i = 2.0f * a1.x * a1.y;
                qq[d][0] = s0r * s0r - s0i * s0i; qq[d][1] = 2.0f * s0r * s0i; qq[d][2] = -qq[d][1]; qq[d][3] = s1r * s1r - s1i * s1i; qq[d][4] = 2.0f * s1r * s1i; qq[d][5] = -qq[d][4]; }
            __syncthreads(); }
        const int combo = grp * 8 + c.wave;
        if (worker && combo < ncombo) {
            const int tc = tc0 + combo % ntc, bp = combo / ntc;
#pragma unroll
            for (int d = 0; d < 2; ++d) hc[d] = CAR[car_idx(2 * bp + hh, g, d, scan_chunk(tc, d), col)];
#pragma unroll
            for (int ks = 0; ks < 4; ++ks) af[0][ks] = s3_afrag(Z, bp, tc, g, 0, ks, lane);
            f32x16 y0 = z16, y1 = z16;
            asm volatile("" : "+v"(y0), "+v"(y1));
#pragma unroll
            for (int dir = 0; dir < 2; ++dir) {
                const LAS unsigned char* tb = tbl + dir * S3_TB + lane * 16;
                if (dir == 1) {
#pragma unroll
                    for (int ks = 0; ks < 4; ++ks) af[0][ks] = af[1][ks]; }
                const f32x4 h0 = hc[dir];
                f32x16 cr0 = z16, cr1 = z16, ci0 = z16, ci1 = z16;
                asm volatile("" : "+v"(cr0), "+v"(cr1), "+v"(ci0), "+v"(ci1));
                __builtin_amdgcn_sched_barrier(0);
                {
                    bf16x8 bq[2][6];
#pragma unroll
                    for (int nb = 0; nb < 6; ++nb) bq[0][nb] = *(const LAS bf16x8*)(tb + s3_pidx(dir, nb) * 1024);
#pragma unroll
                    for (int ks = 0; ks < 4; ++ks) {
                        if (ks < 3) {
#pragma unroll
                            for (int nb = 0; nb < 6; ++nb) if (!s3_skip(dir, (ks + 1) * 6 + nb)) bq[(ks + 1) & 1][nb] = *(const LAS bf16x8*)(tb + s3_pidx(dir, (ks + 1) * 6 + nb) * 1024); }
                        __builtin_amdgcn_sched_barrier(0);
                        cr0 = __builtin_amdgcn_mfma_f32_32x32x16_bf16(af[0][ks], bq[ks & 1][0], cr0, 0, 0, 0); cr1 = __builtin_amdgcn_mfma_f32_32x32x16_bf16(af[0][ks], bq[ks & 1][1], cr1, 0, 0, 0);
                        ci0 = __builtin_amdgcn_mfma_f32_32x32x16_bf16(af[0][ks], bq[ks & 1][2], ci0, 0, 0, 0); ci1 = __builtin_amdgcn_mfma_f32_32x32x16_bf16(af[0][ks], bq[ks & 1][3], ci1, 0, 0, 0);
                        if (!s3_skip(dir, ks * 6 + 4)) y0 = __builtin_amdgcn_mfma_f32_32x32x16_bf16(af[0][ks], bq[ks & 1][4], y0, 0, 0, 0);
                        if (!s3_skip(dir, ks * 6 + 5)) y1 = __builtin_amdgcn_mfma_f32_32x32x16_bf16(af[0][ks], bq[ks & 1][5], y1, 0, 0, 0);
                        __builtin_amdgcn_sched_barrier(0); } }
                __builtin_amdgcn_sched_barrier(0);
                asm volatile("s_nop 15\n\ts_nop 15" : "+v"(cr0), "+v"(cr1), "+v"(ci0), "+v"(ci1) : "v"(af[0][0]), "v"(af[0][1]), "v"(af[0][2]), "v"(af[0][3]));
                __builtin_amdgcn_sched_barrier(0);
                if (dir == 0) {
#pragma unroll
                    for (int ks = 0; ks < 4; ++ks) af[1][ks] = s3_afrag(Z, bp, tc, g, 1, ks, lane); }
                const float q0r = qq[dir][0], q0i = qq[dir][1], nq0i = qq[dir][2], q1r = qq[dir][3], q1i = qq[dir][4], nq1i = qq[dir][5];
                float hr0 = h0[0], hi0 = h0[1], hr1 = h0[2], hi1 = h0[3];
#pragma unroll
                for (int be = 0; be < 16; ++be) { const int i = dir == 0 ? be : 15 - be; const int rho = (i & 3) + 4 * hh + 8 * (i >> 2);
                    *(LAS unsigned*)(img + rho * S3_IMG + 4 * col) = pk2(hr0, hi0); *(LAS unsigned*)(img + rho * S3_IMG + 128 + 4 * col) = pk2(hr1, hi1);
                    const float n0 = fma_v(q0r, hr0, fma_v(nq0i, hi0, cr0[i])), m0 = fma_v(q0r, hi0, fma_v(q0i, hr0, ci0[i]));
                    const float n1 = fma_v(q1r, hr1, fma_v(nq1i, hi1, cr1[i])), m1 = fma_v(q1r, hi1, fma_v(q1i, hr1, ci1[i]));
                    hr0 = n0; hi0 = m0; hr1 = n1; hi1 = m1; }
                asm volatile("" ::: "memory");
                {
                    bf16x8 hq[2][2][3];
#pragma unroll
                    for (int e = 0; e < 2; ++e) { hq[0][e][0] = *(const LAS bf16x8*)(img + col * S3_IMG + 32 * e + 16 * hh); hq[0][e][1] = *(const LAS bf16x8*)(tb + (22 + 2 * e) * 1024); hq[0][e][2] = *(const LAS bf16x8*)(tb + (23 + 2 * e) * 1024); }
#pragma unroll
                    for (int k2 = 0; k2 < 4; ++k2) {
                        if (k2 < 3) {
#pragma unroll
                            for (int e = 0; e < 2; ++e) { const int kk = 2 * (k2 + 1) + e; hq[(k2 + 1) & 1][e][0] = *(const LAS bf16x8*)(img + col * S3_IMG + 32 * kk + 16 * hh);
                                hq[(k2 + 1) & 1][e][1] = *(const LAS bf16x8*)(tb + (22 + 2 * kk) * 1024); hq[(k2 + 1) & 1][e][2] = *(const LAS bf16x8*)(tb + (23 + 2 * kk) * 1024); } }
                        __builtin_amdgcn_sched_barrier(0);
#pragma unroll
                        for (int e = 0; e < 2; ++e) { y0 = __builtin_amdgcn_mfma_f32_32x32x16_bf16(hq[k2 & 1][e][0], hq[k2 & 1][e][1], y0, 0, 0, 0); y1 = __builtin_amdgcn_mfma_f32_32x32x16_bf16(hq[k2 & 1][e][0], hq[k2 & 1][e][2], y1, 0, 0, 0); }
                        __builtin_amdgcn_sched_barrier(0); } }
                asm volatile("" ::: "memory");
            }
            __builtin_amdgcn_sched_barrier(0);
            asm volatile("s_nop 15\n\ts_nop 15" : "+v"(y0), "+v"(y1));
            __builtin_amdgcn_sched_barrier(0);
#pragma unroll
            for (int nb = 0; nb < 2; ++nb)
#pragma unroll
                for (int i = 0; i < 16; ++i) { const float v = gelu_t(nb == 0 ? y0[i] : y1[i]);
                    const int tok = 4 * i + 2 * nb + (col >> 4);
                    *(LAS bf16_t*)(img + ((hh * 64 + tok) * 16 + (col & 15)) * 2) = (bf16_t)(pk2(v, v) & 0xffffu); }
            asm volatile("" ::: "memory");
#pragma unroll
            for (int k = 0; k < 4; ++k) { const int chunk = lane + 64 * k, row = chunk >> 1, half = chunk & 1;
                const u32x4 w = *(const LAS u32x4*)(img + chunk * 16);
                *(u32x4*)(YG + ((size_t)g * T + tok_row(2 * bp + (row >> 6), tc, row & 63)) * 16 + 8 * half) = w; }
            asm volatile("" ::: "memory");
        }
    }
    __syncthreads();
}

__device__ __forceinline__ void acc8(float (&s)[8], u32x4 w) { s[0] += bflo(w.x); s[1] += bfhi(w.x); s[2] += bflo(w.y); s[3] += bfhi(w.y); s[4] += bflo(w.z); s[5] += bfhi(w.z); s[6] += bflo(w.w); s[7] += bfhi(w.w); }
__device__ __forceinline__ void sub8(float (&s)[8], u32x4 w) { s[0] -= bflo(w.x); s[1] -= bfhi(w.x); s[2] -= bflo(w.y); s[3] -= bfhi(w.y); s[4] -= bflo(w.z); s[5] -= bfhi(w.z); s[6] -= bflo(w.w); s[7] -= bfhi(w.w); }
constexpr int POOL_TASKS = NB * 8 * 4 * 2;
constexpr int PV_CSTR = 144, PV_RSTR = 64 * PV_CSTR;
__device__ __forceinline__ void phase_pool(Ctx& c, const int wi, const int nw, const int t0, const int t1, const bool ctx) {
    const bf16_t* Z = (const bf16_t*)(c.ws + WS_Z); bf16_t* PD = (bf16_t*)(c.ws + WS_H);
    LAS unsigned char* V = c.lds;
    __syncthreads();
    for (int task = t0 + wi; task < t1; task += nw) {
        const int half = task & 1, g = (task >> 1) & 3, band = (task >> 3) & 7, b = task >> 6, hw = 1 << g, r0 = band * 8;
        const int ck = c.tid & 7, chn = 128 * g + 64 * half + 8 * ck;
        {
            const int cc = c.tid >> 3; const bf16_t* base = Z + (size_t)(b * SEQ + cc) * NZ + chn; const size_t rstep = (size_t)64 * NZ;
            float sm[8];
#pragma unroll
            for (int j = 0; j < 8; ++j) sm[j] = 0.f;
            const int lo0 = r0 - hw < 0 ? 0 : r0 - hw, hi0 = r0 + hw > 64 ? 64 : r0 + hw;
            const u32x4 zz = {0u, 0u, 0u, 0u};
            u32x4 wi[16], wa[7], wb[7];
#pragma unroll
            for (int j = 0; j < 16; ++j) { const int rr = lo0 + j < hi0 ? lo0 + j : hi0 - 1; wi[j] = *(const u32x4*)(base + (size_t)rr * rstep); }
#pragma unroll
            for (int i = 1; i < 8; ++i) { const int ra = r0 + i + hw - 1 < 64 ? r0 + i + hw - 1 : 63, rs = r0 + i - hw - 1 >= 0 ? r0 + i - hw - 1 : 0;
                wa[i - 1] = *(const u32x4*)(base + (size_t)ra * rstep); wb[i - 1] = *(const u32x4*)(base + (size_t)rs * rstep); }
            __builtin_amdgcn_sched_barrier(0);
#pragma unroll
            for (int j = 0; j < 16; ++j) acc8(sm, lo0 + j < hi0 ? wi[j] : zz);
#pragma unroll
            for (int i = 0; i < 8; ++i) { const int r = r0 + i;
                if (i > 0) { acc8(sm, r + hw - 1 < 64 ? wa[i - 1] : zz); sub8(sm, r - hw - 1 >= 0 ? wb[i - 1] : zz); }
                const int lo = r - hw < 0 ? 0 : r - hw, hi = r + hw > 64 ? 64 : r + hw; const float inv = 1.0f / (float)(hi - lo);
                u32x4 o; o.x = pk2(sm[0] * inv, sm[1] * inv); o.y = pk2(sm[2] * inv, sm[3] * inv); o.z = pk2(sm[4] * inv, sm[5] * inv); o.w = pk2(sm[6] * inv, sm[7] * inv);
                *(LAS u32x4*)(V + i * PV_RSTR + cc * PV_CSTR + ck * 16) = o; }
        }
        __syncthreads();
        {
            const int cseg = (c.tid >> 3) & 7, i = c.tid >> 6, c0 = cseg * 8, r = r0 + i; const LAS unsigned char* vrow = V + i * PV_RSTR + ck * 16;
            float sm[8];
#pragma unroll
            for (int j = 0; j < 8; ++j) sm[j] = 0.f;
            const int lo0 = c0 - hw < 0 ? 0 : c0 - hw, hi0 = c0 + hw > 64 ? 64 : c0 + hw;
            for (int cc = lo0; cc < hi0; ++cc) acc8(sm, *(const LAS u32x4*)(vrow + cc * PV_CSTR));
            const size_t tok0 = (size_t)b * SEQ + r * 64 + c0;
            u32x4 vv[8];
#pragma unroll
            for (int st = 0; st < 8; ++st) vv[st] = *(const u32x4*)(Z + (tok0 + st) * NZ + chn);
#pragma unroll
            for (int st = 0; st < 8; ++st) { const int cc = c0 + st;
                if (st > 0) { if (cc + hw - 1 < 64) acc8(sm, *(const LAS u32x4*)(vrow + (cc + hw - 1) * PV_CSTR)); if (cc - hw - 1 >= 0) sub8(sm, *(const LAS u32x4*)(vrow + (cc - hw - 1) * PV_CSTR)); }
                const int lo = cc - hw < 0 ? 0 : cc - hw, hi = cc + hw > 64 ? 64 : cc + hw; const float inv = 1.0f / (float)(hi - lo); const u32x4 v0 = vv[st];
                u32x4 o; o.x = pk2(sm[0] * inv - bflo(v0.x), sm[1] * inv - bfhi(v0.x)); o.y = pk2(sm[2] * inv - bflo(v0.y), sm[3] * inv - bfhi(v0.y));
                o.z = pk2(sm[4] * inv - bflo(v0.z), sm[5] * inv - bfhi(v0.z)); o.w = pk2(sm[6] * inv - bflo(v0.w), sm[7] * inv - bfhi(v0.w));
                *(u32x4*)(PD + (tok0 + st) * 512 + chn) = o; }
        }
        __syncthreads();
    }
    if (!ctx) return;
    const int gw = wi * NWAVES + c.wave, NGW = nw * NWAVES;
    for (int it = gw; it < (TC / 4) * 4; it += NGW) {
        const int g = it & 3, row = TL + (it >> 2) * 4 + (c.lane >> 4), ck = c.lane & 15, w = 2 << g;
        const int pos = (row - TL) & 255, n = 256;
        const bf16_t* src = Z + (size_t)(row - pos) * NZ + 128 * g + 8 * ck;
        const int lo = pos - w / 2 < 0 ? 0 : pos - w / 2, hi = pos + w / 2 > n ? n : pos + w / 2;
        float sm[8];
#pragma unroll
        for (int j = 0; j < 8; ++j) sm[j] = 0.f;
        { const u32x4 zz = {0u, 0u, 0u, 0u}; u32x4 wv[16];
#pragma unroll
            for (int k = 0; k < 16; ++k) { const int p = pos - w / 2 + k; const int pc = p < 0 ? 0 : (p > n - 1 ? n - 1 : p); wv[k] = *(const u32x4*)(src + (size_t)pc * NZ); }
            __builtin_amdgcn_sched_barrier(0);
#pragma unroll
            for (int k = 0; k < 16; ++k) { const int p = pos - w / 2 + k; acc8(sm, (k < w && p >= 0 && p < n) ? wv[k] : zz); } }
        const float inv = 1.0f / (float)(hi - lo);
        const u32x4 vv = *(const u32x4*)(Z + (size_t)row * NZ + 128 * g + 8 * ck);
        u32x4 o; o.x = pk2(sm[0] * inv - bflo(vv.x), sm[1] * inv - bfhi(vv.x)); o.y = pk2(sm[2] * inv - bflo(vv.y), sm[3] * inv - bfhi(vv.y));
        o.z = pk2(sm[4] * inv - bflo(vv.z), sm[5] * inv - bfhi(vv.z)); o.w = pk2(sm[6] * inv - bflo(vv.w), sm[7] * inv - bfhi(vv.w));
        *(u32x4*)(PD + (size_t)row * 512 + 128 * g + 8 * ck) = o;
    }
}

__device__ __forceinline__ void phase_i(const Args& a, Ctx& c, int l, const bool dummy = false) {
    LAS u32x4* bh = (LAS u32x4*)c.lds; LAS u32x4* bl = bh + 2048;
    for (int i = c.tid; i < 2048; i += NTHREADS) { const int st = i >> 6, ln = i & 63, n = ln & 15, q = ln >> 4; const float* rp = a.in(24) + (size_t)(32 * st + 8 * q) * 16 + n;
        unsigned hi[4], lo[4];
#pragma unroll
        for (int e = 0; e < 4; ++e) { const float v0 = rp[(2 * e) * 16], v1 = rp[(2 * e + 1) * 16]; const unsigned h2 = pk2(v0, v1); hi[e] = h2; lo[e] = pk2(v0 - bflo(h2), v1 - bfhi(h2)); }
        bh[i] = (u32x4){hi[0], hi[1], hi[2], hi[3]}; bl[i] = (u32x4){lo[0], lo[1], lo[2], lo[3]}; }
    volatile LAS int* bcnt = c.misc + 64; volatile LAS int* bbase = c.misc + 80; LAS float* lgt = (LAS float*)(c.lds + 65536);
    if (c.tid < 16) bcnt[c.tid] = 0;
    const int Te = l == DEPTH - 1 ? TL : T;
    const int rpb = (Te + c.G - 1) / c.G, r0 = c.bid * rpb, nrows = (r0 + rpb <= Te) ? rpb : (Te - r0 > 0 ? Te - r0 : 0);
    LAS float* par = (LAS float*)(c.lds + 81920); const int b0 = brow_of(r0);
    for (int i = c.tid; i < 2 * D; i += NTHREADS) { const int bb = i >> 10, col = i & (D - 1), bt = b0 + bb < 8 ? b0 + bb : 8;
        const float* md = (const float*)(c.ws + WS_MODS) + ((size_t)l * 9 + bt) * NMOD + 3 * D;
        par[bb * 2 * D + col] = a.in(7)[(size_t)l * D + col] * (1.0f + md[D + col]); par[bb * 2 * D + D + col] = md[col]; }
    __syncthreads();
    bf16_t* H = (bf16_t*)(c.ws + WS_H); float* GW = (float*)(c.ws + WS_GW);
    const bf16_t* XB = (const bf16_t*)(c.ws + WS_XB);
    const int m = c.lane & 15, q = c.lane >> 4;
    for (int tile = c.wave; tile * 16 < nrows; tile += NWAVES) {
        const int rowl = tile * 16 + m; const bool valid = rowl < nrows; const int row = r0 + (valid ? rowl : nrows - 1);
        const bf16_t* xb = XB + (size_t)row * D + 8 * q;
        u32x4 w[32];
#pragma unroll
        for (int st = 0; st < 32; ++st) w[st] = *(const u32x4*)(xb + 32 * st);
        __builtin_amdgcn_sched_barrier(0);
        float ss = 0.f;
#pragma unroll
        for (int st = 0; st < 32; ++st) { const float x0 = bflo(w[st].x), x1 = bfhi(w[st].x), x2 = bflo(w[st].y), x3 = bfhi(w[st].y), x4 = bflo(w[st].z), x5 = bfhi(w[st].z), x6 = bflo(w[st].w), x7 = bfhi(w[st].w);
            ss += (x0 * x0 + x1 * x1) + (x2 * x2 + x3 * x3) + (x4 * x4 + x5 * x5) + (x6 * x6 + x7 * x7);
            if ((st & 3) == 3) __builtin_amdgcn_sched_barrier(0); }
        ss += shflx(ss, 16, c.lane); ss += shflx(ss, 32, c.lane);
#pragma unroll
        for (int st = 0; st < 32; ++st) asm volatile("" : "+v"(w[st].x), "+v"(w[st].y), "+v"(w[st].z), "+v"(w[st].w));
        const float rstd = 1.0f / sqrtf(ss * (1.0f / D) + RMS_EPS);
        const LAS float* pa = par + (brow_of(row) - b0) * 2 * D + 8 * q;
        bf16_t* hrow = H + (size_t)row * D + 8 * q;
        f32x4 acc = {0.f, 0.f, 0.f, 0.f};
#pragma unroll
        for (int st = 0; st < 32; ++st) {
            const int co = 32 * st;
            const f32x4 g0 = *(const LAS f32x4*)(pa + co), g1 = *(const LAS f32x4*)(pa + co + 4), s0 = *(const LAS f32x4*)(pa + D + co), s1 = *(const LAS f32x4*)(pa + D + co + 4);
            const f32x4 xa = {bflo(w[st].x), bfhi(w[st].x), bflo(w[st].y), bfhi(w[st].y)}, xc = {bflo(w[st].z), bfhi(w[st].z), bflo(w[st].w), bfhi(w[st].w)};
            const f32x4 ha = xa * rstd * g0 + s0, hc = xc * rstd * g1 + s1;
            u32x4 hi4; hi4.x = pk2(ha[0], ha[1]); hi4.y = pk2(ha[2], ha[3]); hi4.z = pk2(hc[0], hc[1]); hi4.w = pk2(hc[2], hc[3]);
            u32x4 lo4; lo4.x = pk2(ha[0] - bflo(hi4.x), ha[1] - bfhi(hi4.x)); lo4.y = pk2(ha[2] - bflo(hi4.y), ha[3] - bfhi(hi4.y));
            lo4.z = pk2(hc[0] - bflo(hi4.z), hc[1] - bfhi(hi4.z)); lo4.w = pk2(hc[2] - bflo(hi4.w), hc[3] - bfhi(hi4.w));
            if (valid) *(u32x4*)(hrow + co) = hi4;
            const bf16x8 ahi = __builtin_bit_cast(bf16x8, hi4), alo = __builtin_bit_cast(bf16x8, lo4);
            const bf16x8 bhi = __builtin_bit_cast(bf16x8, bh[st * 64 + c.lane]), blo = __builtin_bit_cast(bf16x8, bl[st * 64 + c.lane]);
            acc = __builtin_amdgcn_mfma_f32_16x16x32_bf16(ahi, bhi, acc, 0, 0, 0);
            acc = __builtin_amdgcn_mfma_f32_16x16x32_bf16(alo, bhi, acc, 0, 0, 0);
            acc = __builtin_amdgcn_mfma_f32_16x16x32_bf16(ahi, blo, acc, 0, 0, 0);
            __builtin_amdgcn_sched_barrier(0);
        }
#pragma unroll
        for (int j = 0; j < 4; ++j) lgt[(tile * 16 + 4 * q + j) * 16 + m] = acc[j];
    }
    __syncthreads();
    int e1 = 0, e2 = 0, p1 = 0, p2 = 0; const int myrow = c.tid;
    if (myrow < nrows) {
        float rb[16]; { const float* rbp = a.in(25);
#pragma unroll
            for (int q4 = 0; q4 < 4; ++q4) { const f32x4 r4 = *(const f32x4*)(rbp + 4 * q4); rb[4 * q4] = r4[0]; rb[4 * q4 + 1] = r4[1]; rb[4 * q4 + 2] = r4[2]; rb[4 * q4 + 3] = r4[3]; } }
        float sc[16], bi[16];
#pragma unroll
        for (int q4 = 0; q4 < 4; ++q4) { const f32x4 l4 = *(const LAS f32x4*)(lgt + myrow * 16 + q4 * 4);
#pragma unroll
            for (int k = 0; k < 4; ++k) { sc[q4 * 4 + k] = sigm(l4[k]); bi[q4 * 4 + k] = sc[q4 * 4 + k] + rb[q4 * 4 + k]; } }
        float gs[4];
#pragma unroll
        for (int gq = 0; gq < 4; ++gq) { const float x0 = bi[4 * gq], x1 = bi[4 * gq + 1], x2 = bi[4 * gq + 2], x3 = bi[4 * gq + 3];
            const float h1 = fmaxf(x0, x1), l1 = fminf(x0, x1), h2 = fmaxf(x2, x3), l2 = fminf(x2, x3);
            gs[gq] = fmaxf(h1, h2) + fmaxf(fminf(h1, h2), fmaxf(l1, l2)); }
        int bg = 0; float best = gs[0];
#pragma unroll
        for (int gq = 1; gq < 4; ++gq) if (gs[gq] > best) { best = gs[gq]; bg = gq; }
        float vb[4], vs[4];
#pragma unroll
        for (int i = 0; i < 4; ++i) { vb[i] = bg == 0 ? bi[i] : bg == 1 ? bi[4 + i] : bg == 2 ? bi[8 + i] : bi[12 + i]; vs[i] = bg == 0 ? sc[i] : bg == 1 ? sc[4 + i] : bg == 2 ? sc[8 + i] : sc[12 + i]; }
        int i1 = 0; float m1 = vb[0];
#pragma unroll
        for (int i = 1; i < 4; ++i) if (vb[i] > m1) { m1 = vb[i]; i1 = i; }
        int i2 = -1; float m2 = 0.f;
#pragma unroll
        for (int i = 0; i < 4; ++i) if (i != i1 && (i2 < 0 || vb[i] > m2)) { m2 = vb[i]; i2 = i; }
        const float s1 = i1 == 0 ? vs[0] : i1 == 1 ? vs[1] : i1 == 2 ? vs[2] : vs[3], s2 = i2 == 0 ? vs[0] : i2 == 1 ? vs[1] : i2 == 2 ? vs[2] : vs[3];
        const float inv = 1.0f / (s1 + s2);
        e1 = bg * 4 + i1; e2 = bg * 4 + i2;
        p1 = __hip_atomic_fetch_add((LAS int*)(bcnt + e1), 1, __ATOMIC_RELAXED, __HIP_MEMORY_SCOPE_WORKGROUP);
        p2 = __hip_atomic_fetch_add((LAS int*)(bcnt + e2), 1, __ATOMIC_RELAXED, __HIP_MEMORY_SCOPE_WORKGROUP);
        GW[(size_t)(r0 + myrow) * 2] = s1 * inv; GW[(size_t)(r0 + myrow) * 2 + 1] = s2 * inv;
    }
    __syncthreads();
    unsigned* cntw = (unsigned*)(c.ws + WS_CTL) + CW_CNT + (dummy ? l + 4 : l) * 1024;
    if (c.tid < 16) bbase[c.tid] = (int)__hip_atomic_fetch_add(cntw + c.tid * 64, (unsigned)bcnt[c.tid], __ATOMIC_RELAXED, __HIP_MEMORY_SCOPE_AGENT);
    __syncthreads();
    int* list = (int*)(c.ws + (dummy ? WS_HMID : WS_LIST));
    if (myrow < nrows) { const int row = r0 + myrow; list[(size_t)e1 * LCAP + bbase[e1] + p1] = row * 2; list[(size_t)e2 * LCAP + bbase[e2] + p2] = row * 2 + 1; }
}
__device__ __forceinline__ void moe_setup(Ctx& c, int l) {
    const unsigned* cntw = (const unsigned*)(c.ws + WS_CTL) + CW_CNT + l * 1024;
    if (c.tid < NE) c.misc[48 + c.tid] = (int)__hip_atomic_load(cntw + c.tid * 64, __ATOMIC_RELAXED, __HIP_MEMORY_SCOPE_AGENT);
    __syncthreads();
    if (c.tid == 0) { int cum = 0;
        for (int e = 0; e < NE; ++e) { c.misc[16 + e] = cum; cum += (c.misc[48 + e] + 255) >> 8; }
        c.misc[16 + NE] = cum; }
    __syncthreads();
}

struct FinRow { u32x2 x[4], s0[4], s1[4]; f32x4 g[4]; };
__device__ __forceinline__ void fin_load(FinRow& r, const bf16_t* XB, const bf16_t* SL, const float* G2, int row, int lane) {
#pragma unroll
    for (int j = 0; j < 4; ++j) { const int col = 4 * lane + 256 * j; r.x[j] = *(const u32x2*)(XB + (size_t)row * D + col); r.s0[j] = *(const u32x2*)(SL + (size_t)row * 2 * D + col); r.s1[j] = *(const u32x2*)(SL + (size_t)row * 2 * D + D + col);
        r.g[j] = *(const f32x4*)(G2 + (size_t)(row >> 12) * NMOD + col); }
}
__device__ __forceinline__ void fin_row(const FinRow& r, const f32x4 (&fg)[4], float* outp, int row, int lane) {
    f32x4 v[4]; float s = 0.f;
#pragma unroll
    for (int j = 0; j < 4; ++j) { const f32x4 xv = {bflo(r.x[j].x), bfhi(r.x[j].x), bflo(r.x[j].y), bfhi(r.x[j].y)};
        const f32x4 y = (f32x4){bflo(r.s0[j].x) + bflo(r.s1[j].x), bfhi(r.s0[j].x) + bfhi(r.s1[j].x), bflo(r.s0[j].y) + bflo(r.s1[j].y), bfhi(r.s0[j].y) + bfhi(r.s1[j].y)};
        v[j] = xv + r.g[j] * y; s += (v[j][0] * v[j][0] + v[j][1] * v[j][1]) + (v[j][2] * v[j][2] + v[j][3] * v[j][3]); }
    const float rstd = 1.0f / sqrtf(wave_sum(s, lane) * (1.0f / D) + RMS_EPS);
#pragma unroll
    for (int j = 0; j < 4; ++j) *(f32x4*)(outp + (size_t)row * D + 4 * lane + 256 * j) = v[j] * rstd * fg[j];
}
__device__ __forceinline__ void phase_fin(const Args& a, Ctx& c) {
    const int gw = c.bid * NWAVES + c.wave, NGW = c.G * NWAVES;
    const bf16_t* XB = (const bf16_t*)(c.ws + WS_XB); const bf16_t* SL = (const bf16_t*)(c.ws + WS_Z); const float* G2 = (const float*)(c.ws + WS_MODS) + (size_t)(DEPTH - 1) * 9 * NMOD + 5 * D;
    f32x4 fg[4];
#pragma unroll
    for (int j = 0; j < 4; ++j) fg[j] = *(const f32x4*)(a.in(29) + 4 * c.lane + 256 * j);
    float* outp = a.out();
    FinRow ra, rb;
    if (gw < TL) fin_load(ra, XB, SL, G2, gw, c.lane);
    for (int row = gw; row < TL; row += 2 * NGW) {
        const bool hb = row + NGW < TL;
        if (hb) fin_load(rb, XB, SL, G2, row + NGW, c.lane);
        fin_row(ra, fg, outp, row, c.lane);
        if (row + 2 * NGW < TL) fin_load(ra, XB, SL, G2, row + 2 * NGW, c.lane);
        if (hb) fin_row(rb, fg, outp, row + NGW, c.lane);
    }
}

constexpr int STEPS_PER_LAYER = 11, NSTEPS = 1 + DEPTH * STEPS_PER_LAYER + 1;
__device__ __forceinline__ Ctx mkctx(LAS unsigned char* lds, const Args& a, const int wv) {
    unsigned lb = (unsigned)(unsigned long long)lds; asm volatile("" : "+s"(lb));
    Ctx c; c.lds = (LAS unsigned char*)lb; c.misc = (volatile LAS int*)(c.lds + MISC_OFF);
    int g = gridDim.x, b = blockIdx.x; asm volatile("" : "+s"(g), "+s"(b));
    c.wave = wv; c.lane = lane_id_v(); c.tid = wv * 64 + c.lane; c.G = g; c.bid = b; c.ws = a.ws();
    return c;
}
__global__ void __launch_bounds__(NTHREADS, 2) mk_fwd(KArgs ka) {
    extern __shared__ __attribute__((aligned(16))) unsigned char lds_raw[];
    LAS unsigned char* lds = (LAS unsigned char*)lds_raw;
    volatile LAS int* misc = (volatile LAS int*)(lds + MISC_OFF);
#if (MK_DIAG_ZERO & 1)
    for (int i = MISC_OFF / 4 + threadIdx.x; i < LDS_BYTES / 4; i += NTHREADS) ((volatile LAS int*)lds)[i] = 0x7fc12345;
    __syncthreads();
#endif
    if (threadIdx.x < 16) misc[threadIdx.x] = 0;
    if ((threadIdx.x & 63) == 0) misc[WTAB + hw_key()] = (int)(threadIdx.x >> 6);
    if (threadIdx.x == 64) {
#pragma unroll
        for (int k = 0; k < 30; ++k) { const unsigned long long p = (unsigned long long)ka.in[k]; misc[PTAB + 2 * k] = (int)(unsigned)p; misc[PTAB + 2 * k + 1] = (int)(unsigned)(p >> 32); }
        { const unsigned long long p = (unsigned long long)ka.out; misc[PTAB + 60] = (int)(unsigned)p; misc[PTAB + 61] = (int)(unsigned)(p >> 32); }
        { const unsigned long long p = (unsigned long long)ka.ws; misc[PTAB + 62] = (int)(unsigned)p; misc[PTAB + 63] = (int)(unsigned)(p >> 32); }
        misc[PTAB + 64] = ka.lo; misc[PTAB + 65] = ka.hi;
    }
    __syncthreads();
    Args a; a.tab = misc + PTAB;
    int wv = __builtin_amdgcn_readfirstlane((int)(threadIdx.x >> 6)); asm volatile("" : "+s"(wv));
    const int lo = __builtin_amdgcn_readfirstlane(misc[PTAB + 64]), hi = __builtin_amdgcn_readfirstlane(misc[PTAB + 65]);
    XcdBarrier bar; bar.bar = (unsigned*)(a.ws() + WS_CTL) + CW_BAR; bar.x = 0; bar.st = (volatile LAS unsigned*)misc;
    if (hi - lo > 1) bar = xcd_barrier_post((unsigned*)(a.ws() + WS_CTL) + CW_BAR, (volatile LAS unsigned*)misc);
#define IN(s) (lo <= (s) && (s) < hi)
#define SEAM(s) do { if (IN(s) && IN((s) + 1)) { bar.bar = (unsigned*)(a.ws() + WS_CTL) + CW_BAR; xcd_barrier(bar, wv * 64 + lane_id_v()); } } while (0)
    if (IN(0)) { Ctx c = mkctx(lds, a, wv); phase_p0(a, c); __syncthreads(); tr_range(a, c, 0, 0, TR_NITEMS, c.bid * NWAVES + c.wave, c.G * NWAVES);
        if (MK_DBL & 1) { __syncthreads(); phase_p0(a, c); __syncthreads(); tr_range(a, c, 0, 0, TR_NITEMS, c.bid * NWAVES + c.wave, c.G * NWAVES); } } SEAM(0);
    for (int l = 0; l < DEPTH; ++l) {
        const int sb = 1 + l * STEPS_PER_LAYER;
        if (IN(sb + 0)) { Ctx c = mkctx(lds, a, wv); if (MK_DBL & (1 << 11)) { phase_a(a, c, l, true); __syncthreads(); } phase_a(a, c, l); } SEAM(sb + 0);
        if (IN(sb + 1)) {
            Ctx c = mkctx(lds, a, wv);
            pg8::StaticOrder S; S.init(T, NZ, c.G, c.bid); pg8::EpiIn E{(bf16_t*)(c.ws + WS_Z), (bf16_t*)(c.ws + WS_U)};
            pg8::gemm_phase<pg8::EpiIn, pg8::StaticOrder, false>(c.lds, c.tid, (const bf16_t*)(c.ws + WS_H), (const bf16_t*)(c.ws + wbuf_off(l) + WO_WIN), D, S, E);
            if (MK_DBL & (1 << 1)) { __syncthreads(); pg8::gemm_phase<pg8::EpiIn, pg8::StaticOrder, false>(c.lds, c.tid, (const bf16_t*)(c.ws + WS_H), (const bf16_t*)(c.ws + wbuf_off(l) + WO_WIN), D, S, E); }
            { const int tail0 = S.nwg % c.G; if (l + 1 < DEPTH && tail0 != 0 && c.bid >= tail0) tr_range(a, c, l + 1, 0, TR_SPLIT, (c.bid - tail0) * NWAVES + c.wave, (c.G - tail0) * NWAVES);
                if (l == 0) { Ctx c2 = mkctx(lds, a, wv); if (tail0 == 0) s3_tables(a, c2, c2.bid, c2.G); else if (c2.bid >= tail0) s3_tables(a, c2, c2.bid - tail0, c2.G - tail0); } }
        } SEAM(sb + 1);
        if (IN(sb + 2)) { Ctx c = mkctx(lds, a, wv); phase_s1(a, c, l);
            if (MK_DBL & (1 << 2)) { __syncthreads(); phase_s1(a, c, l); }
#if MK_SELFTEST
            if (l == 0) { asm volatile("" ::: "memory"); phase_s1(a, c, l, WS_HMID); bar.bar = (unsigned*)(a.ws() + WS_CTL) + CW_BAR; xcd_barrier(bar, c.tid);
                const u32x4* p = (const u32x4*)(c.ws + WS_CAR); const u32x4* q = (const u32x4*)(c.ws + WS_HMID); unsigned bad = 0;
                for (size_t i = (size_t)c.bid * NTHREADS + c.tid; i < (size_t)NB * 32 * 2 * NCH * 32; i += (size_t)c.G * NTHREADS) { const u32x4 x = p[i], y = q[i]; bad |= (x.x ^ y.x) | (x.y ^ y.y) | (x.z ^ y.z) | (x.w ^ y.w); }
                if (bad) __hip_atomic_fetch_or((unsigned*)(c.ws + WS_CTL) + 8, 1u, __ATOMIC_RELAXED, __HIP_MEMORY_SCOPE_AGENT); }
#endif
        } SEAM(sb + 2);
        if (IN(sb + 3)) { Ctx c = mkctx(lds, a, wv); phase_s2(a, c, l); if (MK_DBL & (1 << 3)) { __syncthreads(); phase_s2(a, c, l); } } SEAM(sb + 3);
        if (IN(sb + 4)) { Ctx c = mkctx(lds, a, wv);
#pragma unroll 1
            for (int rep = 0; rep < ((MK_DBL & (1 << 4)) ? 2 : 1); ++rep) { phase_s3(a, c, l); __syncthreads(); }
            { const int nt3 = 32 * ((4 * (l == DEPTH - 1 ? NCH - 4 : NCH) + 7) >> 3), tail0 = nt3 % c.G;
                if (tail0 == 0) phase_pool(c, c.bid, c.G, 0, POOL_TASKS / 2, false); else if (c.bid >= tail0) phase_pool(c, c.bid - tail0, c.G - tail0, 0, POOL_TASKS / 2, false); }
        } SEAM(sb + 4);
        if (IN(sb + 5)) {
            Ctx c = mkctx(lds, a, wv);
            pg8::StaticOrder S; S.init(l == DEPTH - 1 ? TL : T, 512, c.G, c.bid); pg8::EpiGlu E{(const bf16_t*)(c.ws + WS_YG), (bf16_t*)(c.ws + WS_H) + (size_t)T * 512, a.in(20) + (size_t)l * 512};
            pg8::gemm_phase<pg8::EpiGlu, pg8::StaticOrder, false, true>(c.lds, c.tid, (const bf16_t*)(c.ws + WS_YG), (const bf16_t*)(c.ws + wbuf_off(l) + WO_GLU), 512, S, E);
            if (MK_DBL & (1 << 5)) { __syncthreads(); pg8::gemm_phase<pg8::EpiGlu, pg8::StaticOrder, false, true>(c.lds, c.tid, (const bf16_t*)(c.ws + WS_YG), (const bf16_t*)(c.ws + wbuf_off(l) + WO_GLU), 512, S, E); }
            { const int tail0 = S.nwg % c.G; Ctx c2 = mkctx(lds, a, wv);
                if (tail0 == 0) phase_pool(c2, c2.bid, c2.G, POOL_TASKS / 2, POOL_TASKS, l != DEPTH - 1); else if (c2.bid >= tail0) phase_pool(c2, c2.bid - tail0, c2.G - tail0, POOL_TASKS / 2, POOL_TASKS, l != DEPTH - 1); }
        } SEAM(sb + 5);
        if (IN(sb + 6)) {
            Ctx c = mkctx(lds, a, wv); pg8::PairOrder S; S.so.init(l == DEPTH - 1 ? TL : T, D, c.G, c.bid);
            pg8::EpiM12 E{(const bf16_t*)(c.ws + WS_Z), (bf16_t*)(c.ws + WS_HMID)};
            pg8::gemm_phase<pg8::EpiM12, pg8::PairOrder, false>(c.lds, c.tid, (const bf16_t*)(c.ws + WS_H), (const bf16_t*)(c.ws + wbuf_off(l) + WO_WC), 512, S, E);
            if (MK_DBL & (1 << 6)) { __syncthreads(); pg8::gemm_phase<pg8::EpiM12, pg8::PairOrder, false>(c.lds, c.tid, (const bf16_t*)(c.ws + WS_H), (const bf16_t*)(c.ws + wbuf_off(l) + WO_WC), 512, S, E); }
            { const int tail0 = S.so.nwg % c.G; if (l + 1 < DEPTH && tail0 != 0 && c.bid >= tail0) tr_range(a, c, l + 1, TR_SPLIT, TR_SPLIT2, (c.bid - tail0) * NWAVES + c.wave, (c.G - tail0) * NWAVES); }
        } SEAM(sb + 6);
        if (IN(sb + 7)) {
            Ctx c = mkctx(lds, a, wv);
            pg8::StaticOrder S; S.init(l == DEPTH - 1 ? TL : T, D, c.G, c.bid);
            pg8::EpiOut E{(bf16_t*)(c.ws + WS_XB), (const float*)(c.ws + WS_MODS) + (size_t)l * 9 * NMOD + 2 * D, (bf16_t*)(c.ws + WS_XB)};
            if (MK_DBL & (1 << 7)) { pg8::EpiOut E2{(bf16_t*)(c.ws + WS_XB), (const float*)(c.ws + WS_MODS) + (size_t)l * 9 * NMOD + 2 * D, (bf16_t*)(c.ws + WS_H)};
                pg8::gemm_phase<pg8::EpiOut, pg8::StaticOrder, false>(c.lds, c.tid, (const bf16_t*)(c.ws + WS_HMID), (const bf16_t*)(c.ws + wbuf_off(l) + WO_WOUT), D, S, E2); __syncthreads(); }
            pg8::gemm_phase<pg8::EpiOut, pg8::StaticOrder, false>(c.lds, c.tid, (const bf16_t*)(c.ws + WS_HMID), (const bf16_t*)(c.ws + wbuf_off(l) + WO_WOUT), D, S, E);
            { const int tail0 = S.nwg % c.G; if (l + 1 < DEPTH && tail0 != 0 && c.bid >= tail0) tr_range(a, c, l + 1, TR_SPLIT2, TR_NITEMS, (c.bid - tail0) * NWAVES + c.wave, (c.G - tail0) * NWAVES); }
        } SEAM(sb + 7);
        if (IN(sb + 8)) { Ctx c = mkctx(lds, a, wv); phase_i(a, c, l); if (MK_DBL & (1 << 8)) { __syncthreads(); phase_i(a, c, l, true); } } SEAM(sb + 8);
        if (IN(sb + 9)) {
            Ctx c = mkctx(lds, a, wv);
            moe_setup(c, l);
            pg8::MoeOrder S{(const LAS int*)(c.misc + 16), (const LAS int*)(c.misc + 48), (const int*)(c.ws + WS_LIST), c.G, c.bid}; pg8::EpiUp E{(bf16_t*)(c.ws + WS_HMID)};
            pg8::gemm_phase<pg8::EpiUp, pg8::MoeOrder, true>(c.lds, c.tid, (const bf16_t*)(c.ws + WS_H), (const bf16_t*)(c.ws + wbuf_off(l) + WO_W13), D, S, E);
            if (MK_DBL & (1 << 9)) { __syncthreads(); pg8::gemm_phase<pg8::EpiUp, pg8::MoeOrder, true>(c.lds, c.tid, (const bf16_t*)(c.ws + WS_H), (const bf16_t*)(c.ws + wbuf_off(l) + WO_W13), D, S, E); }
        } SEAM(sb + 9);
        if (IN(sb + 10)) {
            Ctx c = mkctx(lds, a, wv);
            moe_setup(c, l);
            pg8::MoeOrder S{(const LAS int*)(c.misc + 16), (const LAS int*)(c.misc + 48), (const int*)(c.ws + WS_LIST), c.G, c.bid};
            pg8::EpiDown E{(bf16_t*)(c.ws + WS_Z), (const int*)(c.ws + WS_LIST), (const float*)(c.ws + WS_GW), (const LAS int*)(c.misc + 16), (const LAS int*)(c.misc + 48)};
            pg8::gemm_phase<pg8::EpiDown, pg8::MoeOrder, false>(c.lds, c.tid, (const bf16_t*)(c.ws + WS_HMID), (const bf16_t*)(c.ws + wbuf_off(l) + WO_W2), DE, S, E);
            if (MK_DBL & (1 << 10)) { __syncthreads(); pg8::gemm_phase<pg8::EpiDown, pg8::MoeOrder, false>(c.lds, c.tid, (const bf16_t*)(c.ws + WS_HMID), (const bf16_t*)(c.ws + wbuf_off(l) + WO_W2), DE, S, E); }
        } SEAM(sb + 10);
    }
    if (IN(NSTEPS - 1)) { Ctx c = mkctx(lds, a, wv); phase_fin(a, c); }
#undef IN
#undef SEAM
}

extern "C" void kernel_launch(void* const* d_in, const int* in_sizes, int n_in, void* d_out, int out_size, void* d_ws, size_t ws_size, hipStream_t stream) {
    static int grid = 0;
    if (grid == 0) {
        if (n_in != 30 || out_size != TL * D || ws_size < WS_END) { fprintf(stderr, "kernel_launch: unexpected shapes (n_in %d out %d ws %zu)\n", n_in, out_size, ws_size); grid = -1; return; }
        int dev = 0, cus = 0, per_cu = 0;
        if (hipGetDevice(&dev) != hipSuccess || hipDeviceGetAttribute(&cus, hipDeviceAttributeMultiprocessorCount, dev) != hipSuccess) { grid = -1; return; }
        if (hipFuncSetAttribute((const void*)mk_fwd, hipFuncAttributeMaxDynamicSharedMemorySize, LDS_BYTES) != hipSuccess) { fprintf(stderr, "kernel_launch: hipFuncSetAttribute failed\n"); grid = -1; return; }
        if (hipOccupancyMaxActiveBlocksPerMultiprocessor(&per_cu, (const void*)mk_fwd, NTHREADS, LDS_BYTES) != hipSuccess || per_cu < 1) { fprintf(stderr, "kernel_launch: occupancy query says %d\n", per_cu); per_cu = 1; }
        (void)hipGetLastError();
        grid = cus;
    }
    if (grid < 0) return;
    (void)hipMemsetAsync((char*)d_ws + WS_CTL, 0, CTL_ZERO_BYTES, stream);
#if (MK_DIAG_ZERO & 2)
    (void)hipMemsetAsync((char*)d_ws, 0, WS_END, stream);
#endif
#if (MK_DIAG_ZERO & 4)
    (void)hipMemsetAsync((char*)d_out, 0, (size_t)TL * D * 4, stream);
#endif
    KArgs a{};
    for (int i = 0; i < 30; ++i) a.in[i] = (const float*)d_in[i];
    a.out = (float*)d_out; a.ws = (unsigned char*)d_ws;
#if MK_MULTI
    for (int s = 0; s < NSTEPS; ++s) { a.lo = s; a.hi = s + 1; hipLaunchKernelGGL(mk_fwd, dim3(grid), dim3(NTHREADS), LDS_BYTES, stream, a); }
#else
    a.lo = 0; a.hi = NSTEPS; hipLaunchKernelGGL(mk_fwd, dim3(grid), dim3(NTHREADS), LDS_BYTES, stream, a);
#endif
}
```

```cpp
#include <hip/hip_runtime.h>
#include <cstdio>

#ifndef MK_MULTI
#define MK_MULTI 0
#endif
#ifndef MK_SELFTEST
#ifndef MK_DBL
#define MK_DBL 0
#endif
#define MK_SELFTEST 0
#endif
#define MK_DIAG_ZERO 0

#define LAS __attribute__((address_space(3)))
#define GAS __attribute__((address_space(1)))
typedef unsigned short bf16_t;
typedef short bf16x8 __attribute__((ext_vector_type(8)));
typedef float f32x2 __attribute__((ext_vector_type(2)));
typedef float f32x4 __attribute__((ext_vector_type(4)));
typedef float f32x16 __attribute__((ext_vector_type(16)));
typedef unsigned u32x2 __attribute__((ext_vector_type(2)));
typedef unsigned u32x4 __attribute__((ext_vector_type(4)));

constexpr int D = 1024, NB = 8, SEQ = 4096, CTXL = 256, DEPTH = 4;
constexpr int TL = NB * SEQ, TC = NB * CTXL, T = TL + TC;
constexpr int NZ = 3072, NMOD = 6 * D;
constexpr int NE = 16, DE = 512;
constexpr int LCAP = 2 * T;
constexpr int HM_ROWS = 2 * T + NE * 256;
constexpr float RMS_EPS = 1e-6f;
constexpr int NCH = 68;
constexpr int IMG_STRIDE = 336;

constexpr size_t MiB = 1u << 20;
constexpr size_t WS_CTL = 0, CTL_ZERO_BYTES = 2 * MiB;
constexpr size_t WS_MODS = 2 * MiB;
constexpr size_t WS_AB = 3 * MiB;
constexpr size_t WS_BF = 4 * MiB;
constexpr size_t WS_CF = 5 * MiB;
constexpr size_t WS_LIST = 7 * MiB;
constexpr size_t WS_GW = 12 * MiB;
constexpr size_t WS_XCTX = 13 * MiB;
constexpr size_t WS_CAR = 21 * MiB;
constexpr size_t WS_W = 39 * MiB;
constexpr size_t WO_WIN = 0, WO_WC = 6 * MiB, WO_WBS = 7 * MiB, WO_WOUT = 8 * MiB, WO_GLU = 10 * MiB, WO_W13 = 11 * MiB, WO_W2 = 43 * MiB;
constexpr size_t WS_H = 98 * MiB;
constexpr size_t WS_YG = 166 * MiB;
constexpr size_t WS_HMID = 200 * MiB;
constexpr size_t WS_Z = 272 * MiB;
constexpr size_t WS_XB = 476 * MiB;
constexpr size_t WS_W2ND = 544 * MiB;
constexpr size_t WS_CAR2 = 604 * MiB;
constexpr size_t WS_S3T = 621 * MiB;
constexpr size_t WS_U = 631 * MiB;
constexpr size_t WS_END = 665 * MiB;
static_assert((size_t)HM_ROWS * 512 * 2 <= 72 * MiB && (size_t)T * NZ * 2 <= 204 * MiB && (size_t)T * D * 2 == 68 * MiB, "ws map");
constexpr int CW_TMO = 0, CW_BAR = 4096, CW_CNT = 16384;

__device__ __forceinline__ unsigned f2bf(float f) { unsigned u = __builtin_bit_cast(unsigned, f); return (u + 0x7fffu + ((u >> 16) & 1u)) >> 16; }
typedef __bf16 bf16v2 __attribute__((ext_vector_type(2)));
__device__ __forceinline__ unsigned pk2(float lo, float hi) { const f32x2 v = {lo, hi}; const bf16v2 b = __builtin_convertvector(v, bf16v2); return __builtin_bit_cast(unsigned, b); }
__device__ __forceinline__ float bflo(unsigned w) { return __builtin_bit_cast(float, w << 16); }
__device__ __forceinline__ float bfhi(unsigned w) { return __builtin_bit_cast(float, w & 0xffff0000u); }
__device__ __forceinline__ float sigm(float x) { return __builtin_amdgcn_rcpf(1.0f + __builtin_amdgcn_exp2f(-1.44269504f * x)); }
__device__ __forceinline__ float gelu_t(float x) { const float u = 1.5957691216f * (x + 0.044715f * x * x * x); return x * sigm(u); }
__device__ __forceinline__ int lane_id_v() { int l; asm volatile("v_mbcnt_lo_u32_b32 %0, -1, 0\n\tv_mbcnt_hi_u32_b32 %0, -1, %0" : "=v"(l)); return l; }
__device__ __forceinline__ int hw_key() { return (int)(__builtin_amdgcn_s_getreg((5 << 11) | 4) & 0x3fu); }
__device__ __forceinline__ float shflx(float v, int o, int lane) { return __builtin_bit_cast(float, __builtin_amdgcn_ds_bpermute((lane ^ o) << 2, __builtin_bit_cast(int, v))); }
__device__ __forceinline__ float wave_sum(float v, int lane) {
#pragma unroll
    for (int o = 1; o < 64; o <<= 1) v += shflx(v, o, lane);
    return v;
}
__device__ __forceinline__ f32x4 ld_bf4(const bf16_t* p) { const u32x2 w = *(const u32x2*)p; return (f32x4){bflo(w.x), bfhi(w.x), bflo(w.y), bfhi(w.y)}; }
__device__ __forceinline__ void st_bf4(bf16_t* p, f32x4 v) { u32x2 w; w.x = pk2(v[0], v[1]); w.y = pk2(v[2], v[3]); *(u32x2*)p = w; }
#define LDS_WAIT() asm volatile("s_waitcnt lgkmcnt(0)" ::: "memory")
#define VM_WAIT() asm volatile("s_waitcnt vmcnt(0)" ::: "memory")

namespace pg8 {
constexpr int BM = 256, BK = 64, HALF = 128, HTB = HALF * BK * 2, STAGE_BYTES = 8 * HTB, NXCD = 8, WGM = 8;
__host__ __device__ __forceinline__ int lds_byte(int r, int c) { const int st = (r >> 4) * 2 + (c >> 5), rr = r & 15, cc = c & 31, ob = rr * 64 + cc * 2; return st * 1024 + (ob ^ (((ob >> 9) & 1) << 5)); }
__host__ __device__ __forceinline__ void stage_rc(int b, int& R, int& C) { const int st = b / 1024, sb = b % 1024, swz = sb ^ (((sb >> 9) & 1) << 5); R = (st >> 1) * 16 + swz / 64; C = (st & 1) * 32 + (swz % 64) / 2; }
__host__ __device__ __forceinline__ int perm32(int rho) { const int n = rho >> 4, i = rho & 15; return 8 * (i >> 2) + 4 * n + (i & 3); }

struct Unit { int pm, pn, e, pnl; };

struct StaticOrder {
    int nM, nN, nwg, G, c;
    __device__ void init(int M, int N, int G_, int c_) { nM = M / BM; nN = N / BM; nwg = nM * nN; G = G_; c = c_; }
    __device__ bool next(int i, Unit& u) const {
        const long L = (long)i * G + c; if (L >= nwg) return false;
        int wgid = (int)L; { const int q = nwg / NXCD, r = nwg % NXCD, xcd = wgid % NXCD, off = wgid / NXCD; wgid = (xcd < r ? xcd * (q + 1) : r * (q + 1) + (xcd - r) * q) + off; }
        const int nig = WGM * nN, gid = wgid / nig, fm = gid * WGM, gsz = (nM - fm) < WGM ? (nM - fm) : WGM;
        u.pm = fm + ((wgid % nig) % gsz); u.pn = (wgid % nig) / gsz; u.pnl = u.pn; u.e = 0; return true;
    }
    __device__ __forceinline__ int arow(const Unit&, int) const { return 0; }
};
struct ComboOrder {
    int G, c;
    __device__ bool next(int i, Unit& u) const {
        const int L = i * G + c; constexpr int NM = (T / BM) * 4, NG = (T / BM) * 2;
        if (L >= NM + NG) return false;
        if (L < NM) { u.pm = L >> 2; u.pn = L & 3; u.pnl = L & 3; u.e = 0; }
        else { const int q = L - NM; u.pm = (q >> 1) + (int)((WS_YG - WS_H) / ((size_t)BM * 1024)); u.pn = (q & 1) + (int)((WO_GLU - WO_WC) / ((size_t)BM * 1024)); u.pnl = q & 1; u.e = 1; }
        return true;
    }
    __device__ __forceinline__ int arow(const Unit&, int) const { return 0; }
};
struct PairOrder {
    StaticOrder so;
    __device__ bool next(int i, Unit& u) const {
        if (!so.next(i >> 1, u)) return false;
        u.e = i & 1; u.pnl = u.pn;
        if (u.e == 0) { u.pm += T / BM; u.pn += 4; }
        return true;
    }
    __device__ __forceinline__ int arow(const Unit&, int) const { return 0; }
};
struct MoeOrder {
    const LAS int* cum; const LAS int* cnt; const int* list; int G, c;
    __device__ bool next(int i, Unit& u) const {
        const int ntot = cum[NE]; int L;
        if ((G & 7) == 0) { const int x = c & 7, k = i * (G >> 3) + (c >> 3); const int rt = x + 8 * (k >> 2); if (rt >= ntot) return false; L = rt * 4 + (k & 3); }
        else { L = i * G + c; if (L >= ntot * 4) return false; }
        const int rtg = L >> 2; int e = 0;
#pragma unroll
        for (int k = 1; k < NE; ++k) e += (rtg >= cum[k]) ? 1 : 0;
        u.pm = rtg; u.e = e; u.pnl = L & 3; u.pn = e * 4 + (L & 3); return true;
    }
    __device__ __forceinline__ int arow(const Unit& u, int rl) const {
        const int pos = (u.pm - cum[u.e]) * BM + rl;
        int tok = 0; if (pos < cnt[u.e]) tok = list[u.e * LCAP + pos] >> 1;
        return tok;
    }
};

template <class Epi, class Sched, bool GATHER, bool AGRP = false>
__device__ __forceinline__ void gemm_phase(LAS unsigned char* lds, const int tid_in, const bf16_t* A, const bf16_t* Bt, const int K, const Sched& S, const Epi& E) {
    const int tid = tid_in, wid = __builtin_amdgcn_readfirstlane(tid >> 6), lane = tid & 63, wr = wid >> 2, wc = wid & 3, fr = lane & 15, fq = lane >> 4;
    const int nt = K / BK;
    unsigned voffB[2];
#pragma unroll
    for (int i = 0; i < 2; ++i) { int R, C; stage_rc(tid * 16 + i * 8192, R, C); const int Rb = Epi::PERM ? ((R & ~31) + perm32(R & 31)) : R; voffB[i] = (unsigned)(Rb * K + C) * 2u; }
    const size_t kstep = (size_t)(BK * 2);
    const size_t kstepA = AGRP ? (size_t)(BK / 16) * T * 32 : kstep;
    const size_t hstep = (size_t)HALF * K * 2;
    const size_t tstep = 2 * hstep;
    const unsigned ldsw = (unsigned)wid * 1024u;
    const int aoff = lds_byte(wr * 64 + fr, fq * 8), boff = lds_byte(wc * 32 + fr, fq * 8);
#define PG8_SA(b, h) (((b) * 2 + (h)) * HTB)
#define PG8_SB(b, h) ((4 + (b) * 2 + (h)) * HTB)
#define PG8_STAGE(bufoff, gbase, voff) do { _Pragma("unroll") for (int _i = 0; _i < 2; ++_i) \
        __builtin_amdgcn_global_load_lds((const unsigned*)((const char*)(gbase) + (voff)[_i]), (LAS unsigned*)(lds + (bufoff) + ldsw + _i * 8192), 16, 0, 0); } while (0)
#define PG8_STAGEA(bufoff, kt, o0, o1) do { const char* _g = (const char*)A + (size_t)(kt) * kstepA; \
        __builtin_amdgcn_global_load_lds((const unsigned*)(_g + (o0)), (LAS unsigned*)(lds + (bufoff) + ldsw), 16, 0, 0); \
        __builtin_amdgcn_global_load_lds((const unsigned*)(_g + (o1)), (LAS unsigned*)(lds + (bufoff) + ldsw + 8192), 16, 0, 0); } while (0)
#define PG8_LDA(dst, b, h) do { _Pragma("unroll") for (int m = 0; m < 4; ++m) _Pragma("unroll") for (int k = 0; k < 2; ++k) dst[m][k] = *(const LAS bf16x8*)(lds + PG8_SA(b, h) + aoff + m * 2048 + k * 1024); } while (0)
#define PG8_LDB(dst, b, h) do { _Pragma("unroll") for (int n = 0; n < 2; ++n) _Pragma("unroll") for (int k = 0; k < 2; ++k) dst[n][k] = *(const LAS bf16x8*)(lds + PG8_SB(b, h) + boff + n * 2048 + k * 1024); } while (0)
#define PG8_MMA(ai, bj, At, Bt_) do { __builtin_amdgcn_s_setprio(1); _Pragma("unroll") for (int m = 0; m < 4; ++m) _Pragma("unroll") for (int n = 0; n < 2; ++n) _Pragma("unroll") for (int k = 0; k < 2; ++k) \
        acc[ai][bj][m][n] = __builtin_amdgcn_mfma_f32_16x16x32_bf16(Bt_[n][k], At[m][k], acc[ai][bj][m][n], 0, 0, 0); __builtin_amdgcn_s_setprio(0); } while (0)
#define PG8_WAIT_V(n) asm volatile("s_waitcnt vmcnt(" #n ")" ::: "memory")
#define PG8_WAIT_L(n) asm volatile("s_waitcnt lgkmcnt(" #n ")" ::: "memory")
#define PG8_BAR __builtin_amdgcn_s_barrier()
#define PG8_SCHED __builtin_amdgcn_sched_barrier(0)
#define PG8_CALC_OFF(dst, U) do { _Pragma("unroll") for (int _h = 0; _h < 2; ++_h) _Pragma("unroll") for (int _i = 0; _i < 2; ++_i) { int _R, _C; stage_rc(tid * 16 + _i * 8192, _R, _C); const int _rl = _h * HALF + _R; \
        const unsigned _row = GATHER ? (unsigned)S.arow((U), _rl) : (unsigned)((U).pm * BM + _rl); dst[_h * 2 + _i] = AGRP ? (((unsigned)(_C >> 4) * (unsigned)T + _row) * 32u + (unsigned)((_C & 15) * 2)) : _row * (unsigned)(K * 2) + (unsigned)(_C * 2); } } while (0)
    Unit cur, nxt; int ui = 0;
    if (!S.next(0, cur)) return;
    f32x4 acc[2][2][4][2];
#pragma unroll
    for (int a = 0; a < 2; ++a)
#pragma unroll
        for (int b = 0; b < 2; ++b)
#pragma unroll
            for (int m = 0; m < 4; ++m)
#pragma unroll
                for (int n = 0; n < 2; ++n) acc[a][b][m][n] = (f32x4){0.f, 0.f, 0.f, 0.f};
    bf16x8 At[4][2], B0[2][2], B1[2][2];
    unsigned oc[4], on[4];
    PG8_CALC_OFF(oc, cur);
    const char* cB = (const char*)Bt + (size_t)cur.pn * tstep;
    PG8_STAGE(PG8_SB(0, 0), cB, voffB); PG8_STAGE(PG8_SB(0, 1), cB + hstep, voffB); PG8_STAGEA(PG8_SA(0, 0), 0, oc[0], oc[1]); PG8_STAGEA(PG8_SA(0, 1), 0, oc[2], oc[3]);
    if (wr == 1) PG8_BAR;
    PG8_WAIT_V(2); PG8_BAR;
    PG8_STAGE(PG8_SB(1, 0), cB + kstep, voffB); PG8_STAGEA(PG8_SA(1, 0), 1, oc[0], oc[1]); PG8_STAGE(PG8_SB(1, 1), cB + hstep + kstep, voffB);
    PG8_WAIT_V(6); PG8_BAR;
    for (;;) {
        const bool has_next = S.next(ui + 1, nxt);
        if (has_next) { PG8_CALC_OFF(on, nxt); } else {
#pragma unroll
            for (int q = 0; q < 4; ++q) on[q] = oc[q]; }
        const char* nB = has_next ? (const char*)Bt + (size_t)nxt.pn * tstep : cB;
        for (int t = 0; t < nt; t += 2) {
            const bool last = (t == nt - 2);
            const int k2 = last ? 0 : t + 2, k3 = k2 + 1;
            const unsigned s0 = last ? on[0] : oc[0], s1 = last ? on[1] : oc[1], s2 = last ? on[2] : oc[2], s3 = last ? on[3] : oc[3];
            const char* b2 = last ? nB : cB + (size_t)(t + 2) * kstep; const char* b3 = b2 + kstep;
            PG8_LDB(B0, 0, 0); PG8_LDB(B1, 0, 1); PG8_SCHED; PG8_LDA(At, 0, 0); PG8_STAGEA(PG8_SA(1, 1), t + 1, oc[2], oc[3]);
            PG8_WAIT_V(8); PG8_WAIT_L(0); PG8_BAR; PG8_MMA(0, 0, At, B0); PG8_MMA(0, 1, At, B1); PG8_BAR; PG8_SCHED;
            PG8_LDA(At, 0, 1); PG8_STAGE(PG8_SB(0, 0), b2, voffB); PG8_STAGE(PG8_SB(0, 1), b2 + hstep, voffB); PG8_STAGEA(PG8_SA(0, 0), k2, s0, s1);
            PG8_WAIT_V(8); PG8_WAIT_L(0); PG8_BAR; PG8_MMA(1, 0, At, B0); PG8_MMA(1, 1, At, B1); PG8_BAR; PG8_SCHED;
            PG8_LDB(B0, 1, 0); PG8_LDB(B1, 1, 1); PG8_SCHED; PG8_LDA(At, 1, 0); PG8_STAGEA(PG8_SA(0, 1), k2, s2, s3);
            PG8_WAIT_V(8); PG8_WAIT_L(0); PG8_BAR; PG8_MMA(0, 0, At, B0); PG8_MMA(0, 1, At, B1); PG8_BAR; PG8_SCHED;
            PG8_LDA(At, 1, 1); PG8_STAGE(PG8_SB(1, 0), b3, voffB); PG8_STAGE(PG8_SB(1, 1), b3 + hstep, voffB); PG8_STAGEA(PG8_SA(1, 0), k3, s0, s1);
            PG8_WAIT_V(8); PG8_WAIT_L(0); PG8_BAR; PG8_MMA(1, 0, At, B0); PG8_MMA(1, 1, At, B1); PG8_BAR; PG8_SCHED;
        }
        if (wr == 0) PG8_BAR;
        bool keep = false;
        if constexpr (Epi::KEEPS) keep = E.apply(acc, cur, wr, wc, fr, fq); else E(acc, cur, wr, wc, fr, fq);
        if (!has_next) break;
        if (!keep) {
#pragma unroll
        for (int a = 0; a < 2; ++a)
#pragma unroll
            for (int b = 0; b < 2; ++b)
#pragma unroll
                for (int m = 0; m < 4; ++m)
#pragma unroll
                    for (int n = 0; n < 2; ++n) acc[a][b][m][n] = (f32x4){0.f, 0.f, 0.f, 0.f};
        }
        cur = nxt; cB = nB; ++ui;
#pragma unroll
        for (int q = 0; q < 4; ++q) oc[q] = on[q];
        if (wr == 1) PG8_BAR;
    }
    PG8_WAIT_V(0);
    PG8_BAR;
#undef PG8_SA
#undef PG8_SB
#undef PG8_STAGE
#undef PG8_STAGEA
#undef PG8_LDA
#undef PG8_LDB
#undef PG8_MMA
#undef PG8_WAIT_V
#undef PG8_WAIT_L
#undef PG8_BAR
#undef PG8_SCHED
#undef PG8_CALC_OFF
}

typedef const f32x4 (&AccRef)[2][2][4][2];
__device__ __forceinline__ u32x4 pack8(f32x4 v0, f32x4 v1) { u32x4 w; w.x = pk2(v0[0], v0[1]); w.y = pk2(v0[2], v0[3]); w.z = pk2(v1[0], v1[1]); w.w = pk2(v1[2], v1[3]); return w; }
__device__ __forceinline__ void unpack8(u32x4 w, f32x4& v0, f32x4& v1) { v0 = (f32x4){bflo(w.x), bfhi(w.x), bflo(w.y), bfhi(w.y)}; v1 = (f32x4){bflo(w.z), bfhi(w.z), bflo(w.w), bfhi(w.w)}; }
__device__ __forceinline__ f32x4 sigm4(f32x4 v) { return (f32x4){sigm(v[0]), sigm(v[1]), sigm(v[2]), sigm(v[3])}; }

struct EpiIn {
    static constexpr bool PERM = true, KEEPS = false; bf16_t* Z; bf16_t* U;
    __device__ __forceinline__ void operator()(AccRef acc, const Unit& u, int wr, int wc, int fr, int fq) const {
        const int row0 = u.pm * BM + wr * 64 + fr; const bool gate = u.pnl >= 4;
        const int col0 = gate ? 1024 + (u.pnl - 4) * HALF + wc * 32 + 8 * fq : u.pnl * BM + wc * 32 + 8 * fq, cstep = gate ? 1024 : HALF;
#pragma unroll
        for (int ai = 0; ai < 2; ++ai)
#pragma unroll
            for (int m = 0; m < 4; ++m) { bf16_t* rowp = Z + (size_t)(row0 + ai * HALF + m * 16) * NZ + col0;
                f32x4 v0 = acc[ai][0][m][0], v1 = acc[ai][0][m][1], w0 = acc[ai][1][m][0], w1 = acc[ai][1][m][1];
                u32x4 pa = pack8(v0, v1);
                if (gate) { pa = pack8(sigm4(v0), sigm4(v1)); f32x4 p0, p1; unpack8(pa, p0, p1); w0 = sigm4(w0); w1 = sigm4(w1);
#pragma unroll
                    for (int k = 0; k < 4; ++k) { w0[k] *= __builtin_amdgcn_rcpf(fmaxf(p0[k], 1e-30f)); w1[k] *= __builtin_amdgcn_rcpf(fmaxf(p1[k], 1e-30f)); } }
                if (u.pnl == 2 || u.pnl == 3) {
                    const int uc = (u.pnl - 2) * BM + wc * 32 + 8 * fq; const size_t tok = (size_t)(row0 + ai * HALF + m * 16);
                    *(u32x4*)(U + ((size_t)(uc >> 4) * T + tok) * 16 + (uc & 8)) = pa; *(u32x4*)(U + ((size_t)((uc + HALF) >> 4) * T + tok) * 16 + (uc & 8)) = pack8(w0, w1);
                } else { *(u32x4*)rowp = pa; *(u32x4*)(rowp + cstep) = pack8(w0, w1); } }
    }
};
struct EpiGlu {
    static constexpr bool PERM = true, KEEPS = false; const bf16_t* YG; bf16_t* S; const float* gb;
    __device__ __forceinline__ void operator()(AccRef acc, const Unit& u, int wr, int wc, int fr, int fq) const {
        const int row0 = u.pm * BM + wr * 64 + fr, col0 = u.pnl * BM + wc * 32 + 8 * fq;
        f32x4 bv[2][2];
#pragma unroll
        for (int bj = 0; bj < 2; ++bj)
#pragma unroll
            for (int n = 0; n < 2; ++n) bv[bj][n] = *(const f32x4*)(gb + col0 + bj * HALF + 4 * n);
        u32x4 yv[2][4][2];
#pragma unroll
        for (int ai = 0; ai < 2; ++ai)
#pragma unroll
            for (int m = 0; m < 4; ++m)
#pragma unroll
                for (int bj = 0; bj < 2; ++bj) yv[ai][m][bj] = *(const u32x4*)(YG + ((size_t)((col0 + bj * HALF) >> 4) * T + (row0 + ai * HALF + m * 16)) * 16 + ((col0 + bj * HALF) & 8));
        __builtin_amdgcn_sched_barrier(0);
#pragma unroll
        for (int ai = 0; ai < 2; ++ai)
#pragma unroll
            for (int m = 0; m < 4; ++m) { const size_t off = (size_t)(row0 + ai * HALF + m * 16) * 512 + col0;
#pragma unroll
                for (int bj = 0; bj < 2; ++bj) { f32x4 y0, y1; unpack8(yv[ai][m][bj], y0, y1);
                    const f32x4 v0 = y0 * sigm4(acc[ai][bj][m][0] + bv[bj][0]), v1 = y1 * sigm4(acc[ai][bj][m][1] + bv[bj][1]);
                    *(u32x4*)(S + off + bj * HALF) = pack8(v0, v1); } }
    }
};
template <int MODE> struct EpiMerge {
    static constexpr bool PERM = true, KEEPS = false; bf16_t* Z; bf16_t* M;
    __device__ __forceinline__ void operator()(AccRef acc, const Unit& u, int wr, int wc, int fr, int fq) const {
        const int row0 = u.pm * BM + wr * 64 + fr, col0 = u.pnl * BM + wc * 32 + 8 * fq;
#pragma unroll
        for (int ai = 0; ai < 2; ++ai)
#pragma unroll
            for (int m = 0; m < 4; ++m) { bf16_t* rowp = Z + (size_t)(row0 + ai * HALF + m * 16) * NZ + col0;
#pragma unroll
                for (int bj = 0; bj < 2; ++bj) {
                    if (MODE == 0) { f32x4 g0, g1; unpack8(*(const u32x4*)(rowp + 1024 + bj * HALF), g0, g1);
                        *(u32x4*)(rowp + 1024 + bj * HALF) = pack8(g0 * acc[ai][bj][m][0], g1 * acc[ai][bj][m][1]); }
                    else { f32x4 g0, g1, t0, t1; unpack8(*(const u32x4*)(rowp + 2048 + bj * HALF), g0, g1); unpack8(*(const u32x4*)(rowp + 1024 + bj * HALF), t0, t1);
                        *(u32x4*)(M + (size_t)(row0 + ai * HALF + m * 16) * D + col0 + bj * HALF) = pack8(t0 + g0 * acc[ai][bj][m][0], t1 + g1 * acc[ai][bj][m][1]); } } }
    }
};
struct EpiM12 {
    static constexpr bool PERM = true, KEEPS = true; const bf16_t* Z; bf16_t* M;
    __device__ __forceinline__ bool apply(f32x4 (&acc)[2][2][4][2], const Unit& u, int wr, int wc, int fr, int fq) const {
        const int pmr = u.e == 0 ? u.pm - T / BM : u.pm; const int row0_ = pmr * BM + wr * 64 + fr, col0 = u.pnl * BM + wc * 32 + 8 * fq;
        if (u.e == 0) {
            const int row0 = row0_;
            u32x4 qv[2][4][2];
#pragma unroll
            for (int ai = 0; ai < 2; ++ai)
#pragma unroll
                for (int m = 0; m < 4; ++m)
#pragma unroll
                    for (int bj = 0; bj < 2; ++bj) qv[ai][m][bj] = *(const u32x4*)(Z + (size_t)(row0 + ai * HALF + m * 16) * NZ + col0 + bj * HALF + 2048);
            __builtin_amdgcn_sched_barrier(0);
#pragma unroll
            for (int ai = 0; ai < 2; ++ai)
#pragma unroll
                for (int m = 0; m < 4; ++m)
#pragma unroll
                    for (int bj = 0; bj < 2; ++bj) { f32x4 q0, q1; unpack8(qv[ai][m][bj], q0, q1); acc[ai][bj][m][0] *= q0; acc[ai][bj][m][1] *= q1; }
        } else {
            const int row0 = row0_;
            u32x4 pv[2][4][2];
#pragma unroll
            for (int ai = 0; ai < 2; ++ai)
#pragma unroll
                for (int m = 0; m < 4; ++m)
#pragma unroll
                    for (int bj = 0; bj < 2; ++bj) pv[ai][m][bj] = *(const u32x4*)(Z + (size_t)(row0 + ai * HALF + m * 16) * NZ + col0 + bj * HALF + 1024);
            __builtin_amdgcn_sched_barrier(0);
#pragma unroll
            for (int ai = 0; ai < 2; ++ai)
#pragma unroll
                for (int m = 0; m < 4; ++m)
#pragma unroll
                    for (int bj = 0; bj < 2; ++bj) { f32x4 p0, p1; unpack8(pv[ai][m][bj], p0, p1);
                        *(u32x4*)(M + (size_t)(row0 + ai * HALF + m * 16) * D + col0 + bj * HALF) = pack8(acc[ai][bj][m][0] * p0, acc[ai][bj][m][1] * p1); }
        }
        return u.e == 0;
    }
};
struct EpiCombo {
    static constexpr bool PERM = true, KEEPS = false; EpiMerge<0> em; EpiGlu eg;
    __device__ __forceinline__ void operator()(AccRef acc, const Unit& u, int wr, int wc, int fr, int fq) const {
        if (u.e == 0) em(acc, u, wr, wc, fr, fq);
        else { Unit v = u; v.pm = u.pm - (int)((WS_YG - WS_H) / ((size_t)BM * 1024)); eg(acc, v, wr, wc, fr, fq); }
    }
};
struct EpiOut {
    static constexpr bool PERM = false, KEEPS = false; bf16_t* XB; const float* g1; bf16_t* XBW;
    __device__ __forceinline__ void operator()(AccRef acc, const Unit& u, int wr, int wc, int fr, int fq) const {
        const bool lat = u.pm < TL / BM; const int brow = lat ? (u.pm >> 4) : 8;
        bf16_t* xb = XB + (size_t)u.pm * BM * D; bf16_t* xw = XBW + (size_t)u.pm * BM * D;
        const int row0 = wr * 64 + fr, col0 = u.pnl * BM + wc * 32 + 4 * fq;
        f32x4 gv[2][2];
#pragma unroll
        for (int bj = 0; bj < 2; ++bj)
#pragma unroll
            for (int n = 0; n < 2; ++n) gv[bj][n] = *(const f32x4*)(g1 + (size_t)brow * NMOD + col0 + bj * HALF + n * 16);
#pragma unroll
        for (int ai = 0; ai < 2; ++ai) { u32x2 xv[4][2][2];
#pragma unroll
            for (int m = 0; m < 4; ++m)
#pragma unroll
                for (int bj = 0; bj < 2; ++bj)
#pragma unroll
                    for (int n = 0; n < 2; ++n) xv[m][bj][n] = *(const u32x2*)(xb + (size_t)(row0 + ai * HALF + m * 16) * D + col0 + bj * HALF + n * 16);
            __builtin_amdgcn_sched_barrier(0);
#pragma unroll
            for (int m = 0; m < 4; ++m)
#pragma unroll
                for (int bj = 0; bj < 2; ++bj)
#pragma unroll
                    for (int n = 0; n < 2; ++n) { const u32x2 w = xv[m][bj][n]; const f32x4 xo = {bflo(w.x), bfhi(w.x), bflo(w.y), bfhi(w.y)};
                        st_bf4(xw + (size_t)(row0 + ai * HALF + m * 16) * D + col0 + bj * HALF + n * 16, xo + gv[bj][n] * acc[ai][bj][m][n]); } }
    }
};
struct EpiUp {
    static constexpr bool PERM = true, KEEPS = false; bf16_t* HM;
    __device__ __forceinline__ void operator()(AccRef acc, const Unit& u, int wr, int wc, int fr, int fq) const {
        const int row0 = u.pm * BM + wr * 64 + fr, col0 = u.pnl * HALF + wc * 32 + 8 * fq;
#pragma unroll
        for (int ai = 0; ai < 2; ++ai)
#pragma unroll
            for (int m = 0; m < 4; ++m) { f32x4 a0 = acc[ai][0][m][0], a1 = acc[ai][0][m][1]; const f32x4 b0 = acc[ai][1][m][0], b1 = acc[ai][1][m][1];
                a0 = a0 * sigm4(a0) * b0; a1 = a1 * sigm4(a1) * b1;
                *(u32x4*)(HM + (size_t)(row0 + ai * HALF + m * 16) * DE + col0) = pack8(a0, a1); }
    }
};
struct EpiDown {
    static constexpr bool PERM = true, KEEPS = false; bf16_t* SL; const int* list; const float* gw; const LAS int* cum; const LAS int* cnt;
    __device__ __forceinline__ void operator()(AccRef acc, const Unit& u, int wr, int wc, int fr, int fq) const {
        const int col0 = u.pnl * BM + wc * 32 + 8 * fq; const int pos0 = (u.pm - cum[u.e]) * BM + wr * 64 + fr, n_e = cnt[u.e];
        int ent[2][4]; float w[2][4];
#pragma unroll
        for (int ai = 0; ai < 2; ++ai)
#pragma unroll
            for (int m = 0; m < 4; ++m) { const int pos = pos0 + ai * HALF + m * 16; ent[ai][m] = pos < n_e ? list[u.e * LCAP + pos] : -1; }
#pragma unroll
        for (int ai = 0; ai < 2; ++ai)
#pragma unroll
            for (int m = 0; m < 4; ++m) w[ai][m] = ent[ai][m] >= 0 ? gw[ent[ai][m]] : 0.f;
#pragma unroll
        for (int ai = 0; ai < 2; ++ai)
#pragma unroll
            for (int m = 0; m < 4; ++m) asm volatile("" : "+v"(w[ai][m]));
#pragma unroll
        for (int ai = 0; ai < 2; ++ai)
#pragma unroll
            for (int m = 0; m < 4; ++m) if (ent[ai][m] >= 0) { bf16_t* rowp = SL + (size_t)ent[ai][m] * D + col0;
#pragma unroll
                for (int bj = 0; bj < 2; ++bj) *(u32x4*)(rowp + bj * HALF) = pack8(acc[ai][bj][m][0] * w[ai][m], acc[ai][bj][m][1] * w[ai][m]); }
    }
};
}

#define XB_TMO      128
#define XB_XCNT(j)  (256  + 64 * (j))
#define XB_XSUB(j)  (1280 + 64 * (j))
#define XB_XGEN(j)  (2304 + 64 * (j))
#define XB_TOP      3328
#define XB_TOPGEN   3392
#define XCD_BAR_WORDS 3456
#define XB_SPIN_CAP (1u << 22)

__device__ __forceinline__ unsigned xb_ld(unsigned* p)              { return __hip_atomic_load(p, __ATOMIC_RELAXED, __HIP_MEMORY_SCOPE_AGENT); }
__device__ __forceinline__ unsigned xb_add(unsigned* p, unsigned v) { return __hip_atomic_fetch_add(p, v, __ATOMIC_RELAXED, __HIP_MEMORY_SCOPE_AGENT); }
__device__ __forceinline__ unsigned xb_xcc_id() { return (unsigned)__builtin_amdgcn_s_getreg((3 << 11) | 20) & 0xFu; }
#define XB_SPIN(cond, bar) do { unsigned _sp = 0; while (cond) { __builtin_amdgcn_s_sleep(1); \
    if ((++_sp & 255u) == 0u) { if (xb_ld(&(bar)[XB_TMO])) break; if (_sp > XB_SPIN_CAP) { atomicAdd(&(bar)[XB_TMO], 1u); break; } } } } while (0)

struct XcdBarrier { unsigned* bar; unsigned x; volatile LAS unsigned* st; };
__device__ __forceinline__ XcdBarrier xcd_barrier_post(unsigned* bar, volatile LAS unsigned* st) {
    XcdBarrier b; b.bar = bar; b.x = xb_xcc_id(); b.st = st;
    if (threadIdx.x == 0) (void)xb_add(&bar[XB_XCNT(b.x)], 1u);
    return b;
}
__device__ __forceinline__ void xcd_barrier_complete(unsigned* bar, unsigned x_in, unsigned& nloc, unsigned& nx) {
    unsigned x = x_in;
    const unsigned G = gridDim.x * gridDim.y * gridDim.z;
    asm volatile("" : "+s"(x));
    unsigned sum, cnt, mine, sp = 0u;
    for (;;) {
        sum = 0u; cnt = 0u; mine = 0u;
#pragma unroll
        for (unsigned j = 0; j < 16; ++j) { const unsigned c = xb_ld(&bar[XB_XCNT(j)]); sum += c; cnt += (c > 0u) ? 1u : 0u; mine = (j == x) ? c : mine; }
        if (sum == G) break;
        __builtin_amdgcn_s_sleep(1);
        if ((++sp & 255u) == 0u) { if (xb_ld(&bar[XB_TMO])) break; if (sp > XB_SPIN_CAP) { atomicAdd(&bar[XB_TMO], 1u); break; } }
    }
    nloc = mine > 0u ? mine : 1u; nx = cnt > 0u ? cnt : 1u;
}
__device__ __forceinline__ void xcd_barrier(const XcdBarrier& b, const int tid) {
    asm volatile("s_waitcnt vmcnt(0)" ::: "memory");
    __syncthreads();
    if (tid == 0) {
        unsigned* bar = b.bar;
        __builtin_amdgcn_s_waitcnt(0);
        unsigned nloc = b.st[0], nx = b.st[1];
        if (nloc == 0u) { xcd_barrier_complete(bar, b.x, nloc, nx); b.st[0] = nloc; b.st[1] = nx; }
        const unsigned old = xb_add(&bar[XB_XSUB(b.x)], 1u);
        const unsigned gen = old / nloc;
        if (old + 1u == (gen + 1u) * nloc) {
            __builtin_amdgcn_fence(__ATOMIC_RELEASE, "agent");
            asm volatile("s_waitcnt vmcnt(0)" ::: "memory");
            const unsigned og = xb_add(&bar[XB_TOP], 1u);
            const unsigned tg = og / nx;
            if (og + 1u == (tg + 1u) * nx) xb_add(&bar[XB_TOPGEN], 1u);
            else XB_SPIN(xb_ld(&bar[XB_TOPGEN]) == tg, bar);
            __builtin_amdgcn_fence(__ATOMIC_ACQUIRE, "agent");
            xb_add(&bar[XB_XGEN(b.x)], 1u);
            asm volatile("s_waitcnt vmcnt(0)" ::: "memory");
        } else {
            XB_SPIN(xb_ld(&bar[XB_XGEN(b.x)]) == gen, bar);
            __builtin_amdgcn_fence(__ATOMIC_ACQUIRE, "agent");
            asm volatile("s_waitcnt vmcnt(0)" ::: "memory");
        }
    }
    __syncthreads();
}

constexpr int NWAVES = 8, NTHREADS = 512;
constexpr int RING_BYTES = 131072, MISC_OFF = RING_BYTES, LDS_BYTES = 163840;

struct KArgs {
    const float* in[30]; float* out; unsigned char* ws; int lo, hi;
};
constexpr int PTAB = 3072, WTAB = 3200;
constexpr int PTAB_DUMMY = 0;
struct Args {
    volatile LAS int* tab;
    __device__ __forceinline__ unsigned long long ld(int k) const { const unsigned lo = (unsigned)__builtin_amdgcn_readfirstlane(tab[2 * k]), hi = (unsigned)__builtin_amdgcn_readfirstlane(tab[2 * k + 1]); return ((unsigned long long)hi << 32) | lo; }
    __device__ __forceinline__ const float* in(int k) const { return (const float*)(const GAS float*)ld(k); }
    __device__ __forceinline__ float* out() const { return (float*)(GAS float*)ld(30); }
    __device__ __forceinline__ unsigned char* ws() const { return (unsigned char*)(GAS unsigned char*)ld(31); }
};

struct Ctx {
    LAS unsigned char* lds; volatile LAS int* misc;
    int tid, lane, wave, G, bid;
    unsigned char* ws;
};

__device__ __forceinline__ const float* xrow_in(const Args& a, int row) { return row < TL ? a.in(0) + (size_t)row * D : a.in(2) + (size_t)(row - TL) * D; }
__device__ __forceinline__ int brow_of(int row) { return row < TL ? (row >> 12) : 8; }

__device__ __forceinline__ void zoh(const Args& a, int idx  , float& abr, float& abi, float& fr_, float& fi_) {
    const float are = a.in(11)[idx], aim = a.in(12)[idx]; const float dt = expf(a.in(13)[idx >> 6]);
    const float mag = expf(are * dt); abr = mag * cosf(aim * dt); abi = mag * sinf(aim * dt);
    const float nr = abr - 1.0f, ni = abi, den = are * are + aim * aim;
    fr_ = (nr * are + ni * aim) / den; fi_ = (ni * are - nr * aim) / den;
}
__device__ __forceinline__ void zoh_fast(const Args& a, int idx, float& abr, float& abi, float& fr_, float& fi_) {
    const float are = a.in(11)[idx], aim = a.in(12)[idx]; const float dt = __expf(a.in(13)[idx >> 6]);
    const float mag = __expf(are * dt); abr = mag * __cosf(aim * dt); abi = mag * __sinf(aim * dt);
    const float nr = abr - 1.0f, ni = abi, den = __builtin_amdgcn_rcpf(are * are + aim * aim);
    fr_ = (nr * are + ni * aim) * den; fi_ = (ni * are - nr * aim) * den;
}
__device__ __forceinline__ void phase_p0(const Args& a, Ctx& c) {
    LAS float* sl = (LAS float*)c.lds;
    LAS float* part = (LAS float*)(c.lds + 9 * 1024 * 4);
    for (int i = c.tid; i < 9 * 1024; i += NTHREADS) { const float v = i < 8 * 1024 ? a.in(1)[i] : a.in(3)[i - 8 * 1024]; sl[i] = v * sigm(v); }
    __syncthreads();
    float* mods = (float*)(c.ws + WS_MODS);
    for (int it = c.bid; it < DEPTH * 96; it += c.G) {
        const int l = it / 96, col = (it % 96) * 64 + c.lane;
        const float* w = a.in(4) + (size_t)l * D * NMOD + col;
        float acc[9];
#pragma unroll
        for (int r = 0; r < 9; ++r) acc[r] = 0.f;
#pragma unroll 8
        for (int kk = 0; kk < 128; ++kk) { const int k = c.wave * 128 + kk; const float wv = w[(size_t)k * NMOD];
#pragma unroll
            for (int r = 0; r < 9; ++r) acc[r] += sl[r * 1024 + k] * wv; }
#pragma unroll
        for (int r = 0; r < 9; ++r) part[(c.wave * 9 + r) * 64 + c.lane] = acc[r];
        __syncthreads();
        for (int o = c.tid; o < 9 * 64; o += NTHREADS) { float s = 0.f;
#pragma unroll
            for (int w8 = 0; w8 < 8; ++w8) s += part[w8 * 576 + o];
            const int r = o >> 6, cc = (it % 96) * 64 + (o & 63); mods[((size_t)l * 9 + r) * NMOD + cc] = s + a.in(5)[(size_t)l * NMOD + cc]; }
        __syncthreads();
    }
    const int gt = c.bid * NTHREADS + c.tid, GT = c.G * NTHREADS;
    f32x2* AB = (f32x2*)(c.ws + WS_AB);
    for (int i = gt; i < DEPTH * 2 * 32 * 64; i += GT) { float abr, abi, fr_, fi_; zoh(a, i, abr, abi, fr_, fi_); AB[i] = (f32x2){abr, abi}; }
    u32x4* BF = (u32x4*)(c.ws + WS_BF);
    for (int i = gt; i < DEPTH * 2 * 32 * 4 * 64; i += GT) {
        const int ln = i & 63, f = (i >> 6) & 3, ldg = i >> 8; const int ri = f >> 1, tile = f & 1, p = tile * 32 + (ln & 31), hh = ln >> 5;
        float abr, abi, fr_, fi_; zoh(a, ldg * 64 + p, abr, abi, fr_, fi_);
        const float* bre = a.in(14) + ((size_t)ldg * 64 + p) * 16 + 8 * hh; const float* bim = a.in(15) + ((size_t)ldg * 64 + p) * 16 + 8 * hh;
        float v[8];
#pragma unroll
        for (int j = 0; j < 8; ++j) v[j] = ri == 0 ? fr_ * bre[j] - fi_ * bim[j] : fr_ * bim[j] + fi_ * bre[j];
        u32x4 o; o.x = f2bf(v[0]) | (f2bf(v[1]) << 16); o.y = f2bf(v[2]) | (f2bf(v[3]) << 16); o.z = f2bf(v[4]) | (f2bf(v[5]) << 16); o.w = f2bf(v[6]) | (f2bf(v[7]) << 16);
        BF[i] = o;
    }
    u32x4* CF = (u32x4*)(c.ws + WS_CF);
    for (int i = gt; i < DEPTH * 2 * 32 * 5 * 64; i += GT) {
        const int ln = i & 63, ks = (i >> 6) % 5, ldg = (i >> 6) / 5; const int j = ln & 15, q = ln >> 4; const int l = ldg >> 6, g = ldg & 31;
        const float* cre = a.in(16) + ((size_t)ldg * 16 + j) * 64; const float* cim = a.in(17) + ((size_t)ldg * 16 + j) * 64;
        float v[8];
#pragma unroll
        for (int e = 0; e < 8; ++e) { const int k = 32 * ks + 8 * q + e; float x;
            if (k < 128) { const int n = k >> 2, cm = k & 3; x = cm == 0 ? cre[n] : cm == 1 ? -cim[n] : cm == 2 ? cre[n + 32] : -cim[n + 32]; }
            else { const int jj = k - 128; x = (jj == j) ? a.in(18)[l * 512 + g * 16 + j] : 0.f; }
            v[e] = x; }
        u32x4 o; o.x = f2bf(v[0]) | (f2bf(v[1]) << 16); o.y = f2bf(v[2]) | (f2bf(v[3]) << 16); o.z = f2bf(v[4]) | (f2bf(v[5]) << 16); o.w = f2bf(v[6]) | (f2bf(v[7]) << 16);
        CF[i] = o;
    }
}

__device__ __forceinline__ void s3_tables(const Args& a, Ctx& c, const int wi, const int nw) {
    u32x4* TB = (u32x4*)(c.ws + WS_S3T);
    __syncthreads();
    LAS float* sC = (LAS float*)c.lds;
    LAS float* sB = sC + 2 * 16 * 65;
    LAS float* sA = sB + 2048;
    LAS float* sK = sA + 256;
    for (int ldg = wi; ldg < DEPTH * 2 * 32; ldg += nw) {
        const int l = ldg >> 6, dir = (ldg >> 5) & 1, g = ldg & 31;
        __syncthreads();
        for (int i = c.tid; i < 1024; i += NTHREADS) { const int o = i >> 6, n = i & 63; sC[o * 65 + n] = a.in(16)[(size_t)ldg * 1024 + i]; sC[16 * 65 + o * 65 + n] = a.in(17)[(size_t)ldg * 1024 + i]; }
        if (c.tid < 64) { float abr, abi, fr_, fi_; zoh(a, ldg * 64 + c.tid, abr, abi, fr_, fi_); sA[4 * c.tid] = abr; sA[4 * c.tid + 1] = abi; sA[4 * c.tid + 2] = fr_; sA[4 * c.tid + 3] = fi_; }
        __syncthreads();
        for (int i = c.tid; i < 1024; i += NTHREADS) { const int n = i >> 4; const float br = a.in(14)[(size_t)ldg * 1024 + i], bi = a.in(15)[(size_t)ldg * 1024 + i], fr_ = sA[4 * n + 2], fi_ = sA[4 * n + 3];
            sB[i] = fr_ * br - fi_ * bi; sB[1024 + i] = fr_ * bi + fi_ * br; }
        __syncthreads();
        for (int idx = c.tid; idx < 1024; idx += NTHREADS) { const int dd = idx >> 8, o = (idx >> 4) & 15, j = idx & 15; float acc = 0.f;
#pragma unroll 1
            for (int n0 = 0; n0 < 64; n0 += 8) {
                f32x4 ab[8]; float cr[8], ci[8], br[8], bi[8];
#pragma unroll
                for (int q = 0; q < 8; ++q) { const int n = n0 + q; ab[q] = *(const LAS f32x4*)(sA + 4 * n); cr[q] = sC[o * 65 + n]; ci[q] = sC[16 * 65 + o * 65 + n]; br[q] = sB[n * 16 + j]; bi[q] = sB[1024 + n * 16 + j]; }
                __builtin_amdgcn_sched_barrier(0);
#pragma unroll
                for (int q = 0; q < 8; ++q) { float pr = 1.f, pi = 0.f;
#pragma unroll
                    for (int e = 0; e < 3; ++e) if (e < dd) { const float t = pr * ab[q][0] - pi * ab[q][1], u = pr * ab[q][1] + pi * ab[q][0]; pr = t; pi = u; }
                    const float Gr = cr[q] * pr - ci[q] * pi, Gi = cr[q] * pi + ci[q] * pr; acc += Gr * br[q] - Gi * bi[q]; } }
            sK[idx] = acc; }
        __syncthreads();
        for (int en = c.tid; en < 40 * 64; en += NTHREADS) {
        const int ln = en & 63, f = en >> 6; const int col = ln & 31, kh = ln >> 5;
        float v[8];
#pragma unroll
        for (int j = 0; j < 8; ++j) v[j] = 0.f;
        if (f < 24) { const int ks = f / 6, nb = f % 6;
            if (nb < 4) { const int pst = (nb & 1) * 32 + col, comp = nb >> 1; const f32x4 ab = *(const LAS f32x4*)(sA + 4 * pst);
                const f32x4 br0 = *(const LAS f32x4*)(sB + pst * 16 + 8 * kh), br1 = *(const LAS f32x4*)(sB + pst * 16 + 8 * kh + 4), bi0 = *(const LAS f32x4*)(sB + 1024 + pst * 16 + 8 * kh), bi1 = *(const LAS f32x4*)(sB + 1024 + pst * 16 + 8 * kh + 4);
                float pr = 1.f, pi = 0.f; for (int e = 0; e < 3 - ks; ++e) { const float t = pr * ab[0] - pi * ab[1], u = pr * ab[1] + pi * ab[0]; pr = t; pi = u; }
#pragma unroll
                for (int j = 0; j < 4; ++j) { v[j] = comp == 0 ? pr * br0[j] - pi * bi0[j] : pr * bi0[j] + pi * br0[j]; v[4 + j] = comp == 0 ? pr * br1[j] - pi * bi1[j] : pr * bi1[j] + pi * br1[j]; }
            } else { const int sp = 2 * (nb - 4) + (col >> 4), o = col & 15, s1 = dir == 0 ? sp : 3 - sp;
                const int dd = s1 - ks;
                if (dd >= 0) { const f32x4 k0 = *(const LAS f32x4*)(sK + (dd * 16 + o) * 16 + 8 * kh), k1 = *(const LAS f32x4*)(sK + (dd * 16 + o) * 16 + 8 * kh + 4);
#pragma unroll
                    for (int j = 0; j < 4; ++j) { v[j] = k0[j]; v[4 + j] = k1[j]; } }
                if (dir == 0 && dd == 0) {
#pragma unroll
                    for (int j = 0; j < 8; ++j) if (8 * kh + j == o) v[j] += a.in(18)[l * 512 + g * 16 + o]; } }
        } else { const int kk = (f - 24) >> 1, nb = (f - 24) & 1; const int sp = 2 * nb + (col >> 4), o = col & 15, s1 = dir == 0 ? sp : 3 - sp;
            f32x4 ab[4]; float cr[4], ci[4];
#pragma unroll
            for (int q = 0; q < 4; ++q) { const int n = 8 * kk + 4 * kh + q; ab[q] = *(const LAS f32x4*)(sA + 4 * n); cr[q] = sC[o * 65 + n]; ci[q] = sC[16 * 65 + o * 65 + n]; }
            __builtin_amdgcn_sched_barrier(0);
#pragma unroll
            for (int q = 0; q < 4; ++q) { float pr = ab[q][0], pi = ab[q][1];
#pragma unroll
                for (int e = 0; e < 3; ++e) if (e < s1) { const float t = pr * ab[q][0] - pi * ab[q][1], u = pr * ab[q][1] + pi * ab[q][0]; pr = t; pi = u; }
                const float Gr = cr[q] * pr - ci[q] * pi, Gi = cr[q] * pi + ci[q] * pr; v[2 * q] = Gr; v[2 * q + 1] = -Gi; } }
        u32x4 o4; o4.x = f2bf(v[0]) | (f2bf(v[1]) << 16); o4.y = f2bf(v[2]) | (f2bf(v[3]) << 16); o4.z = f2bf(v[4]) | (f2bf(v[5]) << 16); o4.w = f2bf(v[6]) | (f2bf(v[7]) << 16);
        TB[(size_t)ldg * 2560 + en] = o4;
        }
    }
    __syncthreads();
}

template <class RowMap>
__device__ __forceinline__ void tr_item(const float* W, int ldn, int K, bf16_t* WT, const RowMap& rm, LAS bf16_t* scr, int kb, int nb, int lane) {
    const int k0 = 64 * kb, n0 = 64 * nb;
    f32x4 x[16];
#pragma unroll
    for (int i = 0; i < 16; ++i) x[i] = __builtin_nontemporal_load((const f32x4*)(W + (size_t)(k0 + 4 * i + (lane >> 4)) * ldn + n0 + (lane & 15) * 4));
#pragma unroll
    for (int i = 0; i < 16; ++i) { u32x2 w; w.x = pk2(x[i][0], x[i][1]); w.y = pk2(x[i][2], x[i][3]); *(LAS u32x2*)(scr + (4 * i + (lane >> 4)) * 72 + (lane & 15) * 4) = w; }
    LDS_WAIT(); asm volatile("" ::: "memory");
    const int cch = lane & 7;
#pragma unroll
    for (int j = 0; j < 8; ++j) { const int n = (lane >> 3) + 8 * j; const LAS bf16_t* sp = scr + (8 * cch) * 72 + n;
        u32x4 o; o.x = (unsigned)sp[0] | ((unsigned)sp[72] << 16); o.y = (unsigned)sp[2 * 72] | ((unsigned)sp[3 * 72] << 16); o.z = (unsigned)sp[4 * 72] | ((unsigned)sp[5 * 72] << 16); o.w = (unsigned)sp[6 * 72] | ((unsigned)sp[7 * 72] << 16);
        *(u32x4*)(WT + (size_t)rm(n0 + n) * K + k0 + 8 * cch) = o; }
    LDS_WAIT(); asm volatile("" ::: "memory");
}
struct RmId { int off; __device__ __forceinline__ int operator()(int n) const { return off + n; } };
struct RmW13 { int off; __device__ __forceinline__ int operator()(int n) const { return off + 256 * (n >> 7) + (n & 127); } };

__device__ __forceinline__ void norm_row(const Args& a, Ctx& c, int l, int row, int which  , f32x4 (&v)[4]) {
    float s = 0.f;
#pragma unroll
    for (int j = 0; j < 4; ++j) s += (v[j][0] * v[j][0] + v[j][1] * v[j][1]) + (v[j][2] * v[j][2] + v[j][3] * v[j][3]);
    const float rstd = 1.0f / sqrtf(wave_sum(s, c.lane) * (1.0f / D) + RMS_EPS);
    const float* gn = a.in(which ? 7 : 6) + (size_t)l * D; const float* md = (const float*)(c.ws + WS_MODS) + ((size_t)l * 9 + brow_of(row)) * NMOD + (which ? 3 * D : 0);
#pragma unroll
    for (int j = 0; j < 4; ++j) { const int col = 4 * c.lane + 256 * j; const f32x4 g = *(const f32x4*)(gn + col), sh = *(const f32x4*)(md + col), sc = *(const f32x4*)(md + D + col);
        v[j] = v[j] * rstd * g * (1.0f + sc) + sh; }
}
__device__ __forceinline__ void store_row_bf16(bf16_t* dst, int lane, const f32x4 (&v)[4]) {
#pragma unroll
    for (int j = 0; j < 4; ++j) { u32x2 w; w.x = pk2(v[j][0], v[j][1]); w.y = pk2(v[j][2], v[j][3]); *(u32x2*)(dst + 4 * lane + 256 * j) = w; }
}
__device__ __forceinline__ void load_x_row(const Args& a, Ctx& c, int l, int row, f32x4 (&v)[4]) {
    if (l == 0) { const float* xs = xrow_in(a, row); bf16_t* xb = (bf16_t*)(c.ws + WS_XB) + (size_t)row * D;
#pragma unroll
        for (int j = 0; j < 4; ++j) { v[j] = *(const f32x4*)(xs + 4 * c.lane + 256 * j); st_bf4(xb + 4 * c.lane + 256 * j, v[j]); }
    } else {
        bf16_t* xb = (bf16_t*)(c.ws + WS_XB) + (size_t)row * D;
        const bf16_t* sl = (const bf16_t*)(c.ws + WS_Z) + (size_t)row * 2 * D; const float* g2 = (const float*)(c.ws + WS_MODS) + ((size_t)(l - 1) * 9 + brow_of(row)) * NMOD + 5 * D;
#pragma unroll
        for (int j = 0; j < 4; ++j) { const int col = 4 * c.lane + 256 * j; const f32x4 g = *(const f32x4*)(g2 + col);
            v[j] = ld_bf4(xb + col) + g * (ld_bf4(sl + col) + ld_bf4(sl + D + col)); }
#pragma unroll
        for (int j = 0; j < 4; ++j) st_bf4(xb + 4 * c.lane + 256 * j, v[j]);
    }
}
constexpr int TR_I_IN = 16 * 48, TR_I_BS = 8 * 16, TR_I_OUT = 16 * 16, TR_I_GLU = 8 * 8, TR_I_W1 = 16 * 16 * 8, TR_I_W3 = TR_I_W1, TR_I_W2 = 16 * 8 * 16, TR_I_WC = 512;
constexpr int TR_NITEMS = TR_I_IN + TR_I_BS + TR_I_OUT + TR_I_GLU + TR_I_W1 + TR_I_W3 + TR_I_W2 + TR_I_WC;
struct RmGen { int off, w13; __device__ __forceinline__ int operator()(int n) const { return off + (w13 == 1 ? 256 * (n >> 7) + (n & 127) : (w13 == 2 && n >= 1024) ? 1024 + 256 * (((n - 1024) & 1023) >> 7) + 128 * ((n - 1024) >> 10) + (n & 127) : n); } };
__device__ __forceinline__ size_t wbuf_off(int l) { return (l & 1) ? WS_W2ND : WS_W; }
__device__ __forceinline__ void tr_one(const Args& a, Ctx& c, int l, int it, LAS bf16_t* scr) {
    bf16_t* WB = (bf16_t*)(c.ws + wbuf_off(l));
    int r = it;
    if (r < TR_NITEMS - TR_I_WC) {
        const float* src; int ldn, K, kb, nb; bf16_t* dst; RmGen rm{0, 0};
        if (r < TR_I_IN) { src = a.in(8) + (size_t)l * D * NZ; ldn = NZ; K = D; dst = WB + WO_WIN / 2; rm = RmGen{0, 2}; kb = r % 16; nb = r / 16; }
        else if ((r -= TR_I_IN) < TR_I_BS) { src = a.in(22) + (size_t)l * 512 * D; ldn = D; K = 512; dst = WB + WO_WBS / 2; kb = r % 8; nb = r / 8; }
        else if ((r -= TR_I_BS) < TR_I_OUT) { src = a.in(23) + (size_t)l * D * D; ldn = D; K = D; dst = WB + WO_WOUT / 2; kb = r % 16; nb = r / 16; }
        else if ((r -= TR_I_OUT) < TR_I_GLU) { src = a.in(19) + (size_t)l * 512 * 512; ldn = 512; K = 512; dst = WB + WO_GLU / 2; kb = r % 8; nb = r / 8; }
        else if ((r -= TR_I_GLU) < TR_I_W1) { const int e = r >> 7, q = r & 127; src = a.in(26) + ((size_t)l * NE + e) * D * DE; ldn = DE; K = D; dst = WB + WO_W13 / 2; rm = RmGen{e * 1024, 1}; kb = q % 16; nb = q / 16; }
        else if ((r -= TR_I_W1) < TR_I_W3) { const int e = r >> 7, q = r & 127; src = a.in(27) + ((size_t)l * NE + e) * D * DE; ldn = DE; K = D; dst = WB + WO_W13 / 2; rm = RmGen{e * 1024 + 128, 1}; kb = q % 16; nb = q / 16; }
        else { r -= TR_I_W3; const int e = r >> 7, q = r & 127; src = a.in(28) + ((size_t)l * NE + e) * DE * D; ldn = D; K = DE; dst = WB + WO_W2 / 2; rm = RmGen{e * 1024, 0}; kb = q % 8; nb = q / 8; }
        tr_item(src, ldn, K, dst, rm, scr, kb, nb, c.lane);
    } else {
        r -= TR_NITEMS - TR_I_WC;
        {
            const int g = r >> 7, cb = (r >> 4) & 7, db = r & 15, d = db * 64 + c.lane;
            const float* pw = a.in(9) + ((size_t)l * 4 + g) * 128 * 128 + (size_t)(cb * 16) * 128; const float* ps = a.in(10) + (size_t)l * 512 + g * 128;
            const float* wb = a.in(21) + ((size_t)l * 512 + g * 128) * D + d;
            LAS float* pl = (LAS float*)scr;
#pragma unroll
            for (int i = 0; i < 8; ++i) { const int e = i * 256 + c.lane * 4, q = e >> 7, c2 = e & 127; const f32x4 x = *(const f32x4*)(pw + e), sc4 = *(const f32x4*)(ps + c2);
                pl[(c2 + 0) * 16 + q] = x[0] * sc4[0]; pl[(c2 + 1) * 16 + q] = x[1] * sc4[1]; pl[(c2 + 2) * 16 + q] = x[2] * sc4[2]; pl[(c2 + 3) * 16 + q] = x[3] * sc4[3]; }
            LDS_WAIT(); asm volatile("" ::: "memory");
            float acc[16];
#pragma unroll
            for (int q = 0; q < 16; ++q) acc[q] = 0.f;
#pragma unroll 8
            for (int c2 = 0; c2 < 128; ++c2) { const float x = wb[(size_t)c2 * D]; const LAS f32x4* p4 = (const LAS f32x4*)(pl + c2 * 16);
#pragma unroll
                for (int q4 = 0; q4 < 4; ++q4) { const f32x4 w4 = p4[q4]; acc[q4 * 4 + 0] += w4[0] * x; acc[q4 * 4 + 1] += w4[1] * x; acc[q4 * 4 + 2] += w4[2] * x; acc[q4 * 4 + 3] += w4[3] * x; } }
            u32x4 o0, o1; o0.x = pk2(acc[0], acc[1]); o0.y = pk2(acc[2], acc[3]); o0.z = pk2(acc[4], acc[5]); o0.w = pk2(acc[6], acc[7]);
            o1.x = pk2(acc[8], acc[9]); o1.y = pk2(acc[10], acc[11]); o1.z = pk2(acc[12], acc[13]); o1.w = pk2(acc[14], acc[15]);
            bf16_t* dst = WB + WO_WC / 2 + (size_t)d * 512 + g * 128 + cb * 16; *(u32x4*)dst = o0; *(u32x4*)(dst + 8) = o1;
            LDS_WAIT(); asm volatile("" ::: "memory");
        }
    }
}
__device__ __forceinline__ void tr_range(const Args& a, Ctx& c, int l, int first, int last, int w, int nw) {
    LAS bf16_t* scr = (LAS bf16_t*)(c.lds + c.wave * 16384);
#pragma unroll 1
    for (int it = first + w; it < last; it += nw) tr_one(a, c, l, it, scr);
}
constexpr int TR_SPLIT = 3000, TR_SPLIT2 = 5500;
__device__ __forceinline__ void phase_a(const Args& a, Ctx& c, int l, const bool dummy = false) {
    const int gw = c.bid * NWAVES + c.wave, NGW = c.G * NWAVES;
    bf16_t* H = (bf16_t*)(c.ws + (dummy ? WS_HMID : WS_H)); bf16_t* XB = (bf16_t*)(c.ws + WS_XB); bf16_t* XBW = (bf16_t*)(c.ws + (dummy ? WS_HMID : WS_XB));
    const int rpb = (T + c.G - 1) / c.G, rbeg = c.bid * rpb + c.wave, rend = (c.bid + 1) * rpb < T ? (c.bid + 1) * rpb : T;
    f32x4 pg[4], psh[4], pg2[4]; int cur_b = -1; u32x2 nx[4], ns0[4], ns1[4];
    for (int row = rbeg; row < rend; row += NWAVES) {
        const int br = brow_of(row);
        if (br != cur_b) { cur_b = br;
            const float* gn = a.in(6) + (size_t)l * D; const float* md = (const float*)(c.ws + WS_MODS) + ((size_t)l * 9 + br) * NMOD;
            const float* g2 = (const float*)(c.ws + WS_MODS) + ((size_t)(l > 0 ? l - 1 : 0) * 9 + br) * NMOD + 5 * D;
#pragma unroll
            for (int j = 0; j < 4; ++j) { const int col = 4 * c.lane + 256 * j; pg[j] = *(const f32x4*)(gn + col) * (1.0f + *(const f32x4*)(md + D + col)); psh[j] = *(const f32x4*)(md + col); pg2[j] = *(const f32x4*)(g2 + col); } }
        f32x4 v[4];
        if (l == 0) { const float* xs = xrow_in(a, row);
#pragma unroll
            for (int j = 0; j < 4; ++j) v[j] = *(const f32x4*)(xs + 4 * c.lane + 256 * j);
        } else {
            if (row == rbeg) { const bf16_t* xb = XB + (size_t)row * D; const bf16_t* sl = (const bf16_t*)(c.ws + WS_Z) + (size_t)row * 2 * D;
#pragma unroll
                for (int j = 0; j < 4; ++j) { const int col = 4 * c.lane + 256 * j; nx[j] = *(const u32x2*)(xb + col); ns0[j] = *(const u32x2*)(sl + col); ns1[j] = *(const u32x2*)(sl + D + col); } }
            u32x2 cx[4], cs0[4], cs1[4];
#pragma unroll
            for (int j = 0; j < 4; ++j) { cx[j] = nx[j]; cs0[j] = ns0[j]; cs1[j] = ns1[j]; }
            if (row + NWAVES < rend) { const bf16_t* xb = XB + (size_t)(row + NWAVES) * D; const bf16_t* sl = (const bf16_t*)(c.ws + WS_Z) + (size_t)(row + NWAVES) * 2 * D;
#pragma unroll
                for (int j = 0; j < 4; ++j) { const int col = 4 * c.lane + 256 * j; nx[j] = *(const u32x2*)(xb + col); ns0[j] = *(const u32x2*)(sl + col); ns1[j] = *(const u32x2*)(sl + D + col); } }
#pragma unroll
            for (int j = 0; j < 4; ++j) { const f32x4 xv = {bflo(cx[j].x), bfhi(cx[j].x), bflo(cx[j].y), bfhi(cx[j].y)};
                const f32x4 y = {bflo(cs0[j].x) + bflo(cs1[j].x), bfhi(cs0[j].x) + bfhi(cs1[j].x), bflo(cs0[j].y) + bflo(cs1[j].y), bfhi(cs0[j].y) + bfhi(cs1[j].y)};
                v[j] = xv + pg2[j] * y; } }
        float ss = 0.f;
#pragma unroll
        for (int j = 0; j < 4; ++j) { st_bf4(XBW + (size_t)row * D + 4 * c.lane + 256 * j, v[j]); ss += (v[j][0] * v[j][0] + v[j][1] * v[j][1]) + (v[j][2] * v[j][2] + v[j][3] * v[j][3]); }
        const float rstd = 1.0f / sqrtf(wave_sum(ss, c.lane) * (1.0f / D) + RMS_EPS);
#pragma unroll
        for (int j = 0; j < 4; ++j) v[j] = v[j] * rstd * pg[j] + psh[j];
        store_row_bf16(H + (size_t)row * D, c.lane, v);
    }
}

__device__ __forceinline__ float fma_v(float a, float b, float c) { float d; asm("v_fma_f32 %0, %1, %2, %3" : "=v"(d) : "v"(a), "v"(b), "v"(c)); return d; }
__device__ __forceinline__ int tok_row(int b, int tc, int i) { return tc < 4 ? TL + b * CTXL + tc * 64 + i : b * SEQ + (tc - 4) * 64 + i; }
__device__ __forceinline__ int scan_chunk(int tc, int dir) { return dir == 0 ? tc : (tc < 4 ? 3 - tc : 71 - tc); }
__device__ __forceinline__ size_t car_idx(int b, int g, int dir, int cc, int n) { return ((((size_t)b * 32 + g) * 2 + dir) * NCH + cc) * 32 + n; }

#define S5_TILE(READ, dirv, tau)                                                                                                               \
    {                                                                                                                                          \
        const int r_ = lane & 31, sq_ = (r_ >> 2) & 1, stp_ = (r_ & 3) + 4 * (r_ >> 3);                                                        \
        const int ti_ = (dirv) == 0 ? 16 * (tau) + stp_ : 16 * (tau) + 15 - stp_;                                                              \
        const bf16x8 af_ = *(const bf16x8*)(Z + (size_t)tok_row(2 * bp + sq_, tc, ti_) * NZ + 512 + 16 * g + 8 * hh);                          \
        __builtin_amdgcn_sched_barrier(0);                                                                                                     \
        const f32x16 z16_ = {0.f, 0.f, 0.f, 0.f, 0.f, 0.f, 0.f, 0.f, 0.f, 0.f, 0.f, 0.f, 0.f, 0.f, 0.f, 0.f};                                  \
        f32x16 ur0_ = __builtin_amdgcn_mfma_f32_32x32x16_bf16(af_, bfr[0], z16_, 0, 0, 0);                                               \
        f32x16 ur1_ = __builtin_amdgcn_mfma_f32_32x32x16_bf16(af_, bfr[1], z16_, 0, 0, 0);                                               \
        f32x16 ui0_ = __builtin_amdgcn_mfma_f32_32x32x16_bf16(af_, bfr[2], z16_, 0, 0, 0);                                               \
        f32x16 ui1_ = __builtin_amdgcn_mfma_f32_32x32x16_bf16(af_, bfr[3], z16_, 0, 0, 0);                                                     \
        __builtin_amdgcn_sched_barrier(0);                                                                                                     \
        asm volatile("s_nop 15\n\ts_nop 15" : "+v"(ur0_), "+v"(ur1_), "+v"(ui0_), "+v"(ui1_) : "v"(af_), "v"(bfr[0]), "v"(bfr[1]), "v"(bfr[2]), "v"(bfr[3]));   \
        __builtin_amdgcn_sched_barrier(0);                                                                                                     \
        _Pragma("unroll") for (int i_ = 0; i_ < 16; ++i_) {                                                                                    \
              \
            const float n0_ = fma_v(ar0, hr0, fma_v(nai0, hi0, ur0_[i_])), m0_ = fma_v(ar0, hi0, fma_v(ai0, hr0, ui0_[i_]));                    \
            const float n1_ = fma_v(ar1, hr1, fma_v(nai1, hi1, ur1_[i_])), m1_ = fma_v(ar1, hi1, fma_v(ai1, hr1, ui1_[i_]));                    \
            hr0 = n0_; hi0 = m0_; hr1 = n1_; hi1 = m1_;                                                                                        \
            if (READ) { u32x2 w_; w_.x = pk2(hr0, hi0); w_.y = pk2(hr1, hi1); *(LAS u32x2*)(img + (hh * 16 + i_) * IMG_STRIDE + (lane & 31) * 8) = w_; } \
        }                                                                                                                                      \
        if (READ && (dirv) == 0) *(LAS bf16x8*)(img + (sq_ * 16 + stp_) * IMG_STRIDE + 256 + hh * 16) = af_;                                   \
    }

#define S5_TILEP(READ, dirv, tau, afv)                                                                                                               \
    {                                                                                                                                          \
        const int r_ = lane & 31, sq_ = (r_ >> 2) & 1, stp_ = (r_ & 3) + 4 * (r_ >> 3);                                                        \
        const int ti_ = (dirv) == 0 ? 16 * (tau) + stp_ : 16 * (tau) + 15 - stp_;                                                              \
        const bf16x8 af_ = (afv);                          \
        __builtin_amdgcn_sched_barrier(0);                                                                                                     \
        const f32x16 z16_ = {0.f, 0.f, 0.f, 0.f, 0.f, 0.f, 0.f, 0.f, 0.f, 0.f, 0.f, 0.f, 0.f, 0.f, 0.f, 0.f};                                  \
        f32x16 ur0_ = __builtin_amdgcn_mfma_f32_32x32x16_bf16(af_, bfr[0], z16_, 0, 0, 0);                                               \
        f32x16 ur1_ = __builtin_amdgcn_mfma_f32_32x32x16_bf16(af_, bfr[1], z16_, 0, 0, 0);                                               \
        f32x16 ui0_ = __builtin_amdgcn_mfma_f32_32x32x16_bf16(af_, bfr[2], z16_, 0, 0, 0);                                               \
        f32x16 ui1_ = __builtin_amdgcn_mfma_f32_32x32x16_bf16(af_, bfr[3], z16_, 0, 0, 0);                                                     \
        __builtin_amdgcn_sched_barrier(0);                                                                                                     \
        asm volatile("s_nop 15\n\ts_nop 15" : "+v"(ur0_), "+v"(ur1_), "+v"(ui0_), "+v"(ui1_) : "v"(af_), "v"(bfr[0]), "v"(bfr[1]), "v"(bfr[2]), "v"(bfr[3]));   \
        __builtin_amdgcn_sched_barrier(0);                                                                                                     \
        _Pragma("unroll") for (int i_ = 0; i_ < 16; ++i_) {                                                                                    \
              \
            const float n0_ = fma_v(ar0, hr0, fma_v(nai0, hi0, ur0_[i_])), m0_ = fma_v(ar0, hi0, fma_v(ai0, hr0, ui0_[i_]));                    \
            const float n1_ = fma_v(ar1, hr1, fma_v(nai1, hi1, ur1_[i_])), m1_ = fma_v(ar1, hi1, fma_v(ai1, hr1, ui1_[i_]));                    \
            hr0 = n0_; hi0 = m0_; hr1 = n1_; hi1 = m1_;                                                                                        \
            if (READ) { u32x2 w_; w_.x = pk2(hr0, hi0); w_.y = pk2(hr1, hi1); *(LAS u32x2*)(img + (hh * 16 + i_) * IMG_STRIDE + (lane & 31) * 8) = w_; } \
        }                                                                                                                                      \
        if (READ && (dirv) == 0) *(LAS bf16x8*)(img + (sq_ * 16 + stp_) * IMG_STRIDE + 256 + hh * 16) = af_;                                   \
    }

__device__ __forceinline__ bf16x8 s5_afrag(const bf16_t* Z, int bp, int tc, int g, int dir, int tau, int lane) {
    const int r = lane & 31, sq = (r >> 2) & 1, stp = (r & 3) + 4 * (r >> 3), hh = lane >> 5;
    const int ti = dir == 0 ? 16 * tau + stp : 16 * tau + 15 - stp;
    return *(const bf16x8*)(Z + ((size_t)g * T + tok_row(2 * bp + sq, tc, ti)) * 16 + 8 * hh);
}
__device__ __forceinline__ bf16x8 s1_afrag(const bf16_t* Z, int bp, int tc, int g, int dir, int ks, int lane) {
    const int r = lane & 31, sq = (r >> 2) & 1, b4 = (r & 3) + 4 * (r >> 3), hh = lane >> 5;
    const int sg = 4 * b4 + ks, ti = dir == 0 ? sg : 63 - sg;
    return *(const bf16x8*)(Z + ((size_t)g * T + tok_row(2 * bp + sq, tc, ti)) * 16 + 8 * hh);
}
__device__ __forceinline__ void phase_s1(const Args& a, Ctx& c, int l, size_t dst_off = WS_CAR) {
    const bf16_t* Z = (const bf16_t*)(c.ws + WS_U); f32x4* CAR = (f32x4*)(c.ws + dst_off);
    const f32x2* AB = (const f32x2*)(c.ws + WS_AB); const bf16x8* BF = (const bf16x8*)(c.ws + WS_BF);
    const int lane = c.lane, hh = lane >> 5;
    constexpr int NT1 = 4 * NCH * 8;
    const int dir = c.wave & 1;
    int cur_ldg = -1; float qr0 = 0.f, qi0 = 0.f, qr1 = 0.f, qi1 = 0.f, nqi0 = 0.f, nqi1 = 0.f; bf16x8 W[4][4], afc[4], afn[4];
#pragma unroll
    for (int f = 0; f < 4; ++f) { afc[f] = (bf16x8){0, 0, 0, 0, 0, 0, 0, 0}; afn[f] = afc[f];
#pragma unroll
        for (int k = 0; k < 4; ++k) W[k][f] = afc[f]; }
    if (c.bid < NT1) { const int bt = c.bid, rest = bt >> 3, tc = rest % NCH, bp = rest / NCH, g = (bt & 7) * 4 + (c.wave >> 1);
#pragma unroll
        for (int ks = 0; ks < 4; ++ks) afc[ks] = s1_afrag(Z, bp, tc, g, dir, ks, lane); }
    for (int bt = c.bid; bt < NT1; bt += c.G) {
        const int gq = bt & 7, rest = bt >> 3, tc = rest % NCH, bp = rest / NCH; const int g = gq * 4 + (c.wave >> 1);
        const int ldg = (l * 2 + dir) * 32 + g;
        if (ldg != cur_ldg) { cur_ldg = ldg;
            const f32x2 a0 = AB[ldg * 64 + (lane & 31)], a1 = AB[ldg * 64 + 32 + (lane & 31)];
            u32x4 bw[4];
#pragma unroll
            for (int f = 0; f < 4; ++f) bw[f] = __builtin_bit_cast(u32x4, BF[(ldg * 4 + f) * 64 + lane]);
            f32x4 br0a, br0b, br1a, br1b, bi0a, bi0b, bi1a, bi1b; pg8::unpack8(bw[0], br0a, br0b); pg8::unpack8(bw[1], br1a, br1b); pg8::unpack8(bw[2], bi0a, bi0b); pg8::unpack8(bw[3], bi1a, bi1b);
            float pr0 = 1.f, pi0 = 0.f, pr1 = 1.f, pi1 = 0.f;
#pragma unroll
            for (int ks = 3; ks >= 0; --ks) {
                W[ks][0] = __builtin_bit_cast(bf16x8, pg8::pack8(br0a * pr0 - bi0a * pi0, br0b * pr0 - bi0b * pi0));
                W[ks][1] = __builtin_bit_cast(bf16x8, pg8::pack8(br1a * pr1 - bi1a * pi1, br1b * pr1 - bi1b * pi1));
                W[ks][2] = __builtin_bit_cast(bf16x8, pg8::pack8(bi0a * pr0 + br0a * pi0, bi0b * pr0 + br0b * pi0));
                W[ks][3] = __builtin_bit_cast(bf16x8, pg8::pack8(bi1a * pr1 + br1a * pi1, bi1b * pr1 + br1b * pi1));
                const float t0 = pr0 * a0.x - pi0 * a0.y, u0 = pr0 * a0.y + pi0 * a0.x, t1 = pr1 * a1.x - pi1 * a1.y, u1 = pr1 * a1.y + pi1 * a1.x; pr0 = t0; pi0 = u0; pr1 = t1; pi1 = u1; }
            qr0 = pr0; qi0 = pi0; nqi0 = -pi0; qr1 = pr1; qi1 = pi1; nqi1 = -pi1; }
        const int nb = bt + c.G;
        if (nb < NT1) { const int nrest = nb >> 3, ntc = nrest % NCH, nbp = nrest / NCH, ng = (nb & 7) * 4 + (c.wave >> 1);
#pragma unroll
            for (int ks = 0; ks < 4; ++ks) afn[ks] = s1_afrag(Z, nbp, ntc, ng, dir, ks, lane); }
        const f32x16 z16 = {0.f, 0.f, 0.f, 0.f, 0.f, 0.f, 0.f, 0.f, 0.f, 0.f, 0.f, 0.f, 0.f, 0.f, 0.f, 0.f};
        f32x16 cr0 = z16, cr1 = z16, ci0 = z16, ci1 = z16;
        __builtin_amdgcn_sched_barrier(0);
#pragma unroll
        for (int ks = 0; ks < 4; ++ks) {
            cr0 = __builtin_amdgcn_mfma_f32_32x32x16_bf16(afc[ks], W[ks][0], cr0, 0, 0, 0);
            cr1 = __builtin_amdgcn_mfma_f32_32x32x16_bf16(afc[ks], W[ks][1], cr1, 0, 0, 0);
            ci0 = __builtin_amdgcn_mfma_f32_32x32x16_bf16(afc[ks], W[ks][2], ci0, 0, 0, 0);
            ci1 = __builtin_amdgcn_mfma_f32_32x32x16_bf16(afc[ks], W[ks][3], ci1, 0, 0, 0); }
        __builtin_amdgcn_sched_barrier(0);
        asm volatile("s_nop 15\n\ts_nop 15" : "+v"(cr0), "+v"(cr1), "+v"(ci0), "+v"(ci1) : "v"(afc[0]), "v"(afc[1]), "v"(afc[2]), "v"(afc[3]));
        __builtin_amdgcn_sched_barrier(0);
        float hr0 = 0.f, hi0 = 0.f, hr1 = 0.f, hi1 = 0.f;
#pragma unroll
        for (int i = 0; i < 16; ++i) {
            const float n0 = fma_v(qr0, hr0, fma_v(nqi0, hi0, cr0[i])), m0 = fma_v(qr0, hi0, fma_v(qi0, hr0, ci0[i]));
            const float n1 = fma_v(qr1, hr1, fma_v(nqi1, hi1, cr1[i])), m1 = fma_v(qr1, hi1, fma_v(qi1, hr1, ci1[i]));
            hr0 = n0; hi0 = m0; hr1 = n1; hi1 = m1; }
#pragma unroll
        for (int ks = 0; ks < 4; ++ks) afc[ks] = afn[ks];
        CAR[car_idx(2 * bp + hh, g, dir, scan_chunk(tc, dir), lane & 31)] = (f32x4){hr0, hi0, hr1, hi1};
    }
}
__device__ __forceinline__ void phase_s12(const Args& a, Ctx& c, int l) {
    const bf16_t* Z = (const bf16_t*)(c.ws + WS_U); f32x4* HIN = (f32x4*)(c.ws + WS_CAR2);
    const f32x2* AB = (const f32x2*)(c.ws + WS_AB); const bf16x8* BF = (const bf16x8*)(c.ws + WS_BF);
    const int lane = c.lane, hh = lane >> 5;
    LAS f32x4* pre = (LAS f32x4*)(c.lds + c.wave * (9 * 1024));
    LAS f32x4* exch = (LAS f32x4*)(c.lds + 8 * 9 * 1024);
    const int s0 = c.wave < 4 ? 9 * c.wave : 36 + 8 * (c.wave - 4), len = c.wave < 4 ? 9 : 8;
    for (int ct = c.bid; ct < 4 * 32 * 2; ct += c.G) {
        const int bp = ct >> 6, g = (ct >> 1) & 31, dir = ct & 1; const int ldg = (l * 2 + dir) * 32 + g;
        bf16x8 W[4][4]; float qr0, qi0, qr1, qi1, nqi0, nqi1;
        {   const f32x2 a0 = AB[ldg * 64 + (lane & 31)], a1 = AB[ldg * 64 + 32 + (lane & 31)];
            u32x4 bw[4];
#pragma unroll
            for (int f = 0; f < 4; ++f) bw[f] = __builtin_bit_cast(u32x4, BF[(ldg * 4 + f) * 64 + lane]);
            f32x4 br0a, br0b, br1a, br1b, bi0a, bi0b, bi1a, bi1b; pg8::unpack8(bw[0], br0a, br0b); pg8::unpack8(bw[1], br1a, br1b); pg8::unpack8(bw[2], bi0a, bi0b); pg8::unpack8(bw[3], bi1a, bi1b);
            float pr0 = 1.f, pi0 = 0.f, pr1 = 1.f, pi1 = 0.f;
#pragma unroll
            for (int ks = 3; ks >= 0; --ks) {
                W[ks][0] = __builtin_bit_cast(bf16x8, pg8::pack8(br0a * pr0 - bi0a * pi0, br0b * pr0 - bi0b * pi0));
                W[ks][1] = __builtin_bit_cast(bf16x8, pg8::pack8(br1a * pr1 - bi1a * pi1, br1b * pr1 - bi1b * pi1));
                W[ks][2] = __builtin_bit_cast(bf16x8, pg8::pack8(bi0a * pr0 + br0a * pi0, bi0b * pr0 + br0b * pi0));
                W[ks][3] = __builtin_bit_cast(bf16x8, pg8::pack8(bi1a * pr1 + br1a * pi1, bi1b * pr1 + br1b * pi1));
                const float t0 = pr0 * a0.x - pi0 * a0.y, u0 = pr0 * a0.y + pi0 * a0.x, t1 = pr1 * a1.x - pi1 * a1.y, u1 = pr1 * a1.y + pi1 * a1.x; pr0 = t0; pi0 = u0; pr1 = t1; pi1 = u1; }
            qr0 = pr0; qi0 = pi0; nqi0 = -pi0; qr1 = pr1; qi1 = pi1; nqi1 = -pi1; }
        bf16x8 afc[4], afn[4];
        { const int cc = s0, tc = dir == 0 ? cc : (cc < 4 ? 3 - cc : 71 - cc);
#pragma unroll
            for (int ks = 0; ks < 4; ++ks) { afc[ks] = s1_afrag(Z, bp, tc, g, dir, ks, lane); afn[ks] = afc[ks]; } }
        float hr0 = 0.f, hi0 = 0.f, hr1 = 0.f, hi1 = 0.f;
        __syncthreads();
#pragma unroll 1
        for (int k = 0; k < len; ++k) {
            if (k + 1 < len) { const int cc = s0 + k + 1, tc = dir == 0 ? cc : (cc < 4 ? 3 - cc : 71 - cc);
#pragma unroll
                for (int ks = 0; ks < 4; ++ks) afn[ks] = s1_afrag(Z, bp, tc, g, dir, ks, lane); }
            const f32x16 z16 = {0.f, 0.f, 0.f, 0.f, 0.f, 0.f, 0.f, 0.f, 0.f, 0.f, 0.f, 0.f, 0.f, 0.f, 0.f, 0.f};
            f32x16 cr0 = z16, cr1 = z16, ci0 = z16, ci1 = z16;
            asm volatile("" : "+v"(cr0), "+v"(cr1), "+v"(ci0), "+v"(ci1));
            __builtin_amdgcn_sched_barrier(0);
#pragma unroll
            for (int ks = 0; ks < 4; ++ks) {
                cr0 = __builtin_amdgcn_mfma_f32_32x32x16_bf16(afc[ks], W[ks][0], cr0, 0, 0, 0);
                cr1 = __builtin_amdgcn_mfma_f32_32x32x16_bf16(afc[ks], W[ks][1], cr1, 0, 0, 0);
                ci0 = __builtin_amdgcn_mfma_f32_32x32x16_bf16(afc[ks], W[ks][2], ci0, 0, 0, 0);
                ci1 = __builtin_amdgcn_mfma_f32_32x32x16_bf16(afc[ks], W[ks][3], ci1, 0, 0, 0); }
            __builtin_amdgcn_sched_barrier(0);
            asm volatile("s_nop 15\n\ts_nop 15" : "+v"(cr0), "+v"(cr1), "+v"(ci0), "+v"(ci1) : "v"(afc[0]), "v"(afc[1]), "v"(afc[2]), "v"(afc[3]));
            __builtin_amdgcn_sched_barrier(0);
            pre[k * 64 + lane] = (f32x4){hr0, hi0, hr1, hi1};
#pragma unroll
            for (int i = 0; i < 16; ++i) {
                const float n0 = fma_v(qr0, hr0, fma_v(nqi0, hi0, cr0[i])), m0 = fma_v(qr0, hi0, fma_v(qi0, hr0, ci0[i]));
                const float n1 = fma_v(qr1, hr1, fma_v(nqi1, hi1, cr1[i])), m1 = fma_v(qr1, hi1, fma_v(qi1, hr1, ci1[i]));
                hr0 = n0; hi0 = m0; hr1 = n1; hi1 = m1; }
#pragma unroll
            for (int ks = 0; ks < 4; ++ks) afc[ks] = afn[ks];
        }
        exch[c.wave * 64 + lane] = (f32x4){hr0, hi0, hr1, hi1};
        float p0r = qr0, p0i = qi0, p1r = qr1, p1i = qi1;
#pragma unroll
        for (int sq = 0; sq < 4; ++sq) { const float t0 = p0r * p0r - p0i * p0i, u0 = 2.0f * p0r * p0i, t1 = p1r * p1r - p1i * p1i, u1 = 2.0f * p1r * p1i; p0r = t0; p0i = u0; p1r = t1; p1i = u1; }
        float e0r = p0r, e0i = p0i, e1r = p1r, e1i = p1i;
#pragma unroll
        for (int sq = 0; sq < 3; ++sq) { const float t0 = e0r * e0r - e0i * e0i, u0 = 2.0f * e0r * e0i, t1 = e1r * e1r - e1i * e1i, u1 = 2.0f * e1r * e1i; e0r = t0; e0i = u0; e1r = t1; e1i = u1; }
        const float n0r = e0r * p0r - e0i * p0i, n0i = e0r * p0i + e0i * p0r, n1r = e1r * p1r - e1i * p1i, n1i = e1r * p1i + e1i * p1r;
        __syncthreads();
        float c0r = 0.f, c0i = 0.f, c1r = 0.f, c1i = 0.f;
        for (int v = 0; v < c.wave; ++v) { const f32x4 e = exch[v * 64 + lane]; const bool nine = v < 4;
            const float m0r = nine ? n0r : e0r, m0i = nine ? n0i : e0i, m1r = nine ? n1r : e1r, m1i = nine ? n1i : e1i;
            const float t0 = m0r * c0r - m0i * c0i + e[0], u0 = m0r * c0i + m0i * c0r + e[1], t1 = m1r * c1r - m1i * c1i + e[2], u1 = m1r * c1i + m1i * c1r + e[3];
            c0r = t0; c0i = u0; c1r = t1; c1i = u1; }
#pragma unroll 1
        for (int k = 0; k < len; ++k) { const f32x4 pv = pre[k * 64 + lane]; const int cc = s0 + k;
            HIN[car_idx(2 * bp + hh, g, dir, cc, lane & 31)] = (f32x4){pv[0] + c0r, pv[1] + c0i, pv[2] + c1r, pv[3] + c1i};
            const float t0 = p0r * c0r - p0i * c0i, u0 = p0r * c0i + p0i * c0r, t1 = p1r * c1r - p1i * c1i, u1 = p1r * c1i + p1i * c1r; c0r = t0; c0i = u0; c1r = t1; c1i = u1; }
    }
    __syncthreads();
}
__device__ __forceinline__ void phase_s2(const Args& a, Ctx& c, int l) {
    if (c.tid >= 128) return;
    for (int gid = c.bid * 128 + c.tid; gid < NB * 32 * 2 * 32 * 2; gid += c.G * 128) {
    const int tile = gid & 1, n = (gid >> 1) & 31, dir = (gid >> 6) & 1, g = (gid >> 7) & 31, b = gid >> 12;
    const f32x2* AB = (const f32x2*)(c.ws + WS_AB); const f32x2* __restrict__ E = (const f32x2*)(c.ws + WS_CAR); f32x2* __restrict__ HIN = (f32x2*)(c.ws + WS_CAR2);
    f32x2 p = AB[((l * 2 + dir) * 32 + g) * 64 + tile * 32 + n];
#pragma unroll
    for (int s = 0; s < 6; ++s) { const float pr = p.x * p.x - p.y * p.y, pi = 2.0f * p.x * p.y; p.x = pr; p.y = pi; }
    float hr = 0.f, hi = 0.f; const size_t base = car_idx(b, g, dir, 0, n) * 2 + tile;
#pragma unroll 1
    for (int c0 = 0; c0 < NCH; c0 += 17) {
        f32x2 e[17];
#pragma unroll
        for (int k = 0; k < 17; ++k) e[k] = E[base + (size_t)(c0 + k) * 64];
#pragma unroll
        for (int k = 0; k < 17; ++k) { HIN[base + (size_t)(c0 + k) * 64] = (f32x2){hr, hi};
            const float nr = p.x * hr - p.y * hi + e[k].x, ni = p.x * hi + p.y * hr + e[k].y; hr = nr; hi = ni; }
    }
    }
}
__device__ __forceinline__ bf16x8 s3_afrag(const bf16_t* Z, int bp, int tc, int g, int dir, int ks, int lane) {
    const int r = lane & 31, sq = (r >> 2) & 1, i = (r & 3) + 4 * (r >> 3), hh = lane >> 5;
    const int ti = dir == 0 ? 4 * i + ks : 4 * i + 3 - ks;
    return *(const bf16x8*)(Z + ((size_t)g * T + tok_row(2 * bp + sq, tc, ti)) * 16 + 8 * hh);
}
constexpr int S3_IMG = 272;
__device__ __forceinline__ constexpr int s3_skip(int dir, int f) { return f == (dir == 0 ? 16 : 17) || f == (dir == 0 ? 22 : 23); }
__device__ __forceinline__ constexpr int s3_pidx(int dir, int f) { return f - (f > (dir == 0 ? 16 : 17) ? 1 : 0) - (f > (dir == 0 ? 22 : 23) ? 1 : 0); }
constexpr int S3_TB = 38 * 1024;
__device__ __forceinline__ void phase_s3(const Args& a, Ctx& c, int l) {
    const bf16_t* Z = (const bf16_t*)(c.ws + WS_U); const f32x4* CAR = (const f32x4*)(c.ws + WS_CAR2); bf16_t* YG = (bf16_t*)(c.ws + WS_YG);
    const f32x2* AB = (const f32x2*)(c.ws + WS_AB); const u32x4* TB = (const u32x4*)(c.ws + WS_S3T);
    const int lane = c.lane, hh = lane >> 5, col = lane & 31;
    LAS unsigned char* tbl = c.lds;
    LAS unsigned char* img = c.lds + (c.wave < 6 ? 2 * S3_TB + c.wave * (32 * S3_IMG) : c.wave == 6 ? MISC_OFF + 1024 : LDS_BYTES - 16384);
    const int tc0 = (l == DEPTH - 1) ? 4 : 0, ntc = NCH - tc0, ncombo = 4 * ntc, ngrp = (ncombo + 7) >> 3;
    int cur_g = -1;
    const f32x16 z16 = {0.f, 0.f, 0.f, 0.f, 0.f, 0.f, 0.f, 0.f, 0.f, 0.f, 0.f, 0.f, 0.f, 0.f, 0.f, 0.f};
    float qq[2][6];
    bf16x8 af[2][4]; f32x4 hc[2];
#pragma unroll
    for (int d = 0; d < 2; ++d) { hc[d] = (f32x4){0.f, 0.f, 0.f, 0.f};
#pragma unroll
        for (int k = 0; k < 6; ++k) qq[d][k] = 0.f;
#pragma unroll
        for (int ks = 0; ks < 4; ++ks) af[d][ks] = (bf16x8){0, 0, 0, 0, 0, 0, 0, 0}; }
    const bool worker = true;
    for (int wt = c.bid; wt < 32 * ngrp; wt += c.G) {
        const int g = ((wt >> 3) & 3) | ((wt & 7) << 2), grp = wt >> 5;
        if (g != cur_g) { cur_g = g; __syncthreads();
            for (int i = c.tid; i < 2 * 40 * 64; i += NTHREADS) { const int d = i / 2560, r = i - d * 2560, f = r >> 6; if (!s3_skip(d, f)) *(LAS u32x4*)(tbl + d * S3_TB + (s3_pidx(d, f) * 64 + (r & 63)) * 16) = TB[(size_t)((l * 2 + d) * 32 + g) * 2560 + r]; }
#pragma unroll
            for (int d = 0; d < 2; ++d) { const int ldg = (l * 2 + d) * 32 + g; const f32x2 a0 = AB[ldg * 64 + col], a1 = AB[ldg * 64 + 32 + col];
                const float s0r = a0.x * a0.x - a0.y * a0.y, s0i = 2.0f * a0.x * a0.y, s1r = a1.x * a1.x - a1.y * a1.y, s1i = 2.0f * a1.x * a1.y;
                qq[d][0] = s0r * s0r - s0i * s0i; qq[d][1] = 2.0f * s0r * s0i; qq[d][2] = -qq[d][1]; qq[d][3] = s1r * s1r - s1i * s1i; qq[d][4] = 2.0f * s1r * s1i; qq[d][5] = -qq[d][4]; }
            __syncthreads(); }
        const int combo = grp * 8 + c.wave;
        if (worker && combo < ncombo) {
            const int tc = tc0 + combo % ntc, bp = combo / ntc;
#pragma unroll
            for (int d = 0; d < 2; ++d) hc[d] = CAR[car_idx(2 * bp + hh, g, d, scan_chunk(tc, d), col)];
#pragma unroll
            for (int ks = 0; ks < 4; ++ks) af[0][ks] = s3_afrag(Z, bp, tc, g, 0, ks, lane);
            f32x16 y0 = z16, y1 = z16;
            asm volatile("" : "+v"(y0), "+v"(y1));
#pragma unroll
            for (int dir = 0; dir < 2; ++dir) {
                const LAS unsigned char* tb = tbl + dir * S3_TB + lane * 16;
                if (dir == 1) {
#pragma unroll
                    for (int ks = 0; ks < 4; ++ks) af[0][ks] = s3_afrag(Z, bp, tc, g, 1, ks, lane); }
                const f32x4 h0 = hc[dir];
                f32x16 cr0 = z16, cr1 = z16, ci0 = z16, ci1 = z16;
                asm volatile("" : "+v"(cr0), "+v"(cr1), "+v"(ci0), "+v"(ci1));
                __builtin_amdgcn_sched_barrier(0);
                {
                    bf16x8 bq[2][6];
#pragma unroll
                    for (int nb = 0; nb < 6; ++nb) bq[0][nb] = *(const LAS bf16x8*)(tb + s3_pidx(dir, nb) * 1024);
#pragma unroll
                    for (int ks = 0; ks < 4; ++ks) {
                        if (ks < 3) {
#pragma unroll
                            for (int nb = 0; nb < 6; ++nb) if (!s3_skip(dir, (ks + 1) * 6 + nb)) bq[(ks + 1) & 1][nb] = *(const LAS bf16x8*)(tb + s3_pidx(dir, (ks + 1) * 6 + nb) * 1024); }
                        __builtin_amdgcn_sched_barrier(0);
                        cr0 = __builtin_amdgcn_mfma_f32_32x32x16_bf16(af[0][ks], bq[ks & 1][0], cr0, 0, 0, 0); cr1 = __builtin_amdgcn_mfma_f32_32x32x16_bf16(af[0][ks], bq[ks & 1][1], cr1, 0, 0, 0);
                        ci0 = __builtin_amdgcn_mfma_f32_32x32x16_bf16(af[0][ks], bq[ks & 1][2], ci0, 0, 0, 0); ci1 = __builtin_amdgcn_mfma_f32_32x32x16_bf16(af[0][ks], bq[ks & 1][3], ci1, 0, 0, 0);
                        if (!s3_skip(dir, ks * 6 + 4)) y0 = __builtin_amdgcn_mfma_f32_32x32x16_bf16(af[0][ks], bq[ks & 1][4], y0, 0, 0, 0);
                        if (!s3_skip(dir, ks * 6 + 5)) y1 = __builtin_amdgcn_mfma_f32_32x32x16_bf16(af[0][ks], bq[ks & 1][5], y1, 0, 0, 0);
                        __builtin_amdgcn_sched_barrier(0); } }
                __builtin_amdgcn_sched_barrier(0);
                asm volatile("s_nop 15\n\ts_nop 15" : "+v"(cr0), "+v"(cr1), "+v"(ci0), "+v"(ci1) : "v"(af[0][0]), "v"(af[0][1]), "v"(af[0][2]), "v"(af[0][3]));
                __builtin_amdgcn_sched_barrier(0);
                const float q0r = qq[dir][0], q0i = qq[dir][1], nq0i = qq[dir][2], q1r = qq[dir][3], q1i = qq[dir][4], nq1i = qq[dir][5];
                float hr0 = h0[0], hi0 = h0[1], hr1 = h0[2], hi1 = h0[3];
#pragma unroll
                for (int be = 0; be < 16; ++be) { const int i = dir == 0 ? be : 15 - be; const int rho = (i & 3) + 4 * hh + 8 * (i >> 2);
                    *(LAS unsigned*)(img + rho * S3_IMG + 4 * col) = pk2(hr0, hi0); *(LAS unsigned*)(img + rho * S3_IMG + 128 + 4 * col) = pk2(hr1, hi1);
                    const float n0 = fma_v(q0r, hr0, fma_v(nq0i, hi0, cr0[i])), m0 = fma_v(q0r, hi0, fma_v(q0i, hr0, ci0[i]));
                    const float n1 = fma_v(q1r, hr1, fma_v(nq1i, hi1, cr1[i])), m1 = fma_v(q1r, hi1, fma_v(q1i, hr1, ci1[i]));
                    hr0 = n0; hi0 = m0; hr1 = n1; hi1 = m1; }
                asm volatile("" ::: "memory");
                {
                    bf16x8 hq[2][2][3];
#pragma unroll
                    for (int e = 0; e < 2; ++e) { hq[0][e][0] = *(const LAS bf16x8*)(img + col * S3_IMG + 32 * e + 16 * hh); hq[0][e][1] = *(const LAS bf16x8*)(tb + (22 + 2 * e) * 1024); hq[0][e][2] = *(const LAS bf16x8*)(tb + (23 + 2 * e) * 1024); }
#pragma unroll
                    for (int k2 = 0; k2 < 4; ++k2) {
                        if (k2 < 3) {
#pragma unroll
                            for (int e = 0; e < 2; ++e) { const int kk = 2 * (k2 + 1) + e; hq[(k2 + 1) & 1][e][0] = *(const LAS bf16x8*)(img + col * S3_IMG + 32 * kk + 16 * hh);
                                hq[(k2 + 1) & 1][e][1] = *(const LAS bf16x8*)(tb + (22 + 2 * kk) * 1024); hq[(k2 + 1) & 1][e][2] = *(const LAS bf16x8*)(tb + (23 + 2 * kk) * 1024); } }
                        __builtin_amdgcn_sched_barrier(0);
#pragma unroll
                        for (int e = 0; e < 2; ++e) { y0 = __builtin_amdgcn_mfma_f32_32x32x16_bf16(hq[k2 & 1][e][0], hq[k2 & 1][e][1], y0, 0, 0, 0); y1 = __builtin_amdgcn_mfma_f32_32x32x16_bf16(hq[k2 & 1][e][0], hq[k2 & 1][e][2], y1, 0, 0, 0); }
                        __builtin_amdgcn_sched_barrier(0); } }
                asm volatile("" ::: "memory");
            }
            __builtin_amdgcn_sched_barrier(0);
            asm volatile("s_nop 15\n\ts_nop 15" : "+v"(y0), "+v"(y1));
            __builtin_amdgcn_sched_barrier(0);
#pragma unroll
            for (int nb = 0; nb < 2; ++nb)
#pragma unroll
                for (int i = 0; i < 16; ++i) { const float v = gelu_t(nb == 0 ? y0[i] : y1[i]);
                    const int tok = 4 * i + 2 * nb + (col >> 4);
                    *(LAS bf16_t*)(img + ((hh * 64 + tok) * 16 + (col & 15)) * 2) = (bf16_t)(pk2(v, v) & 0xffffu); }
            asm volatile("" ::: "memory");
#pragma unroll
            for (int k = 0; k < 4; ++k) { const int chunk = lane + 64 * k, row = chunk >> 1, half = chunk & 1;
                const u32x4 w = *(const LAS u32x4*)(img + chunk * 16);
                *(u32x4*)(YG + ((size_t)g * T + tok_row(2 * bp + (row >> 6), tc, row & 63)) * 16 + 8 * half) = w; }
            asm volatile("" ::: "memory");
        }
    }
    __syncthreads();
}

__device__ __forceinline__ void acc8(float (&s)[8], u32x4 w) { s[0] += bflo(w.x); s[1] += bfhi(w.x); s[2] += bflo(w.y); s[3] += bfhi(w.y); s[4] += bflo(w.z); s[5] += bfhi(w.z); s[6] += bflo(w.w); s[7] += bfhi(w.w); }
__device__ __forceinline__ void sub8(float (&s)[8], u32x4 w) { s[0] -= bflo(w.x); s[1] -= bfhi(w.x); s[2] -= bflo(w.y); s[3] -= bfhi(w.y); s[4] -= bflo(w.z); s[5] -= bfhi(w.z); s[6] -= bflo(w.w); s[7] -= bfhi(w.w); }
constexpr int POOL_TASKS = NB * 8 * 4 * 2;
constexpr int PV_CSTR = 144, PV_RSTR = 64 * PV_CSTR;
__device__ __forceinline__ void phase_pool(Ctx& c, const int wi, const int nw, const int t0, const int t1, const bool ctx) {
    const bf16_t* Z = (const bf16_t*)(c.ws + WS_Z); bf16_t* PD = (bf16_t*)(c.ws + WS_H);
    LAS unsigned char* V = c.lds;
    __syncthreads();
    for (int task = t0 + wi; task < t1; task += nw) {
        const int half = task & 1, g = (task >> 1) & 3, band = (task >> 3) & 7, b = task >> 6, hw = 1 << g, r0 = band * 8;
        const int ck = c.tid & 7, chn = 128 * g + 64 * half + 8 * ck;
        {
            const int cc = c.tid >> 3; const bf16_t* base = Z + (size_t)(b * SEQ + cc) * NZ + chn; const size_t rstep = (size_t)64 * NZ;
            float sm[8];
#pragma unroll
            for (int j = 0; j < 8; ++j) sm[j] = 0.f;
            const int lo0 = r0 - hw < 0 ? 0 : r0 - hw, hi0 = r0 + hw > 64 ? 64 : r0 + hw;
            const u32x4 zz = {0u, 0u, 0u, 0u};
            u32x4 wi[16], wa[7], wb[7];
#pragma unroll
            for (int j = 0; j < 16; ++j) { const int rr = lo0 + j < hi0 ? lo0 + j : hi0 - 1; wi[j] = *(const u32x4*)(base + (size_t)rr * rstep); }
#pragma unroll
            for (int i = 1; i < 8; ++i) { const int ra = r0 + i + hw - 1 < 64 ? r0 + i + hw - 1 : 63, rs = r0 + i - hw - 1 >= 0 ? r0 + i - hw - 1 : 0;
                wa[i - 1] = *(const u32x4*)(base + (size_t)ra * rstep); wb[i - 1] = *(const u32x4*)(base + (size_t)rs * rstep); }
            __builtin_amdgcn_sched_barrier(0);
#pragma unroll
            for (int j = 0; j < 16; ++j) acc8(sm, lo0 + j < hi0 ? wi[j] : zz);
#pragma unroll
            for (int i = 0; i < 8; ++i) { const int r = r0 + i;
                if (i > 0) { acc8(sm, r + hw - 1 < 64 ? wa[i - 1] : zz); sub8(sm, r - hw - 1 >= 0 ? wb[i - 1] : zz); }
                const int lo = r - hw < 0 ? 0 : r - hw, hi = r + hw > 64 ? 64 : r + hw; const float inv = 1.0f / (float)(hi - lo);
                u32x4 o; o.x = pk2(sm[0] * inv, sm[1] * inv); o.y = pk2(sm[2] * inv, sm[3] * inv); o.z = pk2(sm[4] * inv, sm[5] * inv); o.w = pk2(sm[6] * inv, sm[7] * inv);
                *(LAS u32x4*)(V + i * PV_RSTR + cc * PV_CSTR + ck * 16) = o; }
        }
        __syncthreads();
        {
            const int cseg = (c.tid >> 3) & 7, i = c.tid >> 6, c0 = cseg * 8, r = r0 + i; const LAS unsigned char* vrow = V + i * PV_RSTR + ck * 16;
            float sm[8];
#pragma unroll
            for (int j = 0; j < 8; ++j) sm[j] = 0.f;
            const int lo0 = c0 - hw < 0 ? 0 : c0 - hw, hi0 = c0 + hw > 64 ? 64 : c0 + hw;
            for (int cc = lo0; cc < hi0; ++cc) acc8(sm, *(const LAS u32x4*)(vrow + cc * PV_CSTR));
            const size_t tok0 = (size_t)b * SEQ + r * 64 + c0;
            u32x4 vv[8];
#pragma unroll
            for (int st = 0; st < 8; ++st) vv[st] = *(const u32x4*)(Z + (tok0 + st) * NZ + chn);
#pragma unroll
            for (int st = 0; st < 8; ++st) { const int cc = c0 + st;
                if (st > 0) { if (cc + hw - 1 < 64) acc8(sm, *(const LAS u32x4*)(vrow + (cc + hw - 1) * PV_CSTR)); if (cc - hw - 1 >= 0) sub8(sm, *(const LAS u32x4*)(vrow + (cc - hw - 1) * PV_CSTR)); }
                const int lo = cc - hw < 0 ? 0 : cc - hw, hi = cc + hw > 64 ? 64 : cc + hw; const float inv = 1.0f / (float)(hi - lo); const u32x4 v0 = vv[st];
                u32x4 o; o.x = pk2(sm[0] * inv - bflo(v0.x), sm[1] * inv - bfhi(v0.x)); o.y = pk2(sm[2] * inv - bflo(v0.y), sm[3] * inv - bfhi(v0.y));
                o.z = pk2(sm[4] * inv - bflo(v0.z), sm[5] * inv - bfhi(v0.z)); o.w = pk2(sm[6] * inv - bflo(v0.w), sm[7] * inv - bfhi(v0.w));
                *(u32x4*)(PD + (tok0 + st) * 512 + chn) = o; }
        }
        __syncthreads();
    }
    if (!ctx) return;
    const int gw = wi * NWAVES + c.wave, NGW = nw * NWAVES;
    for (int it = gw; it < (TC / 4) * 4; it += NGW) {
        const int g = it & 3, row = TL + (it >> 2) * 4 + (c.lane >> 4), ck = c.lane & 15, w = 2 << g;
        const int pos = (row - TL) & 255, n = 256;
        const bf16_t* src = Z + (size_t)(row - pos) * NZ + 128 * g + 8 * ck;
        const int lo = pos - w / 2 < 0 ? 0 : pos - w / 2, hi = pos + w / 2 > n ? n : pos + w / 2;
        float sm[8];
#pragma unroll
        for (int j = 0; j < 8; ++j) sm[j] = 0.f;
        { const u32x4 zz = {0u, 0u, 0u, 0u}; u32x4 wv[16];
#pragma unroll
            for (int k = 0; k < 16; ++k) { const int p = pos - w / 2 + k; const int pc = p < 0 ? 0 : (p > n - 1 ? n - 1 : p); wv[k] = *(const u32x4*)(src + (size_t)pc * NZ); }
            __builtin_amdgcn_sched_barrier(0);
#pragma unroll
            for (int k = 0; k < 16; ++k) { const int p = pos - w / 2 + k; acc8(sm, (k < w && p >= 0 && p < n) ? wv[k] : zz); } }
        const float inv = 1.0f / (float)(hi - lo);
        const u32x4 vv = *(const u32x4*)(Z + (size_t)row * NZ + 128 * g + 8 * ck);
        u32x4 o; o.x = pk2(sm[0] * inv - bflo(vv.x), sm[1] * inv - bfhi(vv.x)); o.y = pk2(sm[2] * inv - bflo(vv.y), sm[3] * inv - bfhi(vv.y));
        o.z = pk2(sm[4] * inv - bflo(vv.z), sm[5] * inv - bfhi(vv.z)); o.w = pk2(sm[6] * inv - bflo(vv.w), sm[7] * inv - bfhi(vv.w));
        *(u32x4*)(PD + (size_t)row * 512 + 128 * g + 8 * ck) = o;
    }
}

__device__ __forceinline__ void phase_i(const Args& a, Ctx& c, int l, const bool dummy = false) {
    LAS u32x4* bh = (LAS u32x4*)c.lds; LAS u32x4* bl = bh + 2048;
    for (int i = c.tid; i < 2048; i += NTHREADS) { const int st = i >> 6, ln = i & 63, n = ln & 15, q = ln >> 4; const float* rp = a.in(24) + (size_t)(32 * st + 8 * q) * 16 + n;
        unsigned hi[4], lo[4];
#pragma unroll
        for (int e = 0; e < 4; ++e) { const float v0 = rp[(2 * e) * 16], v1 = rp[(2 * e + 1) * 16]; const unsigned h2 = pk2(v0, v1); hi[e] = h2; lo[e] = pk2(v0 - bflo(h2), v1 - bfhi(h2)); }
        bh[i] = (u32x4){hi[0], hi[1], hi[2], hi[3]}; bl[i] = (u32x4){lo[0], lo[1], lo[2], lo[3]}; }
    volatile LAS int* bcnt = c.misc + 64; volatile LAS int* bbase = c.misc + 80; LAS float* lgt = (LAS float*)(c.lds + 65536);
    if (c.tid < 16) bcnt[c.tid] = 0;
    const int Te = l == DEPTH - 1 ? TL : T;
    const int rpb = (Te + c.G - 1) / c.G, r0 = c.bid * rpb, nrows = (r0 + rpb <= Te) ? rpb : (Te - r0 > 0 ? Te - r0 : 0);
    LAS float* par = (LAS float*)(c.lds + 81920); const int b0 = brow_of(r0);
    for (int i = c.tid; i < 2 * D; i += NTHREADS) { const int bb = i >> 10, col = i & (D - 1), bt = b0 + bb < 8 ? b0 + bb : 8;
        const float* md = (const float*)(c.ws + WS_MODS) + ((size_t)l * 9 + bt) * NMOD + 3 * D;
        par[bb * 2 * D + col] = a.in(7)[(size_t)l * D + col] * (1.0f + md[D + col]); par[bb * 2 * D + D + col] = md[col]; }
    __syncthreads();
    bf16_t* H = (bf16_t*)(c.ws + WS_H); float* GW = (float*)(c.ws + WS_GW);
    const bf16_t* XB = (const bf16_t*)(c.ws + WS_XB);
    const int m = c.lane & 15, q = c.lane >> 4;
    for (int tile = c.wave; tile * 16 < nrows; tile += NWAVES) {
        const int rowl = tile * 16 + m; const bool valid = rowl < nrows; const int row = r0 + (valid ? rowl : nrows - 1);
        const bf16_t* xb = XB + (size_t)row * D + 8 * q;
        u32x4 w[32];
#pragma unroll
        for (int st = 0; st < 32; ++st) w[st] = *(const u32x4*)(xb + 32 * st);
        __builtin_amdgcn_sched_barrier(0);
        float ss = 0.f;
#pragma unroll
        for (int st = 0; st < 32; ++st) { const float x0 = bflo(w[st].x), x1 = bfhi(w[st].x), x2 = bflo(w[st].y), x3 = bfhi(w[st].y), x4 = bflo(w[st].z), x5 = bfhi(w[st].z), x6 = bflo(w[st].w), x7 = bfhi(w[st].w);
            ss += (x0 * x0 + x1 * x1) + (x2 * x2 + x3 * x3) + (x4 * x4 + x5 * x5) + (x6 * x6 + x7 * x7);
            if ((st & 3) == 3) __builtin_amdgcn_sched_barrier(0); }
        ss += shflx(ss, 16, c.lane); ss += shflx(ss, 32, c.lane);
#pragma unroll
        for (int st = 0; st < 32; ++st) asm volatile("" : "+v"(w[st].x), "+v"(w[st].y), "+v"(w[st].z), "+v"(w[st].w));
        const float rstd = 1.0f / sqrtf(ss * (1.0f / D) + RMS_EPS);
        const LAS float* pa = par + (brow_of(row) - b0) * 2 * D + 8 * q;
        bf16_t* hrow = H + (size_t)row * D + 8 * q;
        f32x4 acc = {0.f, 0.f, 0.f, 0.f};
#pragma unroll
        for (int st = 0; st < 32; ++st) {
            const int co = 32 * st;
            const f32x4 g0 = *(const LAS f32x4*)(pa + co), g1 = *(const LAS f32x4*)(pa + co + 4), s0 = *(const LAS f32x4*)(pa + D + co), s1 = *(const LAS f32x4*)(pa + D + co + 4);
            const f32x4 xa = {bflo(w[st].x), bfhi(w[st].x), bflo(w[st].y), bfhi(w[st].y)}, xc = {bflo(w[st].z), bfhi(w[st].z), bflo(w[st].w), bfhi(w[st].w)};
            const f32x4 ha = xa * rstd * g0 + s0, hc = xc * rstd * g1 + s1;
            u32x4 hi4; hi4.x = pk2(ha[0], ha[1]); hi4.y = pk2(ha[2], ha[3]); hi4.z = pk2(hc[0], hc[1]); hi4.w = pk2(hc[2], hc[3]);
            u32x4 lo4; lo4.x = pk2(ha[0] - bflo(hi4.x), ha[1] - bfhi(hi4.x)); lo4.y = pk2(ha[2] - bflo(hi4.y), ha[3] - bfhi(hi4.y));
            lo4.z = pk2(hc[0] - bflo(hi4.z), hc[1] - bfhi(hi4.z)); lo4.w = pk2(hc[2] - bflo(hi4.w), hc[3] - bfhi(hi4.w));
            if (valid) *(u32x4*)(hrow + co) = hi4;
            const bf16x8 ahi = __builtin_bit_cast(bf16x8, hi4), alo = __builtin_bit_cast(bf16x8, lo4);
            const bf16x8 bhi = __builtin_bit_cast(bf16x8, bh[st * 64 + c.lane]), blo = __builtin_bit_cast(bf16x8, bl[st * 64 + c.lane]);
            acc = __builtin_amdgcn_mfma_f32_16x16x32_bf16(ahi, bhi, acc, 0, 0, 0);
            acc = __builtin_amdgcn_mfma_f32_16x16x32_bf16(alo, bhi, acc, 0, 0, 0);
            acc = __builtin_amdgcn_mfma_f32_16x16x32_bf16(ahi, blo, acc, 0, 0, 0);
            __builtin_amdgcn_sched_barrier(0);
        }
#pragma unroll
        for (int j = 0; j < 4; ++j) lgt[(tile * 16 + 4 * q + j) * 16 + m] = acc[j];
    }
    __syncthreads();
    int e1 = 0, e2 = 0, p1 = 0, p2 = 0; const int myrow = c.tid;
    if (myrow < nrows) {
        float rb[16]; { const float* rbp = a.in(25);
#pragma unroll
            for (int q4 = 0; q4 < 4; ++q4) { const f32x4 r4 = *(const f32x4*)(rbp + 4 * q4); rb[4 * q4] = r4[0]; rb[4 * q4 + 1] = r4[1]; rb[4 * q4 + 2] = r4[2]; rb[4 * q4 + 3] = r4[3]; } }
        float sc[16], bi[16];
#pragma unroll
        for (int q4 = 0; q4 < 4; ++q4) { const f32x4 l4 = *(const LAS f32x4*)(lgt + myrow * 16 + q4 * 4);
#pragma unroll
            for (int k = 0; k < 4; ++k) { sc[q4 * 4 + k] = sigm(l4[k]); bi[q4 * 4 + k] = sc[q4 * 4 + k] + rb[q4 * 4 + k]; } }
        float gs[4];
#pragma unroll
        for (int gq = 0; gq < 4; ++gq) { const float x0 = bi[4 * gq], x1 = bi[4 * gq + 1], x2 = bi[4 * gq + 2], x3 = bi[4 * gq + 3];
            const float h1 = fmaxf(x0, x1), l1 = fminf(x0, x1), h2 = fmaxf(x2, x3), l2 = fminf(x2, x3);
            gs[gq] = fmaxf(h1, h2) + fmaxf(fminf(h1, h2), fmaxf(l1, l2)); }
        int bg = 0; float best = gs[0];
#pragma unroll
        for (int gq = 1; gq < 4; ++gq) if (gs[gq] > best) { best = gs[gq]; bg = gq; }
        float vb[4], vs[4];
#pragma unroll
        for (int i = 0; i < 4; ++i) { vb[i] = bg == 0 ? bi[i] : bg == 1 ? bi[4 + i] : bg == 2 ? bi[8 + i] : bi[12 + i]; vs[i] = bg == 0 ? sc[i] : bg == 1 ? sc[4 + i] : bg == 2 ? sc[8 + i] : sc[12 + i]; }
        int i1 = 0; float m1 = vb[0];
#pragma unroll
        for (int i = 1; i < 4; ++i) if (vb[i] > m1) { m1 = vb[i]; i1 = i; }
        int i2 = -1; float m2 = 0.f;
#pragma unroll
        for (int i = 0; i < 4; ++i) if (i != i1 && (i2 < 0 || vb[i] > m2)) { m2 = vb[i]; i2 = i; }
        const float s1 = i1 == 0 ? vs[0] : i1 == 1 ? vs[1] : i1 == 2 ? vs[2] : vs[3], s2 = i2 == 0 ? vs[0] : i2 == 1 ? vs[1] : i2 == 2 ? vs[2] : vs[3];
        const float inv = 1.0f / (s1 + s2);
        e1 = bg * 4 + i1; e2 = bg * 4 + i2;
        p1 = __hip_atomic_fetch_add((LAS int*)(bcnt + e1), 1, __ATOMIC_RELAXED, __HIP_MEMORY_SCOPE_WORKGROUP);
        p2 = __hip_atomic_fetch_add((LAS int*)(bcnt + e2), 1, __ATOMIC_RELAXED, __HIP_MEMORY_SCOPE_WORKGROUP);
        GW[(size_t)(r0 + myrow) * 2] = s1 * inv; GW[(size_t)(r0 + myrow) * 2 + 1] = s2 * inv;
    }
    __syncthreads();
    unsigned* cntw = (unsigned*)(c.ws + WS_CTL) + CW_CNT + (dummy ? l + 4 : l) * 1024;
    if (c.tid < 16) bbase[c.tid] = (int)__hip_atomic_fetch_add(cntw + c.tid * 64, (unsigned)bcnt[c.tid], __ATOMIC_RELAXED, __HIP_MEMORY_SCOPE_AGENT);
    __syncthreads();
    int* list = (int*)(c.ws + (dummy ? WS_HMID : WS_LIST));
    if (myrow < nrows) { const int row = r0 + myrow; list[(size_t)e1 * LCAP + bbase[e1] + p1] = row * 2; list[(size_t)e2 * LCAP + bbase[e2] + p2] = row * 2 + 1; }
}
__device__ __forceinline__ void moe_setup(Ctx& c, int l) {
    const unsigned* cntw = (const unsigned*)(c.ws + WS_CTL) + CW_CNT + l * 1024;
    if (c.tid < NE) c.misc[48 + c.tid] = (int)__hip_atomic_load(cntw + c.tid * 64, __ATOMIC_RELAXED, __HIP_MEMORY_SCOPE_AGENT);
    __syncthreads();
    if (c.tid == 0) { int cum = 0;
        for (int e = 0; e < NE; ++e) { c.misc[16 + e] = cum; cum += (c.misc[48 + e] + 255) >> 8; }
        c.misc[16 + NE] = cum; }
    __syncthreads();
}

struct FinRow { u32x2 x[4], s0[4], s1[4]; f32x4 g[4]; };
__device__ __forceinline__ void fin_load(FinRow& r, const bf16_t* XB, const bf16_t* SL, const float* G2, int row, int lane) {
#pragma unroll
    for (int j = 0; j < 4; ++j) { const int col = 4 * lane + 256 * j; r.x[j] = *(const u32x2*)(XB + (size_t)row * D + col); r.s0[j] = *(const u32x2*)(SL + (size_t)row * 2 * D + col); r.s1[j] = *(const u32x2*)(SL + (size_t)row * 2 * D + D + col);
        r.g[j] = *(const f32x4*)(G2 + (size_t)(row >> 12) * NMOD + col); }
}
__device__ __forceinline__ void fin_row(const FinRow& r, const f32x4 (&fg)[4], float* outp, int row, int lane) {
    f32x4 v[4]; float s = 0.f;
#pragma unroll
    for (int j = 0; j < 4; ++j) { const f32x4 xv = {bflo(r.x[j].x), bfhi(r.x[j].x), bflo(r.x[j].y), bfhi(r.x[j].y)};
        const f32x4 y = (f32x4){bflo(r.s0[j].x) + bflo(r.s1[j].x), bfhi(r.s0[j].x) + bfhi(r.s1[j].x), bflo(r.s0[j].y) + bflo(r.s1[j].y), bfhi(r.s0[j].y) + bfhi(r.s1[j].y)};
        v[j] = xv + r.g[j] * y; s += (v[j][0] * v[j][0] + v[j][1] * v[j][1]) + (v[j][2] * v[j][2] + v[j][3] * v[j][3]); }
    const float rstd = 1.0f / sqrtf(wave_sum(s, lane) * (1.0f / D) + RMS_EPS);
#pragma unroll
    for (int j = 0; j < 4; ++j) *(f32x4*)(outp + (size_t)row * D + 4 * lane + 256 * j) = v[j] * rstd * fg[j];
}
__device__ __forceinline__ void phase_fin(const Args& a, Ctx& c) {
    const int gw = c.bid * NWAVES + c.wave, NGW = c.G * NWAVES;
    const bf16_t* XB = (const bf16_t*)(c.ws + WS_XB); const bf16_t* SL = (const bf16_t*)(c.ws + WS_Z); const float* G2 = (const float*)(c.ws + WS_MODS) + (size_t)(DEPTH - 1) * 9 * NMOD + 5 * D;
    f32x4 fg[4];
#pragma unroll
    for (int j = 0; j < 4; ++j) fg[j] = *(const f32x4*)(a.in(29) + 4 * c.lane + 256 * j);
    float* outp = a.out();
    FinRow ra, rb;
    if (gw < TL) fin_load(ra, XB, SL, G2, gw, c.lane);
    for (int row = gw; row < TL; row += 2 * NGW) {
        const bool hb = row + NGW < TL;
        if (hb) fin_load(rb, XB, SL, G2, row + NGW, c.lane);
        fin_row(ra, fg, outp, row, c.lane);
        if (row + 2 * NGW < TL) fin_load(ra, XB, SL, G2, row + 2 * NGW, c.lane);
        if (hb) fin_row(rb, fg, outp, row + NGW, c.lane);
    }
}

constexpr int STEPS_PER_LAYER = 11, NSTEPS = 1 + DEPTH * STEPS_PER_LAYER + 1;
__device__ __forceinline__ Ctx mkctx(LAS unsigned char* lds, const Args& a, const int wv) {
    unsigned lb = (unsigned)(unsigned long long)lds; asm volatile("" : "+s"(lb));
    Ctx c; c.lds = (LAS unsigned char*)lb; c.misc = (volatile LAS int*)(c.lds + MISC_OFF);
    int g = gridDim.x, b = blockIdx.x; asm volatile("" : "+s"(g), "+s"(b));
    c.wave = wv; c.lane = lane_id_v(); c.tid = wv * 64 + c.lane; c.G = g; c.bid = b; c.ws = a.ws();
    return c;
}
__global__ void __launch_bounds__(NTHREADS, 2) mk_fwd(KArgs ka) {
    extern __shared__ __attribute__((aligned(16))) unsigned char lds_raw[];
    LAS unsigned char* lds = (LAS unsigned char*)lds_raw;
    volatile LAS int* misc = (volatile LAS int*)(lds + MISC_OFF);
#if (MK_DIAG_ZERO & 1)
    for (int i = MISC_OFF / 4 + threadIdx.x; i < LDS_BYTES / 4; i += NTHREADS) ((volatile LAS int*)lds)[i] = 0x7fc12345;
    __syncthreads();
#endif
    if (threadIdx.x < 16) misc[threadIdx.x] = 0;
    if ((threadIdx.x & 63) == 0) misc[WTAB + hw_key()] = (int)(threadIdx.x >> 6);
    if (threadIdx.x == 64) {
#pragma unroll
        for (int k = 0; k < 30; ++k) { const unsigned long long p = (unsigned long long)ka.in[k]; misc[PTAB + 2 * k] = (int)(unsigned)p; misc[PTAB + 2 * k + 1] = (int)(unsigned)(p >> 32); }
        { const unsigned long long p = (unsigned long long)ka.out; misc[PTAB + 60] = (int)(unsigned)p; misc[PTAB + 61] = (int)(unsigned)(p >> 32); }
        { const unsigned long long p = (unsigned long long)ka.ws; misc[PTAB + 62] = (int)(unsigned)p; misc[PTAB + 63] = (int)(unsigned)(p >> 32); }
        misc[PTAB + 64] = ka.lo; misc[PTAB + 65] = ka.hi;
    }
    __syncthreads();
    Args a; a.tab = misc + PTAB;
    int wv = __builtin_amdgcn_readfirstlane((int)(threadIdx.x >> 6)); asm volatile("" : "+s"(wv));
    const int lo = __builtin_amdgcn_readfirstlane(misc[PTAB + 64]), hi = __builtin_amdgcn_readfirstlane(misc[PTAB + 65]);
    XcdBarrier bar; bar.bar = (unsigned*)(a.ws() + WS_CTL) + CW_BAR; bar.x = 0; bar.st = (volatile LAS unsigned*)misc;
    if (hi - lo > 1) bar = xcd_barrier_post((unsigned*)(a.ws() + WS_CTL) + CW_BAR, (volatile LAS unsigned*)misc);
#define IN(s) (lo <= (s) && (s) < hi)
#define SEAM(s) do { if (IN(s) && IN((s) + 1)) { bar.bar = (unsigned*)(a.ws() + WS_CTL) + CW_BAR; xcd_barrier(bar, wv * 64 + lane_id_v()); } } while (0)
    if (IN(0)) { Ctx c = mkctx(lds, a, wv); phase_p0(a, c); __syncthreads(); tr_range(a, c, 0, 0, TR_NITEMS, c.bid * NWAVES + c.wave, c.G * NWAVES);
        if (MK_DBL & 1) { __syncthreads(); phase_p0(a, c); __syncthreads(); tr_range(a, c, 0, 0, TR_NITEMS, c.bid * NWAVES + c.wave, c.G * NWAVES); } } SEAM(0);
    for (int l = 0; l < DEPTH; ++l) {
        const int sb = 1 + l * STEPS_PER_LAYER;
        if (IN(sb + 0)) { Ctx c = mkctx(lds, a, wv); if (MK_DBL & (1 << 11)) { phase_a(a, c, l, true); __syncthreads(); } phase_a(a, c, l); } SEAM(sb + 0);
        if (IN(sb + 1)) {
            Ctx c = mkctx(lds, a, wv);
            pg8::StaticOrder S; S.init(T, NZ, c.G, c.bid); pg8::EpiIn E{(bf16_t*)(c.ws + WS_Z), (bf16_t*)(c.ws + WS_U)};
            pg8::gemm_phase<pg8::EpiIn, pg8::StaticOrder, false>(c.lds, c.tid, (const bf16_t*)(c.ws + WS_H), (const bf16_t*)(c.ws + wbuf_off(l) + WO_WIN), D, S, E);
            if (MK_DBL & (1 << 1)) { __syncthreads(); pg8::gemm_phase<pg8::EpiIn, pg8::StaticOrder, false>(c.lds, c.tid, (const bf16_t*)(c.ws + WS_H), (const bf16_t*)(c.ws + wbuf_off(l) + WO_WIN), D, S, E); }
            { const int tail0 = S.nwg % c.G; if (l + 1 < DEPTH && tail0 != 0 && c.bid >= tail0) tr_range(a, c, l + 1, 0, TR_SPLIT, (c.bid - tail0) * NWAVES + c.wave, (c.G - tail0) * NWAVES);
                if (l == 0) { Ctx c2 = mkctx(lds, a, wv); if (tail0 == 0) s3_tables(a, c2, c2.bid, c2.G); else if (c2.bid >= tail0) s3_tables(a, c2, c2.bid - tail0, c2.G - tail0); } }
        } SEAM(sb + 1);
        if (IN(sb + 2)) { Ctx c = mkctx(lds, a, wv); phase_s12(a, c, l);
            if (MK_DBL & (1 << 2)) { __syncthreads(); phase_s12(a, c, l); }
#if MK_SELFTEST
            if (l == 0) { asm volatile("" ::: "memory"); phase_s1(a, c, l, WS_HMID); bar.bar = (unsigned*)(a.ws() + WS_CTL) + CW_BAR; xcd_barrier(bar, c.tid);
                const u32x4* p = (const u32x4*)(c.ws + WS_CAR); const u32x4* q = (const u32x4*)(c.ws + WS_HMID); unsigned bad = 0;
                for (size_t i = (size_t)c.bid * NTHREADS + c.tid; i < (size_t)NB * 32 * 2 * NCH * 32; i += (size_t)c.G * NTHREADS) { const u32x4 x = p[i], y = q[i]; bad |= (x.x ^ y.x) | (x.y ^ y.y) | (x.z ^ y.z) | (x.w ^ y.w); }
                if (bad) __hip_atomic_fetch_or((unsigned*)(c.ws + WS_CTL) + 8, 1u, __ATOMIC_RELAXED, __HIP_MEMORY_SCOPE_AGENT); }
#endif
        } SEAM(sb + 2);
        if (IN(sb + 4)) { Ctx c = mkctx(lds, a, wv);
#pragma unroll 1
            for (int rep = 0; rep < ((MK_DBL & (1 << 4)) ? 2 : 1); ++rep) { phase_s3(a, c, l); __syncthreads(); }
            { const int nt3 = 32 * ((4 * (l == DEPTH - 1 ? NCH - 4 : NCH) + 7) >> 3), tail0 = nt3 % c.G;
                if (tail0 == 0) phase_pool(c, c.bid, c.G, 0, POOL_TASKS / 2, false); else if (c.bid >= tail0) phase_pool(c, c.bid - tail0, c.G - tail0, 0, POOL_TASKS / 2, false); }
        } SEAM(sb + 4);
        if (IN(sb + 5)) {
            Ctx c = mkctx(lds, a, wv);
            pg8::StaticOrder S; S.init(l == DEPTH - 1 ? TL : T, 512, c.G, c.bid); pg8::EpiGlu E{(const bf16_t*)(c.ws + WS_YG), (bf16_t*)(c.ws + WS_H) + (size_t)T * 512, a.in(20) + (size_t)l * 512};
            pg8::gemm_phase<pg8::EpiGlu, pg8::StaticOrder, false, true>(c.lds, c.tid, (const bf16_t*)(c.ws + WS_YG), (const bf16_t*)(c.ws + wbuf_off(l) + WO_GLU), 512, S, E);
            if (MK_DBL & (1 << 5)) { __syncthreads(); pg8::gemm_phase<pg8::EpiGlu, pg8::StaticOrder, false, true>(c.lds, c.tid, (const bf16_t*)(c.ws + WS_YG), (const bf16_t*)(c.ws + wbuf_off(l) + WO_GLU), 512, S, E); }
            { const int tail0 = S.nwg % c.G; Ctx c2 = mkctx(lds, a, wv);
                if (tail0 == 0) phase_pool(c2, c2.bid, c2.G, POOL_TASKS / 2, POOL_TASKS, l != DEPTH - 1); else if (c2.bid >= tail0) phase_pool(c2, c2.bid - tail0, c2.G - tail0, POOL_TASKS / 2, POOL_TASKS, l != DEPTH - 1); }
        } SEAM(sb + 5);
        if (IN(sb + 6)) {
            Ctx c = mkctx(lds, a, wv); pg8::PairOrder S; S.so.init(l == DEPTH - 1 ? TL : T, D, c.G, c.bid);
            pg8::EpiM12 E{(const bf16_t*)(c.ws + WS_Z), (bf16_t*)(c.ws + WS_HMID)};
            pg8::gemm_phase<pg8::EpiM12, pg8::PairOrder, false>(c.lds, c.tid, (const bf16_t*)(c.ws + WS_H), (const bf16_t*)(c.ws + wbuf_off(l) + WO_WC), 512, S, E);
            if (MK_DBL & (1 << 6)) { __syncthreads(); pg8::gemm_phase<pg8::EpiM12, pg8::PairOrder, false>(c.lds, c.tid, (const bf16_t*)(c.ws + WS_H), (const bf16_t*)(c.ws + wbuf_off(l) + WO_WC), 512, S, E); }
            { const int tail0 = S.so.nwg % c.G; if (l + 1 < DEPTH && tail0 != 0 && c.bid >= tail0) tr_range(a, c, l + 1, TR_SPLIT, TR_SPLIT2, (c.bid - tail0) * NWAVES + c.wave, (c.G - tail0) * NWAVES); }
        } SEAM(sb + 6);
        if (IN(sb + 7)) {
            Ctx c = mkctx(lds, a, wv);
            pg8::StaticOrder S; S.init(l == DEPTH - 1 ? TL : T, D, c.G, c.bid);
            pg8::EpiOut E{(bf16_t*)(c.ws + WS_XB), (const float*)(c.ws + WS_MODS) + (size_t)l * 9 * NMOD + 2 * D, (bf16_t*)(c.ws + WS_XB)};
            if (MK_DBL & (1 << 7)) { pg8::EpiOut E2{(bf16_t*)(c.ws + WS_XB), (const float*)(c.ws + WS_MODS) + (size_t)l * 9 * NMOD + 2 * D, (bf16_t*)(c.ws + WS_H)};
                pg8::gemm_phase<pg8::EpiOut, pg8::StaticOrder, false>(c.lds, c.tid, (const bf16_t*)(c.ws + WS_HMID), (const bf16_t*)(c.ws + wbuf_off(l) + WO_WOUT), D, S, E2); __syncthreads(); }
            pg8::gemm_phase<pg8::EpiOut, pg8::StaticOrder, false>(c.lds, c.tid, (const bf16_t*)(c.ws + WS_HMID), (const bf16_t*)(c.ws + wbuf_off(l) + WO_WOUT), D, S, E);
            { const int tail0 = S.nwg % c.G; if (l + 1 < DEPTH && tail0 != 0 && c.bid >= tail0) tr_range(a, c, l + 1, TR_SPLIT2, TR_NITEMS, (c.bid - tail0) * NWAVES + c.wave, (c.G - tail0) * NWAVES); }
        } SEAM(sb + 7);
        if (IN(sb + 8)) { Ctx c = mkctx(lds, a, wv); phase_i(a, c, l); if (MK_DBL & (1 << 8)) { __syncthreads(); phase_i(a, c, l, true); } } SEAM(sb + 8);
        if (IN(sb + 9)) {
            Ctx c = mkctx(lds, a, wv);
            moe_setup(c, l);
            pg8::MoeOrder S{(const LAS int*)(c.misc + 16), (const LAS int*)(c.misc + 48), (const int*)(c.ws + WS_LIST), c.G, c.bid}; pg8::EpiUp E{(bf16_t*)(c.ws + WS_HMID)};
            pg8::gemm_phase<pg8::EpiUp, pg8::MoeOrder, true>(c.lds, c.tid, (const bf16_t*)(c.ws + WS_H), (const bf16_t*)(c.ws + wbuf_off(l) + WO_W13), D, S, E);
            if (MK_DBL & (1 << 9)) { __syncthreads(); pg8::gemm_phase<pg8::EpiUp, pg8::MoeOrder, true>(c.lds, c.tid, (const bf16_t*)(c.ws + WS_H), (const bf16_t*)(c.ws + wbuf_off(l) + WO_W13), D, S, E); }
        } SEAM(sb + 9);
        if (IN(sb + 10)) {
            Ctx c = mkctx(lds, a, wv);
            moe_setup(c, l);
            pg8::MoeOrder S{(const LAS int*)(c.misc + 16), (const LAS int*)(c.misc + 48), (const int*)(c.ws + WS_LIST), c.G, c.bid};
            pg8::EpiDown E{(bf16_t*)(c.ws + WS_Z), (const int*)(c.ws + WS_LIST), (const float*)(c.ws + WS_GW), (const LAS int*)(c.misc + 16), (const LAS int*)(c.misc + 48)};
            pg8::gemm_phase<pg8::EpiDown, pg8::MoeOrder, false>(c.lds, c.tid, (const bf16_t*)(c.ws + WS_HMID), (const bf16_t*)(c.ws + wbuf_off(l) + WO_W2), DE, S, E);
            if (MK_DBL & (1 << 10)) { __syncthreads(); pg8::gemm_phase<pg8::EpiDown, pg8::MoeOrder, false>(c.lds, c.tid, (const bf16_t*)(c.ws + WS_HMID), (const bf16_t*)(c.ws + wbuf_off(l) + WO_W2), DE, S, E); }
        } SEAM(sb + 10);
    }
    if (IN(NSTEPS - 1)) { Ctx c = mkctx(lds, a, wv); phase_fin(a, c); }
#undef IN
#undef SEAM
}

extern "C" void kernel_launch(void* const* d_in, const int* in_sizes, int n_in, void* d_out, int out_size, void* d_ws, size_t ws_size, hipStream_t stream) {
    static int grid = 0;
    if (grid == 0) {
        if (n_in != 30 || out_size != TL * D || ws_size < WS_END) { fprintf(stderr, "kernel_launch: unexpected shapes (n_in %d out %d ws %zu)\n", n_in, out_size, ws_size); grid = -1; return; }
        int dev = 0, cus = 0, per_cu = 0;
        if (hipGetDevice(&dev) != hipSuccess || hipDeviceGetAttribute(&cus, hipDeviceAttributeMultiprocessorCount, dev) != hipSuccess) { grid = -1; return; }
        if (hipFuncSetAttribute((const void*)mk_fwd, hipFuncAttributeMaxDynamicSharedMemorySize, LDS_BYTES) != hipSuccess) { fprintf(stderr, "kernel_launch: hipFuncSetAttribute failed\n"); grid = -1; return; }
        if (hipOccupancyMaxActiveBlocksPerMultiprocessor(&per_cu, (const void*)mk_fwd, NTHREADS, LDS_BYTES) != hipSuccess || per_cu < 1) { fprintf(stderr, "kernel_launch: occupancy query says %d\n", per_cu); per_cu = 1; }
        (void)hipGetLastError();
        grid = cus;
    }
    if (grid < 0) return;
    (void)hipMemsetAsync((char*)d_ws + WS_CTL, 0, CTL_ZERO_BYTES, stream);
#if (MK_DIAG_ZERO & 2)
    (void)hipMemsetAsync((char*)d_ws, 0, WS_END, stream);
#endif
#if (MK_DIAG_ZERO & 4)
    (void)hipMemsetAsync((char*)d_out, 0, (size_t)TL * D * 4, stream);
#endif
    KArgs a{};
    for (int i = 0; i < 30; ++i) a.in[i] = (const float*)d_in[i];
    a.out = (float*)d_out; a.ws = (unsigned char*)d_ws;
#if MK_MULTI
    for (int s = 0; s < NSTEPS; ++s) { a.lo = s; a.hi = s + 1; hipLaunchKernelGGL(mk_fwd, dim3(grid), dim3(NTHREADS), LDS_BYTES, stream, a); }
#else
    a.lo = 0; a.hi = NSTEPS; hipLaunchKernelGGL(mk_fwd, dim3(grid), dim3(NTHREADS), LDS_BYTES, stream, a);
#endif
}
```

```cpp
#include <hip/hip_runtime.h>
#include <cstdio>

#ifndef MK_MULTI
#define MK_MULTI 0
#endif
#ifndef MK_SELFTEST
#ifndef MK_DBL
#define MK_DBL 0
#endif
#define MK_SELFTEST 0
#endif
#define MK_DIAG_ZERO 0

#define LAS __attribute__((address_space(3)))
#define GAS __attribute__((address_space(1)))
typedef unsigned short bf16_t;
typedef short bf16x8 __attribute__((ext_vector_type(8)));
typedef float f32x2 __attribute__((ext_vector_type(2)));
typedef float f32x4 __attribute__((ext_vector_type(4)));
typedef float f32x16 __attribute__((ext_vector_type(16)));
typedef unsigned u32x2 __attribute__((ext_vector_type(2)));
typedef unsigned u32x4 __attribute__((ext_vector_type(4)));

constexpr int D = 1024, NB = 8, SEQ = 4096, CTXL = 256, DEPTH = 4;
constexpr int TL = NB * SEQ, TC = NB * CTXL, T = TL + TC;
constexpr int NZ = 3072, NMOD = 6 * D;
constexpr int NE = 16, DE = 512;
constexpr int LCAP = 2 * T;
constexpr int HM_ROWS = 2 * T + NE * 256;
constexpr float RMS_EPS = 1e-6f;
constexpr int NCH = 68;
constexpr int IMG_STRIDE = 336;

constexpr size_t MiB = 1u << 20;
constexpr size_t WS_CTL = 0, CTL_ZERO_BYTES = 2 * MiB;
constexpr size_t WS_MODS = 2 * MiB;
constexpr size_t WS_AB = 3 * MiB;
constexpr size_t WS_BF = 4 * MiB;
constexpr size_t WS_CF = 5 * MiB;
constexpr size_t WS_LIST = 7 * MiB;
constexpr size_t WS_GW = 12 * MiB;
constexpr size_t WS_XCTX = 13 * MiB;
constexpr size_t WS_CAR = 21 * MiB;
constexpr size_t WS_W = 39 * MiB;
constexpr size_t WO_WIN = 0, WO_WC = 6 * MiB, WO_WBS = 7 * MiB, WO_WOUT = 8 * MiB, WO_GLU = 10 * MiB, WO_W13 = 11 * MiB, WO_W2 = 43 * MiB;
constexpr size_t WS_H = 98 * MiB;
constexpr size_t WS_YG = 166 * MiB;
constexpr size_t WS_HMID = 200 * MiB;
constexpr size_t WS_Z = 272 * MiB;
constexpr size_t WS_XB = 476 * MiB;
constexpr size_t WS_W2ND = 544 * MiB;
constexpr size_t WS_CAR2 = 604 * MiB;
constexpr size_t WS_S3T = 621 * MiB;
constexpr size_t WS_U = 631 * MiB;
constexpr size_t WS_END = 665 * MiB;
static_assert((size_t)HM_ROWS * 512 * 2 <= 72 * MiB && (size_t)T * NZ * 2 <= 204 * MiB && (size_t)T * D * 2 == 68 * MiB, "ws map");
constexpr int CW_TMO = 0, CW_BAR = 4096, CW_CNT = 16384;

__device__ __forceinline__ unsigned f2bf(float f) { unsigned u = __builtin_bit_cast(unsigned, f); return (u + 0x7fffu + ((u >> 16) & 1u)) >> 16; }
typedef __bf16 bf16v2 __attribute__((ext_vector_type(2)));
__device__ __forceinline__ unsigned pk2(float lo, float hi) { const f32x2 v = {lo, hi}; const bf16v2 b = __builtin_convertvector(v, bf16v2); return __builtin_bit_cast(unsigned, b); }
__device__ __forceinline__ float bflo(unsigned w) { return __builtin_bit_cast(float, w << 16); }
__device__ __forceinline__ float bfhi(unsigned w) { return __builtin_bit_cast(float, w & 0xffff0000u); }
__device__ __forceinline__ float sigm(float x) { return __builtin_amdgcn_rcpf(1.0f + __builtin_amdgcn_exp2f(-1.44269504f * x)); }
__device__ __forceinline__ float gelu_t(float x) { const float u = 1.5957691216f * (x + 0.044715f * x * x * x); return x * sigm(u); }
__device__ __forceinline__ int lane_id_v() { int l; asm volatile("v_mbcnt_lo_u32_b32 %0, -1, 0\n\tv_mbcnt_hi_u32_b32 %0, -1, %0" : "=v"(l)); return l; }
__device__ __forceinline__ int hw_key() { return (int)(__builtin_amdgcn_s_getreg((5 << 11) | 4) & 0x3fu); }
__device__ __forceinline__ float shflx(float v, int o, int lane) { return __builtin_bit_cast(float, __builtin_amdgcn_ds_bpermute((lane ^ o) << 2, __builtin_bit_cast(int, v))); }
__device__ __forceinline__ float wave_sum(float v, int lane) {
#pragma unroll
    for (int o = 1; o < 64; o <<= 1) v += shflx(v, o, lane);
    return v;
}
__device__ __forceinline__ f32x4 ld_bf4(const bf16_t* p) { const u32x2 w = *(const u32x2*)p; return (f32x4){bflo(w.x), bfhi(w.x), bflo(w.y), bfhi(w.y)}; }
__device__ __forceinline__ void st_bf4(bf16_t* p, f32x4 v) { u32x2 w; w.x = pk2(v[0], v[1]); w.y = pk2(v[2], v[3]); *(u32x2*)p = w; }
#define LDS_WAIT() asm volatile("s_waitcnt lgkmcnt(0)" ::: "memory")
#define VM_WAIT() asm volatile("s_waitcnt vmcnt(0)" ::: "memory")

namespace pg8 {
constexpr int BM = 256, BK = 64, HALF = 128, HTB = HALF * BK * 2, STAGE_BYTES = 8 * HTB, NXCD = 8, WGM = 8;
__host__ __device__ __forceinline__ int lds_byte(int r, int c) { const int st = (r >> 4) * 2 + (c >> 5), rr = r & 15, cc = c & 31, ob = rr * 64 + cc * 2; return st * 1024 + (ob ^ (((ob >> 9) & 1) << 5)); }
__host__ __device__ __forceinline__ void stage_rc(int b, int& R, int& C) { const int st = b / 1024, sb = b % 1024, swz = sb ^ (((sb >> 9) & 1) << 5); R = (st >> 1) * 16 + swz / 64; C = (st & 1) * 32 + (swz % 64) / 2; }
__host__ __device__ __forceinline__ int perm32(int rho) { const int n = rho >> 4, i = rho & 15; return 8 * (i >> 2) + 4 * n + (i & 3); }

struct Unit { int pm, pn, e, pnl; };

struct StaticOrder {
    int nM, nN, nwg, G, c;
    __device__ void init(int M, int N, int G_, int c_) { nM = M / BM; nN = N / BM; nwg = nM * nN; G = G_; c = c_; }
    __device__ bool next(int i, Unit& u) const {
        const long L = (long)i * G + c; if (L >= nwg) return false;
        int wgid = (int)L; { const int q = nwg / NXCD, r = nwg % NXCD, xcd = wgid % NXCD, off = wgid / NXCD; wgid = (xcd < r ? xcd * (q + 1) : r * (q + 1) + (xcd - r) * q) + off; }
        const int nig = WGM * nN, gid = wgid / nig, fm = gid * WGM, gsz = (nM - fm) < WGM ? (nM - fm) : WGM;
        u.pm = fm + ((wgid % nig) % gsz); u.pn = (wgid % nig) / gsz; u.pnl = u.pn; u.e = 0; return true;
    }
    __device__ __forceinline__ int arow(const Unit&, int) const { return 0; }
};
struct ComboOrder {
    int G, c;
    __device__ bool next(int i, Unit& u) const {
        const int L = i * G + c; constexpr int NM = (T / BM) * 4, NG = (T / BM) * 2;
        if (L >= NM + NG) return false;
        if (L < NM) { u.pm = L >> 2; u.pn = L & 3; u.pnl = L & 3; u.e = 0; }
        else { const int q = L - NM; u.pm = (q >> 1) + (int)((WS_YG - WS_H) / ((size_t)BM * 1024)); u.pn = (q & 1) + (int)((WO_GLU - WO_WC) / ((size_t)BM * 1024)); u.pnl = q & 1; u.e = 1; }
        return true;
    }
    __device__ __forceinline__ int arow(const Unit&, int) const { return 0; }
};
struct PairOrder {
    StaticOrder so;
    __device__ bool next(int i, Unit& u) const {
        if (!so.next(i >> 1, u)) return false;
        u.e = i & 1; u.pnl = u.pn;
        if (u.e == 0) { u.pm += T / BM; u.pn += 4; }
        return true;
    }
    __device__ __forceinline__ int arow(const Unit&, int) const { return 0; }
};
struct MoeOrder {
    const LAS int* cum; const LAS int* cnt; const int* list; int G, c;
    __device__ bool next(int i, Unit& u) const {
        const int ntot = cum[NE]; int L;
        if ((G & 7) == 0) { const int x = c & 7, k = i * (G >> 3) + (c >> 3); const int rt = x + 8 * (k >> 2); if (rt >= ntot) return false; L = rt * 4 + (k & 3); }
        else { L = i * G + c; if (L >= ntot * 4) return false; }
        const int rtg = L >> 2; int e = 0;
#pragma unroll
        for (int k = 1; k < NE; ++k) e += (rtg >= cum[k]) ? 1 : 0;
        u.pm = rtg; u.e = e; u.pnl = L & 3; u.pn = e * 4 + (L & 3); return true;
    }
    __device__ __forceinline__ int arow(const Unit& u, int rl) const {
        const int pos = (u.pm - cum[u.e]) * BM + rl;
        int tok = 0; if (pos < cnt[u.e]) tok = list[u.e * LCAP + pos] >> 1;
        return tok;
    }
};

template <class Epi, class Sched, bool GATHER, bool AGRP = false>
__device__ __forceinline__ void gemm_phase(LAS unsigned char* lds, const int tid_in, const bf16_t* A, const bf16_t* Bt, const int K, const Sched& S, const Epi& E) {
    const int tid = tid_in, wid = __builtin_amdgcn_readfirstlane(tid >> 6), lane = tid & 63, wr = wid >> 2, wc = wid & 3, fr = lane & 15, fq = lane >> 4;
    const int nt = K / BK;
    unsigned voffB[2];
#pragma unroll
    for (int i = 0; i < 2; ++i) { int R, C; stage_rc(tid * 16 + i * 8192, R, C); const int Rb = Epi::PERM ? ((R & ~31) + perm32(R & 31)) : R; voffB[i] = (unsigned)(Rb * K + C) * 2u; }
    const size_t kstep = (size_t)(BK * 2);
    const size_t kstepA = AGRP ? (size_t)(BK / 16) * T * 32 : kstep;
    const size_t hstep = (size_t)HALF * K * 2;
    const size_t tstep = 2 * hstep;
    const unsigned ldsw = (unsigned)wid * 1024u;
    const int aoff = lds_byte(wr * 64 + fr, fq * 8), boff = lds_byte(wc * 32 + fr, fq * 8);
#define PG8_SA(b, h) (((b) * 2 + (h)) * HTB)
#define PG8_SB(b, h) ((4 + (b) * 2 + (h)) * HTB)
#define PG8_STAGE(bufoff, gbase, voff) do { _Pragma("unroll") for (int _i = 0; _i < 2; ++_i) \
        __builtin_amdgcn_global_load_lds((const unsigned*)((const char*)(gbase) + (voff)[_i]), (LAS unsigned*)(lds + (bufoff) + ldsw + _i * 8192), 16, 0, 0); } while (0)
#define PG8_STAGEA(bufoff, kt, o0, o1) do { const char* _g = (const char*)A + (size_t)(kt) * kstepA; \
        __builtin_amdgcn_global_load_lds((const unsigned*)(_g + (o0)), (LAS unsigned*)(lds + (bufoff) + ldsw), 16, 0, 0); \
        __builtin_amdgcn_global_load_lds((const unsigned*)(_g + (o1)), (LAS unsigned*)(lds + (bufoff) + ldsw + 8192), 16, 0, 0); } while (0)
#define PG8_LDA(dst, b, h) do { _Pragma("unroll") for (int m = 0; m < 4; ++m) _Pragma("unroll") for (int k = 0; k < 2; ++k) dst[m][k] = *(const LAS bf16x8*)(lds + PG8_SA(b, h) + aoff + m * 2048 + k * 1024); } while (0)
#define PG8_LDB(dst, b, h) do { _Pragma("unroll") for (int n = 0; n < 2; ++n) _Pragma("unroll") for (int k = 0; k < 2; ++k) dst[n][k] = *(const LAS bf16x8*)(lds + PG8_SB(b, h) + boff + n * 2048 + k * 1024); } while (0)
#define PG8_MMA(ai, bj, At, Bt_) do { __builtin_amdgcn_s_setprio(1); _Pragma("unroll") for (int m = 0; m < 4; ++m) _Pragma("unroll") for (int n = 0; n < 2; ++n) _Pragma("unroll") for (int k = 0; k < 2; ++k) \
        acc[ai][bj][m][n] = __builtin_amdgcn_mfma_f32_16x16x32_bf16(Bt_[n][k], At[m][k], acc[ai][bj][m][n], 0, 0, 0); __builtin_amdgcn_s_setprio(0); } while (0)
#define PG8_WAIT_V(n) asm volatile("s_waitcnt vmcnt(" #n ")" ::: "memory")
#define PG8_WAIT_L(n) asm volatile("s_waitcnt lgkmcnt(" #n ")" ::: "memory")
#define PG8_BAR __builtin_amdgcn_s_barrier()
#define PG8_SCHED __builtin_amdgcn_sched_barrier(0)
#define PG8_CALC_OFF(dst, U) do { _Pragma("unroll") for (int _h = 0; _h < 2; ++_h) _Pragma("unroll") for (int _i = 0; _i < 2; ++_i) { int _R, _C; stage_rc(tid * 16 + _i * 8192, _R, _C); const int _rl = _h * HALF + _R; \
        const unsigned _row = GATHER ? (unsigned)S.arow((U), _rl) : (unsigned)((U).pm * BM + _rl); dst[_h * 2 + _i] = AGRP ? (((unsigned)(_C >> 4) * (unsigned)T + _row) * 32u + (unsigned)((_C & 15) * 2)) : _row * (unsigned)(K * 2) + (unsigned)(_C * 2); } } while (0)
    Unit cur, nxt; int ui = 0;
    if (!S.next(0, cur)) return;
    f32x4 acc[2][2][4][2];
#pragma unroll
    for (int a = 0; a < 2; ++a)
#pragma unroll
        for (int b = 0; b < 2; ++b)
#pragma unroll
            for (int m = 0; m < 4; ++m)
#pragma unroll
                for (int n = 0; n < 2; ++n) acc[a][b][m][n] = (f32x4){0.f, 0.f, 0.f, 0.f};
    bf16x8 At[4][2], B0[2][2], B1[2][2];
    unsigned oc[4], on[4];
    PG8_CALC_OFF(oc, cur);
    const char* cB = (const char*)Bt + (size_t)cur.pn * tstep;
    PG8_STAGE(PG8_SB(0, 0), cB, voffB); PG8_STAGE(PG8_SB(0, 1), cB + hstep, voffB); PG8_STAGEA(PG8_SA(0, 0), 0, oc[0], oc[1]); PG8_STAGEA(PG8_SA(0, 1), 0, oc[2], oc[3]);
    if (wr == 1) PG8_BAR;
    PG8_WAIT_V(2); PG8_BAR;
    PG8_STAGE(PG8_SB(1, 0), cB + kstep, voffB); PG8_STAGEA(PG8_SA(1, 0), 1, oc[0], oc[1]); PG8_STAGE(PG8_SB(1, 1), cB + hstep + kstep, voffB);
    PG8_WAIT_V(6); PG8_BAR;
    for (;;) {
        const bool has_next = S.next(ui + 1, nxt);
        if (has_next) { PG8_CALC_OFF(on, nxt); } else {
#pragma unroll
            for (int q = 0; q < 4; ++q) on[q] = oc[q]; }
        const char* nB = has_next ? (const char*)Bt + (size_t)nxt.pn * tstep : cB;
        for (int t = 0; t < nt; t += 2) {
            const bool last = (t == nt - 2);
            const int k2 = last ? 0 : t + 2, k3 = k2 + 1;
            const unsigned s0 = last ? on[0] : oc[0], s1 = last ? on[1] : oc[1], s2 = last ? on[2] : oc[2], s3 = last ? on[3] : oc[3];
            const char* b2 = last ? nB : cB + (size_t)(t + 2) * kstep; const char* b3 = b2 + kstep;
            PG8_LDB(B0, 0, 0); PG8_LDB(B1, 0, 1); PG8_SCHED; PG8_LDA(At, 0, 0); PG8_STAGEA(PG8_SA(1, 1), t + 1, oc[2], oc[3]);
            PG8_WAIT_V(8); PG8_WAIT_L(0); PG8_BAR; PG8_MMA(0, 0, At, B0); PG8_MMA(0, 1, At, B1); PG8_BAR; PG8_SCHED;
            PG8_LDA(At, 0, 1); PG8_STAGE(PG8_SB(0, 0), b2, voffB); PG8_STAGE(PG8_SB(0, 1), b2 + hstep, voffB); PG8_STAGEA(PG8_SA(0, 0), k2, s0, s1);
            PG8_WAIT_V(8); PG8_WAIT_L(0); PG8_BAR; PG8_MMA(1, 0, At, B0); PG8_MMA(1, 1, At, B1); PG8_BAR; PG8_SCHED;
            PG8_LDB(B0, 1, 0); PG8_LDB(B1, 1, 1); PG8_SCHED; PG8_LDA(At, 1, 0); PG8_STAGEA(PG8_SA(0, 1), k2, s2, s3);
            PG8_WAIT_V(8); PG8_WAIT_L(0); PG8_BAR; PG8_MMA(0, 0, At, B0); PG8_MMA(0, 1, At, B1); PG8_BAR; PG8_SCHED;
            PG8_LDA(At, 1, 1); PG8_STAGE(PG8_SB(1, 0), b3, voffB); PG8_STAGE(PG8_SB(1, 1), b3 + hstep, voffB); PG8_STAGEA(PG8_SA(1, 0), k3, s0, s1);
            PG8_WAIT_V(8); PG8_WAIT_L(0); PG8_BAR; PG8_MMA(1, 0, At, B0); PG8_MMA(1, 1, At, B1); PG8_BAR; PG8_SCHED;
        }
        if (wr == 0) PG8_BAR;
        bool keep = false;
        if constexpr (Epi::KEEPS) keep = E.apply(acc, cur, wr, wc, fr, fq); else E(acc, cur, wr, wc, fr, fq);
        if (!has_next) break;
        if (!keep) {
#pragma unroll
        for (int a = 0; a < 2; ++a)
#pragma unroll
            for (int b = 0; b < 2; ++b)
#pragma unroll
                for (int m = 0; m < 4; ++m)
#pragma unroll
                    for (int n = 0; n < 2; ++n) acc[a][b][m][n] = (f32x4){0.f, 0.f, 0.f, 0.f};
        }
        cur = nxt; cB = nB; ++ui;
#pragma unroll
        for (int q = 0; q < 4; ++q) oc[q] = on[q];
        if (wr == 1) PG8_BAR;
    }
    PG8_WAIT_V(0);
    PG8_BAR;
#undef PG8_SA
#undef PG8_SB
#undef PG8_STAGE
#undef PG8_STAGEA
#undef PG8_LDA
#undef PG8_LDB
#undef PG8_MMA
#undef PG8_WAIT_V
#undef PG8_WAIT_L
#undef PG8_BAR
#undef PG8_SCHED
#undef PG8_CALC_OFF
}

typedef const f32x4 (&AccRef)[2][2][4][2];
__device__ __forceinline__ u32x4 pack8(f32x4 v0, f32x4 v1) { u32x4 w; w.x = pk2(v0[0], v0[1]); w.y = pk2(v0[2], v0[3]); w.z = pk2(v1[0], v1[1]); w.w = pk2(v1[2], v1[3]); return w; }
__device__ __forceinline__ void unpack8(u32x4 w, f32x4& v0, f32x4& v1) { v0 = (f32x4){bflo(w.x), bfhi(w.x), bflo(w.y), bfhi(w.y)}; v1 = (f32x4){bflo(w.z), bfhi(w.z), bflo(w.w), bfhi(w.w)}; }
__device__ __forceinline__ f32x4 sigm4(f32x4 v) { return (f32x4){sigm(v[0]), sigm(v[1]), sigm(v[2]), sigm(v[3])}; }

struct EpiIn {
    static constexpr bool PERM = true, KEEPS = false; bf16_t* Z; bf16_t* U;
    __device__ __forceinline__ void operator()(AccRef acc, const Unit& u, int wr, int wc, int fr, int fq) const {
        const int row0 = u.pm * BM + wr * 64 + fr; const bool gate = u.pnl >= 4;
        const int col0 = gate ? 1024 + (u.pnl - 4) * HALF + wc * 32 + 8 * fq : u.pnl * BM + wc * 32 + 8 * fq, cstep = gate ? 1024 : HALF;
#pragma unroll
        for (int ai = 0; ai < 2; ++ai)
#pragma unroll
            for (int m = 0; m < 4; ++m) { bf16_t* rowp = Z + (size_t)(row0 + ai * HALF + m * 16) * NZ + col0;
                f32x4 v0 = acc[ai][0][m][0], v1 = acc[ai][0][m][1], w0 = acc[ai][1][m][0], w1 = acc[ai][1][m][1];
                u32x4 pa = pack8(v0, v1);
                if (gate) { pa = pack8(sigm4(v0), sigm4(v1)); f32x4 p0, p1; unpack8(pa, p0, p1); w0 = sigm4(w0); w1 = sigm4(w1);
#pragma unroll
                    for (int k = 0; k < 4; ++k) { w0[k] *= __builtin_amdgcn_rcpf(fmaxf(p0[k], 1e-30f)); w1[k] *= __builtin_amdgcn_rcpf(fmaxf(p1[k], 1e-30f)); } }
                if (u.pnl == 2 || u.pnl == 3) {
                    const int uc = (u.pnl - 2) * BM + wc * 32 + 8 * fq; const size_t tok = (size_t)(row0 + ai * HALF + m * 16);
                    *(u32x4*)(U + ((size_t)(uc >> 4) * T + tok) * 16 + (uc & 8)) = pa; *(u32x4*)(U + ((size_t)((uc + HALF) >> 4) * T + tok) * 16 + (uc & 8)) = pack8(w0, w1);
                } else { *(u32x4*)rowp = pa; *(u32x4*)(rowp + cstep) = pack8(w0, w1); } }
    }
};
struct EpiGlu {
    static constexpr bool PERM = true, KEEPS = false; const bf16_t* YG; bf16_t* S; const float* gb;
    __device__ __forceinline__ void operator()(AccRef acc, const Unit& u, int wr, int wc, int fr, int fq) const {
        const int row0 = u.pm * BM + wr * 64 + fr, col0 = u.pnl * BM + wc * 32 + 8 * fq;
        f32x4 bv[2][2];
#pragma unroll
        for (int bj = 0; bj < 2; ++bj)
#pragma unroll
            for (int n = 0; n < 2; ++n) bv[bj][n] = *(const f32x4*)(gb + col0 + bj * HALF + 4 * n);
        u32x4 yv[2][4][2];
#pragma unroll
        for (int ai = 0; ai < 2; ++ai)
#pragma unroll
            for (int m = 0; m < 4; ++m)
#pragma unroll
                for (int bj = 0; bj < 2; ++bj) yv[ai][m][bj] = *(const u32x4*)(YG + ((size_t)((col0 + bj * HALF) >> 4) * T + (row0 + ai * HALF + m * 16)) * 16 + ((col0 + bj * HALF) & 8));
        __builtin_amdgcn_sched_barrier(0);
#pragma unroll
        for (int ai = 0; ai < 2; ++ai)
#pragma unroll
            for (int m = 0; m < 4; ++m) { const size_t off = (size_t)(row0 + ai * HALF + m * 16) * 512 + col0;
#pragma unroll
                for (int bj = 0; bj < 2; ++bj) { f32x4 y0, y1; unpack8(yv[ai][m][bj], y0, y1);
                    const f32x4 v0 = y0 * sigm4(acc[ai][bj][m][0] + bv[bj][0]), v1 = y1 * sigm4(acc[ai][bj][m][1] + bv[bj][1]);
                    *(u32x4*)(S + off + bj * HALF) = pack8(v0, v1); } }
    }
};
template <int MODE> struct EpiMerge {
    static constexpr bool PERM = true, KEEPS = false; bf16_t* Z; bf16_t* M;
    __device__ __forceinline__ void operator()(AccRef acc, const Unit& u, int wr, int wc, int fr, int fq) const {
        const int row0 = u.pm * BM + wr * 64 + fr, col0 = u.pnl * BM + wc * 32 + 8 * fq;
#pragma unroll
        for (int ai = 0; ai < 2; ++ai)
#pragma unroll
            for (int m = 0; m < 4; ++m) { bf16_t* rowp = Z + (size_t)(row0 + ai * HALF + m * 16) * NZ + col0;
#pragma unroll
                for (int bj = 0; bj < 2; ++bj) {
                    if (MODE == 0) { f32x4 g0, g1; unpack8(*(const u32x4*)(rowp + 1024 + bj * HALF), g0, g1);
                        *(u32x4*)(rowp + 1024 + bj * HALF) = pack8(g0 * acc[ai][bj][m][0], g1 * acc[ai][bj][m][1]); }
                    else { f32x4 g0, g1, t0, t1; unpack8(*(const u32x4*)(rowp + 2048 + bj * HALF), g0, g1); unpack8(*(const u32x4*)(rowp + 1024 + bj * HALF), t0, t1);
                        *(u32x4*)(M + (size_t)(row0 + ai * HALF + m * 16) * D + col0 + bj * HALF) = pack8(t0 + g0 * acc[ai][bj][m][0], t1 + g1 * acc[ai][bj][m][1]); } } }
    }
};
struct EpiM12 {
    static constexpr bool PERM = true, KEEPS = true; const bf16_t* Z; bf16_t* M;
    __device__ __forceinline__ bool apply(f32x4 (&acc)[2][2][4][2], const Unit& u, int wr, int wc, int fr, int fq) const {
        const int pmr = u.e == 0 ? u.pm - T / BM : u.pm; const int row0_ = pmr * BM + wr * 64 + fr, col0 = u.pnl * BM + wc * 32 + 8 * fq;
        if (u.e == 0) {
            const int row0 = row0_;
            u32x4 qv[2][4][2];
#pragma unroll
            for (int ai = 0; ai < 2; ++ai)
#pragma unroll
                for (int m = 0; m < 4; ++m)
#pragma unroll
                    for (int bj = 0; bj < 2; ++bj) qv[ai][m][bj] = *(const u32x4*)(Z + (size_t)(row0 + ai * HALF + m * 16) * NZ + col0 + bj * HALF + 2048);
            __builtin_amdgcn_sched_barrier(0);
#pragma unroll
            for (int ai = 0; ai < 2; ++ai)
#pragma unroll
                for (int m = 0; m < 4; ++m)
#pragma unroll
                    for (int bj = 0; bj < 2; ++bj) { f32x4 q0, q1; unpack8(qv[ai][m][bj], q0, q1); acc[ai][bj][m][0] *= q0; acc[ai][bj][m][1] *= q1; }
        } else {
            const int row0 = row0_;
            u32x4 pv[2][4][2];
#pragma unroll
            for (int ai = 0; ai < 2; ++ai)
#pragma unroll
                for (int m = 0; m < 4; ++m)
#pragma unroll
                    for (int bj = 0; bj < 2; ++bj) pv[ai][m][bj] = *(const u32x4*)(Z + (size_t)(row0 + ai * HALF + m * 16) * NZ + col0 + bj * HALF + 1024);
            __builtin_amdgcn_sched_barrier(0);
#pragma unroll
            for (int ai = 0; ai < 2; ++ai)
#pragma unroll
                for (int m = 0; m < 4; ++m)
#pragma unroll
                    for (int bj = 0; bj < 2; ++bj) { f32x4 p0, p1; unpack8(pv[ai][m][bj], p0, p1);
                        *(u32x4*)(M + (size_t)(row0 + ai * HALF + m * 16) * D + col0 + bj * HALF) = pack8(acc[ai][bj][m][0] * p0, acc[ai][bj][m][1] * p1); }
        }
        return u.e == 0;
    }
};
struct EpiCombo {
    static constexpr bool PERM = true, KEEPS = false; EpiMerge<0> em; EpiGlu eg;
    __device__ __forceinline__ void operator()(AccRef acc, const Unit& u, int wr, int wc, int fr, int fq) const {
        if (u.e == 0) em(acc, u, wr, wc, fr, fq);
        else { Unit v = u; v.pm = u.pm - (int)((WS_YG - WS_H) / ((size_t)BM * 1024)); eg(acc, v, wr, wc, fr, fq); }
    }
};
struct EpiOut {
    static constexpr bool PERM = true, KEEPS = false; bf16_t* XB; const float* g1; bf16_t* XBW;
    __device__ __forceinline__ void operator()(AccRef acc, const Unit& u, int wr, int wc, int fr, int fq) const {
        const bool lat = u.pm < TL / BM; const int brow = lat ? (u.pm >> 4) : 8;
        bf16_t* xb = XB + (size_t)u.pm * BM * D; bf16_t* xw = XBW + (size_t)u.pm * BM * D;
        const int row0 = wr * 64 + fr, col0 = u.pnl * BM + wc * 32 + 8 * fq;
        f32x4 gv[2][2];
#pragma unroll
        for (int bj = 0; bj < 2; ++bj)
#pragma unroll
            for (int n = 0; n < 2; ++n) gv[bj][n] = *(const f32x4*)(g1 + (size_t)brow * NMOD + col0 + bj * HALF + 4 * n);
#pragma unroll
        for (int ai = 0; ai < 2; ++ai) { u32x4 xv[4][2];
#pragma unroll
            for (int m = 0; m < 4; ++m)
#pragma unroll
                for (int bj = 0; bj < 2; ++bj) xv[m][bj] = *(const u32x4*)(xb + (size_t)(row0 + ai * HALF + m * 16) * D + col0 + bj * HALF);
            __builtin_amdgcn_sched_barrier(0);
#pragma unroll
            for (int m = 0; m < 4; ++m)
#pragma unroll
                for (int bj = 0; bj < 2; ++bj) { f32x4 p0, p1; unpack8(xv[m][bj], p0, p1);
                    *(u32x4*)(xw + (size_t)(row0 + ai * HALF + m * 16) * D + col0 + bj * HALF) = pack8(p0 + gv[bj][0] * acc[ai][bj][m][0], p1 + gv[bj][1] * acc[ai][bj][m][1]); } }
    }
};
struct EpiUp {
    static constexpr bool PERM = true, KEEPS = false; bf16_t* HM;
    __device__ __forceinline__ void operator()(AccRef acc, const Unit& u, int wr, int wc, int fr, int fq) const {
        const int row0 = u.pm * BM + wr * 64 + fr, col0 = u.pnl * HALF + wc * 32 + 8 * fq;
#pragma unroll
        for (int ai = 0; ai < 2; ++ai)
#pragma unroll
            for (int m = 0; m < 4; ++m) { f32x4 a0 = acc[ai][0][m][0], a1 = acc[ai][0][m][1]; const f32x4 b0 = acc[ai][1][m][0], b1 = acc[ai][1][m][1];
                a0 = a0 * sigm4(a0) * b0; a1 = a1 * sigm4(a1) * b1;
                *(u32x4*)(HM + (size_t)(row0 + ai * HALF + m * 16) * DE + col0) = pack8(a0, a1); }
    }
};
struct EpiDown {
    static constexpr bool PERM = true, KEEPS = false; bf16_t* SL; const int* list; const float* gw; const LAS int* cum; const LAS int* cnt;
    __device__ __forceinline__ void operator()(AccRef acc, const Unit& u, int wr, int wc, int fr, int fq) const {
        const int col0 = u.pnl * BM + wc * 32 + 8 * fq; const int pos0 = (u.pm - cum[u.e]) * BM + wr * 64 + fr, n_e = cnt[u.e];
        int ent[2][4]; float w[2][4];
#pragma unroll
        for (int ai = 0; ai < 2; ++ai)
#pragma unroll
            for (int m = 0; m < 4; ++m) { const int pos = pos0 + ai * HALF + m * 16; ent[ai][m] = pos < n_e ? list[u.e * LCAP + pos] : -1; }
#pragma unroll
        for (int ai = 0; ai < 2; ++ai)
#pragma unroll
            for (int m = 0; m < 4; ++m) w[ai][m] = ent[ai][m] >= 0 ? gw[ent[ai][m]] : 0.f;
#pragma unroll
        for (int ai = 0; ai < 2; ++ai)
#pragma unroll
            for (int m = 0; m < 4; ++m) asm volatile("" : "+v"(w[ai][m]));
#pragma unroll
        for (int ai = 0; ai < 2; ++ai)
#pragma unroll
            for (int m = 0; m < 4; ++m) if (ent[ai][m] >= 0) { bf16_t* rowp = SL + (size_t)ent[ai][m] * D + col0;
#pragma unroll
                for (int bj = 0; bj < 2; ++bj) *(u32x4*)(rowp + bj * HALF) = pack8(acc[ai][bj][m][0] * w[ai][m], acc[ai][bj][m][1] * w[ai][m]); }
    }
};
}

#define XB_TMO      128
#define XB_XCNT(j)  (256  + 64 * (j))
#define XB_XSUB(j)  (1280 + 64 * (j))
#define XB_XGEN(j)  (2304 + 64 * (j))
#define XB_TOP      3328
#define XB_TOPGEN   3392
#define XCD_BAR_WORDS 3456
#define XB_SPIN_CAP (1u << 22)

__device__ __forceinline__ unsigned xb_ld(unsigned* p)              { return __hip_atomic_load(p, __ATOMIC_RELAXED, __HIP_MEMORY_SCOPE_AGENT); }
__device__ __forceinline__ unsigned xb_add(unsigned* p, unsigned v) { return __hip_atomic_fetch_add(p, v, __ATOMIC_RELAXED, __HIP_MEMORY_SCOPE_AGENT); }
__device__ __forceinline__ unsigned xb_xcc_id() { return (unsigned)__builtin_amdgcn_s_getreg((3 << 11) | 20) & 0xFu; }
#define XB_SPIN(cond, bar) do { unsigned _sp = 0; while (cond) { __builtin_amdgcn_s_sleep(1); \
    if ((++_sp & 255u) == 0u) { if (xb_ld(&(bar)[XB_TMO])) break; if (_sp > XB_SPIN_CAP) { atomicAdd(&(bar)[XB_TMO], 1u); break; } } } } while (0)

struct XcdBarrier { unsigned* bar; unsigned x; volatile LAS unsigned* st; };
__device__ __forceinline__ XcdBarrier xcd_barrier_post(unsigned* bar, volatile LAS unsigned* st) {
    XcdBarrier b; b.bar = bar; b.x = xb_xcc_id(); b.st = st;
    if (threadIdx.x == 0) (void)xb_add(&bar[XB_XCNT(b.x)], 1u);
    return b;
}
__device__ __forceinline__ void xcd_barrier_complete(unsigned* bar, unsigned x_in, unsigned& nloc, unsigned& nx) {
    unsigned x = x_in;
    const unsigned G = gridDim.x * gridDim.y * gridDim.z;
    asm volatile("" : "+s"(x));
    unsigned sum, cnt, mine, sp = 0u;
    for (;;) {
        sum = 0u; cnt = 0u; mine = 0u;
#pragma unroll
        for (unsigned j = 0; j < 16; ++j) { const unsigned c = xb_ld(&bar[XB_XCNT(j)]); sum += c; cnt += (c > 0u) ? 1u : 0u; mine = (j == x) ? c : mine; }
        if (sum == G) break;
        __builtin_amdgcn_s_sleep(1);
        if ((++sp & 255u) == 0u) { if (xb_ld(&bar[XB_TMO])) break; if (sp > XB_SPIN_CAP) { atomicAdd(&bar[XB_TMO], 1u); break; } }
    }
    nloc = mine > 0u ? mine : 1u; nx = cnt > 0u ? cnt : 1u;
}
__device__ __forceinline__ void xcd_barrier(const XcdBarrier& b, const int tid) {
    asm volatile("s_waitcnt vmcnt(0)" ::: "memory");
    __syncthreads();
    if (tid == 0) {
        unsigned* bar = b.bar;
        __builtin_amdgcn_s_waitcnt(0);
        unsigned nloc = b.st[0], nx = b.st[1];
        if (nloc == 0u) { xcd_barrier_complete(bar, b.x, nloc, nx); b.st[0] = nloc; b.st[1] = nx; }
        const unsigned old = xb_add(&bar[XB_XSUB(b.x)], 1u);
        const unsigned gen = old / nloc;
        if (old + 1u == (gen + 1u) * nloc) {
            __builtin_amdgcn_fence(__ATOMIC_RELEASE, "agent");
            asm volatile("s_waitcnt vmcnt(0)" ::: "memory");
            const unsigned og = xb_add(&bar[XB_TOP], 1u);
            const unsigned tg = og / nx;
            if (og + 1u == (tg + 1u) * nx) xb_add(&bar[XB_TOPGEN], 1u);
            else XB_SPIN(xb_ld(&bar[XB_TOPGEN]) == tg, bar);
            __builtin_amdgcn_fence(__ATOMIC_ACQUIRE, "agent");
            xb_add(&bar[XB_XGEN(b.x)], 1u);
            asm volatile("s_waitcnt vmcnt(0)" ::: "memory");
        } else {
            XB_SPIN(xb_ld(&bar[XB_XGEN(b.x)]) == gen, bar);
            __builtin_amdgcn_fence(__ATOMIC_ACQUIRE, "agent");
            asm volatile("s_waitcnt vmcnt(0)" ::: "memory");
        }
    }
    __syncthreads();
}

constexpr int NWAVES = 8, NTHREADS = 512;
constexpr int RING_BYTES = 131072, MISC_OFF = RING_BYTES, LDS_BYTES = 163840;

struct KArgs {
    const float* in[30]; float* out; unsigned char* ws; int lo, hi;
};
constexpr int PTAB = 3072, WTAB = 3200;
constexpr int PTAB_DUMMY = 0;
struct Args {
    volatile LAS int* tab;
    __device__ __forceinline__ unsigned long long ld(int k) const { const unsigned lo = (unsigned)__builtin_amdgcn_readfirstlane(tab[2 * k]), hi = (unsigned)__builtin_amdgcn_readfirstlane(tab[2 * k + 1]); return ((unsigned long long)hi << 32) | lo; }
    __device__ __forceinline__ const float* in(int k) const { return (const float*)(const GAS float*)ld(k); }
    __device__ __forceinline__ float* out() const { return (float*)(GAS float*)ld(30); }
    __device__ __forceinline__ unsigned char* ws() const { return (unsigned char*)(GAS unsigned char*)ld(31); }
};

struct Ctx {
    LAS unsigned char* lds; volatile LAS int* misc;
    int tid, lane, wave, G, bid;
    unsigned char* ws;
};

__device__ __forceinline__ const float* xrow_in(const Args& a, int row) { return row < TL ? a.in(0) + (size_t)row * D : a.in(2) + (size_t)(row - TL) * D; }
__device__ __forceinline__ int brow_of(int row) { return row < TL ? (row >> 12) : 8; }

__device__ __forceinline__ void zoh(const Args& a, int idx  , float& abr, float& abi, float& fr_, float& fi_) {
    const float are = a.in(11)[idx], aim = a.in(12)[idx]; const float dt = expf(a.in(13)[idx >> 6]);
    const float mag = expf(are * dt); abr = mag * cosf(aim * dt); abi = mag * sinf(aim * dt);
    const float nr = abr - 1.0f, ni = abi, den = are * are + aim * aim;
    fr_ = (nr * are + ni * aim) / den; fi_ = (ni * are - nr * aim) / den;
}
__device__ __forceinline__ void zoh_fast(const Args& a, int idx, float& abr, float& abi, float& fr_, float& fi_) {
    const float are = a.in(11)[idx], aim = a.in(12)[idx]; const float dt = __expf(a.in(13)[idx >> 6]);
    const float mag = __expf(are * dt); abr = mag * __cosf(aim * dt); abi = mag * __sinf(aim * dt);
    const float nr = abr - 1.0f, ni = abi, den = __builtin_amdgcn_rcpf(are * are + aim * aim);
    fr_ = (nr * are + ni * aim) * den; fi_ = (ni * are - nr * aim) * den;
}
__device__ __forceinline__ void phase_p0(const Args& a, Ctx& c) {
    LAS float* sl = (LAS float*)c.lds;
    LAS float* part = (LAS float*)(c.lds + 9 * 1024 * 4);
    for (int i = c.tid; i < 9 * 1024; i += NTHREADS) { const float v = i < 8 * 1024 ? a.in(1)[i] : a.in(3)[i - 8 * 1024]; sl[i] = v * sigm(v); }
    __syncthreads();
    float* mods = (float*)(c.ws + WS_MODS);
    for (int it = c.bid; it < DEPTH * 96; it += c.G) {
        const int l = it / 96, col = (it % 96) * 64 + c.lane;
        const float* w = a.in(4) + (size_t)l * D * NMOD + col;
        float acc[9];
#pragma unroll
        for (int r = 0; r < 9; ++r) acc[r] = 0.f;
#pragma unroll 8
        for (int kk = 0; kk < 128; ++kk) { const int k = c.wave * 128 + kk; const float wv = w[(size_t)k * NMOD];
#pragma unroll
            for (int r = 0; r < 9; ++r) acc[r] += sl[r * 1024 + k] * wv; }
#pragma unroll
        for (int r = 0; r < 9; ++r) part[(c.wave * 9 + r) * 64 + c.lane] = acc[r];
        __syncthreads();
        for (int o = c.tid; o < 9 * 64; o += NTHREADS) { float s = 0.f;
#pragma unroll
            for (int w8 = 0; w8 < 8; ++w8) s += part[w8 * 576 + o];
            const int r = o >> 6, cc = (it % 96) * 64 + (o & 63); mods[((size_t)l * 9 + r) * NMOD + cc] = s + a.in(5)[(size_t)l * NMOD + cc]; }
        __syncthreads();
    }
    const int gt = c.bid * NTHREADS + c.tid, GT = c.G * NTHREADS;
    f32x2* AB = (f32x2*)(c.ws + WS_AB);
    for (int i = gt; i < DEPTH * 2 * 32 * 64; i += GT) { float abr, abi, fr_, fi_; zoh(a, i, abr, abi, fr_, fi_); AB[i] = (f32x2){abr, abi}; }
    u32x4* BF = (u32x4*)(c.ws + WS_BF);
    for (int i = gt; i < DEPTH * 2 * 32 * 4 * 64; i += GT) {
        const int ln = i & 63, f = (i >> 6) & 3, ldg = i >> 8; const int ri = f >> 1, tile = f & 1, p = tile * 32 + (ln & 31), hh = ln >> 5;
        float abr, abi, fr_, fi_; zoh(a, ldg * 64 + p, abr, abi, fr_, fi_);
        const float* bre = a.in(14) + ((size_t)ldg * 64 + p) * 16 + 8 * hh; const float* bim = a.in(15) + ((size_t)ldg * 64 + p) * 16 + 8 * hh;
        float v[8];
#pragma unroll
        for (int j = 0; j < 8; ++j) v[j] = ri == 0 ? fr_ * bre[j] - fi_ * bim[j] : fr_ * bim[j] + fi_ * bre[j];
        u32x4 o; o.x = f2bf(v[0]) | (f2bf(v[1]) << 16); o.y = f2bf(v[2]) | (f2bf(v[3]) << 16); o.z = f2bf(v[4]) | (f2bf(v[5]) << 16); o.w = f2bf(v[6]) | (f2bf(v[7]) << 16);
        BF[i] = o;
    }
    u32x4* CF = (u32x4*)(c.ws + WS_CF);
    for (int i = gt; i < DEPTH * 2 * 32 * 5 * 64; i += GT) {
        const int ln = i & 63, ks = (i >> 6) % 5, ldg = (i >> 6) / 5; const int j = ln & 15, q = ln >> 4; const int l = ldg >> 6, g = ldg & 31;
        const float* cre = a.in(16) + ((size_t)ldg * 16 + j) * 64; const float* cim = a.in(17) + ((size_t)ldg * 16 + j) * 64;
        float v[8];
#pragma unroll
        for (int e = 0; e < 8; ++e) { const int k = 32 * ks + 8 * q + e; float x;
            if (k < 128) { const int n = k >> 2, cm = k & 3; x = cm == 0 ? cre[n] : cm == 1 ? -cim[n] : cm == 2 ? cre[n + 32] : -cim[n + 32]; }
            else { const int jj = k - 128; x = (jj == j) ? a.in(18)[l * 512 + g * 16 + j] : 0.f; }
            v[e] = x; }
        u32x4 o; o.x = f2bf(v[0]) | (f2bf(v[1]) << 16); o.y = f2bf(v[2]) | (f2bf(v[3]) << 16); o.z = f2bf(v[4]) | (f2bf(v[5]) << 16); o.w = f2bf(v[6]) | (f2bf(v[7]) << 16);
        CF[i] = o;
    }
}

__device__ __forceinline__ void s3_tables(const Args& a, Ctx& c, const int wi, const int nw) {
    u32x4* TB = (u32x4*)(c.ws + WS_S3T);
    __syncthreads();
    LAS float* sC = (LAS float*)c.lds;
    LAS float* sB = sC + 2 * 16 * 65;
    LAS float* sA = sB + 2048;
    LAS float* sK = sA + 256;
    for (int ldg = wi; ldg < DEPTH * 2 * 32; ldg += nw) {
        const int l = ldg >> 6, dir = (ldg >> 5) & 1, g = ldg & 31;
        __syncthreads();
        for (int i = c.tid; i < 1024; i += NTHREADS) { const int o = i >> 6, n = i & 63; sC[o * 65 + n] = a.in(16)[(size_t)ldg * 1024 + i]; sC[16 * 65 + o * 65 + n] = a.in(17)[(size_t)ldg * 1024 + i]; }
        if (c.tid < 64) { float abr, abi, fr_, fi_; zoh(a, ldg * 64 + c.tid, abr, abi, fr_, fi_); sA[4 * c.tid] = abr; sA[4 * c.tid + 1] = abi; sA[4 * c.tid + 2] = fr_; sA[4 * c.tid + 3] = fi_; }
        __syncthreads();
        for (int i = c.tid; i < 1024; i += NTHREADS) { const int n = i >> 4; const float br = a.in(14)[(size_t)ldg * 1024 + i], bi = a.in(15)[(size_t)ldg * 1024 + i], fr_ = sA[4 * n + 2], fi_ = sA[4 * n + 3];
            sB[i] = fr_ * br - fi_ * bi; sB[1024 + i] = fr_ * bi + fi_ * br; }
        __syncthreads();
        for (int idx = c.tid; idx < 1024; idx += NTHREADS) { const int dd = idx >> 8, o = (idx >> 4) & 15, j = idx & 15; float acc = 0.f;
#pragma unroll 1
            for (int n0 = 0; n0 < 64; n0 += 8) {
                f32x4 ab[8]; float cr[8], ci[8], br[8], bi[8];
#pragma unroll
                for (int q = 0; q < 8; ++q) { const int n = n0 + q; ab[q] = *(const LAS f32x4*)(sA + 4 * n); cr[q] = sC[o * 65 + n]; ci[q] = sC[16 * 65 + o * 65 + n]; br[q] = sB[n * 16 + j]; bi[q] = sB[1024 + n * 16 + j]; }
                __builtin_amdgcn_sched_barrier(0);
#pragma unroll
                for (int q = 0; q < 8; ++q) { float pr = 1.f, pi = 0.f;
#pragma unroll
                    for (int e = 0; e < 3; ++e) if (e < dd) { const float t = pr * ab[q][0] - pi * ab[q][1], u = pr * ab[q][1] + pi * ab[q][0]; pr = t; pi = u; }
                    const float Gr = cr[q] * pr - ci[q] * pi, Gi = cr[q] * pi + ci[q] * pr; acc += Gr * br[q] - Gi * bi[q]; } }
            sK[idx] = acc; }
        __syncthreads();
        for (int en = c.tid; en < 40 * 64; en += NTHREADS) {
        const int ln = en & 63, f = en >> 6; const int col = ln & 31, kh = ln >> 5;
        float v[8];
#pragma unroll
        for (int j = 0; j < 8; ++j) v[j] = 0.f;
        if (f < 24) { const int ks = f / 6, nb = f % 6;
            if (nb < 4) { const int pst = (nb & 1) * 32 + col, comp = nb >> 1; const f32x4 ab = *(const LAS f32x4*)(sA + 4 * pst);
                const f32x4 br0 = *(const LAS f32x4*)(sB + pst * 16 + 8 * kh), br1 = *(const LAS f32x4*)(sB + pst * 16 + 8 * kh + 4), bi0 = *(const LAS f32x4*)(sB + 1024 + pst * 16 + 8 * kh), bi1 = *(const LAS f32x4*)(sB + 1024 + pst * 16 + 8 * kh + 4);
                float pr = 1.f, pi = 0.f; for (int e = 0; e < 3 - ks; ++e) { const float t = pr * ab[0] - pi * ab[1], u = pr * ab[1] + pi * ab[0]; pr = t; pi = u; }
#pragma unroll
                for (int j = 0; j < 4; ++j) { v[j] = comp == 0 ? pr * br0[j] - pi * bi0[j] : pr * bi0[j] + pi * br0[j]; v[4 + j] = comp == 0 ? pr * br1[j] - pi * bi1[j] : pr * bi1[j] + pi * br1[j]; }
            } else { const int sp = 2 * (nb - 4) + (col >> 4), o = col & 15, s1 = dir == 0 ? sp : 3 - sp;
                const int dd = s1 - ks;
                if (dd >= 0) { const f32x4 k0 = *(const LAS f32x4*)(sK + (dd * 16 + o) * 16 + 8 * kh), k1 = *(const LAS f32x4*)(sK + (dd * 16 + o) * 16 + 8 * kh + 4);
#pragma unroll
                    for (int j = 0; j < 4; ++j) { v[j] = k0[j]; v[4 + j] = k1[j]; } }
                if (dir == 0 && dd == 0) {
#pragma unroll
                    for (int j = 0; j < 8; ++j) if (8 * kh + j == o) v[j] += a.in(18)[l * 512 + g * 16 + o]; } }
        } else { const int kk = (f - 24) >> 1, nb = (f - 24) & 1; const int sp = 2 * nb + (col >> 4), o = col & 15, s1 = dir == 0 ? sp : 3 - sp;
            f32x4 ab[4]; float cr[4], ci[4];
#pragma unroll
            for (int q = 0; q < 4; ++q) { const int n = 8 * kk + 4 * kh + q; ab[q] = *(const LAS f32x4*)(sA + 4 * n); cr[q] = sC[o * 65 + n]; ci[q] = sC[16 * 65 + o * 65 + n]; }
            __builtin_amdgcn_sched_barrier(0);
#pragma unroll
            for (int q = 0; q < 4; ++q) { float pr = ab[q][0], pi = ab[q][1];
#pragma unroll
                for (int e = 0; e < 3; ++e) if (e < s1) { const float t = pr * ab[q][0] - pi * ab[q][1], u = pr * ab[q][1] + pi * ab[q][0]; pr = t; pi = u; }
                const float Gr = cr[q] * pr - ci[q] * pi, Gi = cr[q] * pi + ci[q] * pr; v[2 * q] = Gr; v[2 * q + 1] = -Gi; } }
        u32x4 o4; o4.x = f2bf(v[0]) | (f2bf(v[1]) << 16); o4.y = f2bf(v[2]) | (f2bf(v[3]) << 16); o4.z = f2bf(v[4]) | (f2bf(v[5]) << 16); o4.w = f2bf(v[6]) | (f2bf(v[7]) << 16);
        TB[(size_t)ldg * 2560 + en] = o4;
        }
    }
    __syncthreads();
}

template <class RowMap>
__device__ __forceinline__ void tr_item(const float* W, int ldn, int K, bf16_t* WT, const RowMap& rm, LAS bf16_t* scr, int kb, int nb, int lane) {
    const int k0 = 64 * kb, n0 = 64 * nb;
    f32x4 x[16];
#pragma unroll
    for (int i = 0; i < 16; ++i) x[i] = __builtin_nontemporal_load((const f32x4*)(W + (size_t)(k0 + 4 * i + (lane >> 4)) * ldn + n0 + (lane & 15) * 4));
#pragma unroll
    for (int i = 0; i < 16; ++i) { u32x2 w; w.x = pk2(x[i][0], x[i][1]); w.y = pk2(x[i][2], x[i][3]); *(LAS u32x2*)(scr + (4 * i + (lane >> 4)) * 72 + (lane & 15) * 4) = w; }
    LDS_WAIT(); asm volatile("" ::: "memory");
    const int cch = lane & 7;
#pragma unroll
    for (int j = 0; j < 8; ++j) { const int n = (lane >> 3) + 8 * j; const LAS bf16_t* sp = scr + (8 * cch) * 72 + n;
        u32x4 o; o.x = (unsigned)sp[0] | ((unsigned)sp[72] << 16); o.y = (unsigned)sp[2 * 72] | ((unsigned)sp[3 * 72] << 16); o.z = (unsigned)sp[4 * 72] | ((unsigned)sp[5 * 72] << 16); o.w = (unsigned)sp[6 * 72] | ((unsigned)sp[7 * 72] << 16);
        *(u32x4*)(WT + (size_t)rm(n0 + n) * K + k0 + 8 * cch) = o; }
    LDS_WAIT(); asm volatile("" ::: "memory");
}
struct RmId { int off; __device__ __forceinline__ int operator()(int n) const { return off + n; } };
struct RmW13 { int off; __device__ __forceinline__ int operator()(int n) const { return off + 256 * (n >> 7) + (n & 127); } };

__device__ __forceinline__ void norm_row(const Args& a, Ctx& c, int l, int row, int which  , f32x4 (&v)[4]) {
    float s = 0.f;
#pragma unroll
    for (int j = 0; j < 4; ++j) s += (v[j][0] * v[j][0] + v[j][1] * v[j][1]) + (v[j][2] * v[j][2] + v[j][3] * v[j][3]);
    const float rstd = 1.0f / sqrtf(wave_sum(s, c.lane) * (1.0f / D) + RMS_EPS);
    const float* gn = a.in(which ? 7 : 6) + (size_t)l * D; const float* md = (const float*)(c.ws + WS_MODS) + ((size_t)l * 9 + brow_of(row)) * NMOD + (which ? 3 * D : 0);
#pragma unroll
    for (int j = 0; j < 4; ++j) { const int col = 4 * c.lane + 256 * j; const f32x4 g = *(const f32x4*)(gn + col), sh = *(const f32x4*)(md + col), sc = *(const f32x4*)(md + D + col);
        v[j] = v[j] * rstd * g * (1.0f + sc) + sh; }
}
__device__ __forceinline__ void store_row_bf16(bf16_t* dst, int lane, const f32x4 (&v)[4]) {
#pragma unroll
    for (int j = 0; j < 4; ++j) { u32x2 w; w.x = pk2(v[j][0], v[j][1]); w.y = pk2(v[j][2], v[j][3]); *(u32x2*)(dst + 4 * lane + 256 * j) = w; }
}
__device__ __forceinline__ void load_x_row(const Args& a, Ctx& c, int l, int row, f32x4 (&v)[4]) {
    if (l == 0) { const float* xs = xrow_in(a, row); bf16_t* xb = (bf16_t*)(c.ws + WS_XB) + (size_t)row * D;
#pragma unroll
        for (int j = 0; j < 4; ++j) { v[j] = *(const f32x4*)(xs + 4 * c.lane + 256 * j); st_bf4(xb + 4 * c.lane + 256 * j, v[j]); }
    } else {
        bf16_t* xb = (bf16_t*)(c.ws + WS_XB) + (size_t)row * D;
        const bf16_t* sl = (const bf16_t*)(c.ws + WS_Z) + (size_t)row * 2 * D; const float* g2 = (const float*)(c.ws + WS_MODS) + ((size_t)(l - 1) * 9 + brow_of(row)) * NMOD + 5 * D;
#pragma unroll
        for (int j = 0; j < 4; ++j) { const int col = 4 * c.lane + 256 * j; const f32x4 g = *(const f32x4*)(g2 + col);
            v[j] = ld_bf4(xb + col) + g * (ld_bf4(sl + col) + ld_bf4(sl + D + col)); }
#pragma unroll
        for (int j = 0; j < 4; ++j) st_bf4(xb + 4 * c.lane + 256 * j, v[j]);
    }
}
constexpr int TR_I_IN = 16 * 48, TR_I_BS = 8 * 16, TR_I_OUT = 16 * 16, TR_I_GLU = 8 * 8, TR_I_W1 = 16 * 16 * 8, TR_I_W3 = TR_I_W1, TR_I_W2 = 16 * 8 * 16, TR_I_WC = 512;
constexpr int TR_NITEMS = TR_I_IN + TR_I_BS + TR_I_OUT + TR_I_GLU + TR_I_W1 + TR_I_W3 + TR_I_W2 + TR_I_WC;
struct RmGen { int off, w13; __device__ __forceinline__ int operator()(int n) const { return off + (w13 == 1 ? 256 * (n >> 7) + (n & 127) : (w13 == 2 && n >= 1024) ? 1024 + 256 * (((n - 1024) & 1023) >> 7) + 128 * ((n - 1024) >> 10) + (n & 127) : n); } };
__device__ __forceinline__ size_t wbuf_off(int l) { return (l & 1) ? WS_W2ND : WS_W; }
__device__ __forceinline__ void tr_one(const Args& a, Ctx& c, int l, int it, LAS bf16_t* scr) {
    bf16_t* WB = (bf16_t*)(c.ws + wbuf_off(l));
    int r = it;
    if (r < TR_NITEMS - TR_I_WC) {
        const float* src; int ldn, K, kb, nb; bf16_t* dst; RmGen rm{0, 0};
        if (r < TR_I_IN) { src = a.in(8) + (size_t)l * D * NZ; ldn = NZ; K = D; dst = WB + WO_WIN / 2; rm = RmGen{0, 2}; kb = r % 16; nb = r / 16; }
        else if ((r -= TR_I_IN) < TR_I_BS) { src = a.in(22) + (size_t)l * 512 * D; ldn = D; K = 512; dst = WB + WO_WBS / 2; kb = r % 8; nb = r / 8; }
        else if ((r -= TR_I_BS) < TR_I_OUT) { src = a.in(23) + (size_t)l * D * D; ldn = D; K = D; dst = WB + WO_WOUT / 2; kb = r % 16; nb = r / 16; }
        else if ((r -= TR_I_OUT) < TR_I_GLU) { src = a.in(19) + (size_t)l * 512 * 512; ldn = 512; K = 512; dst = WB + WO_GLU / 2; kb = r % 8; nb = r / 8; }
        else if ((r -= TR_I_GLU) < TR_I_W1) { const int e = r >> 7, q = r & 127; src = a.in(26) + ((size_t)l * NE + e) * D * DE; ldn = DE; K = D; dst = WB + WO_W13 / 2; rm = RmGen{e * 1024, 1}; kb = q % 16; nb = q / 16; }
        else if ((r -= TR_I_W1) < TR_I_W3) { const int e = r >> 7, q = r & 127; src = a.in(27) + ((size_t)l * NE + e) * D * DE; ldn = DE; K = D; dst = WB + WO_W13 / 2; rm = RmGen{e * 1024 + 128, 1}; kb = q % 16; nb = q / 16; }
        else { r -= TR_I_W3; const int e = r >> 7, q = r & 127; src = a.in(28) + ((size_t)l * NE + e) * DE * D; ldn = D; K = DE; dst = WB + WO_W2 / 2; rm = RmGen{e * 1024, 0}; kb = q % 8; nb = q / 8; }
        tr_item(src, ldn, K, dst, rm, scr, kb, nb, c.lane);
    } else {
        r -= TR_NITEMS - TR_I_WC;
        {
            const int g = r >> 7, cb = (r >> 4) & 7, db = r & 15, d = db * 64 + c.lane;
            const float* pw = a.in(9) + ((size_t)l * 4 + g) * 128 * 128 + (size_t)(cb * 16) * 128; const float* ps = a.in(10) + (size_t)l * 512 + g * 128;
            const float* wb = a.in(21) + ((size_t)l * 512 + g * 128) * D + d;
            LAS float* pl = (LAS float*)scr;
#pragma unroll
            for (int i = 0; i < 8; ++i) { const int e = i * 256 + c.lane * 4, q = e >> 7, c2 = e & 127; const f32x4 x = *(const f32x4*)(pw + e), sc4 = *(const f32x4*)(ps + c2);
                pl[(c2 + 0) * 16 + q] = x[0] * sc4[0]; pl[(c2 + 1) * 16 + q] = x[1] * sc4[1]; pl[(c2 + 2) * 16 + q] = x[2] * sc4[2]; pl[(c2 + 3) * 16 + q] = x[3] * sc4[3]; }
            LDS_WAIT(); asm volatile("" ::: "memory");
            float acc[16];
#pragma unroll
            for (int q = 0; q < 16; ++q) acc[q] = 0.f;
#pragma unroll 8
            for (int c2 = 0; c2 < 128; ++c2) { const float x = wb[(size_t)c2 * D]; const LAS f32x4* p4 = (const LAS f32x4*)(pl + c2 * 16);
#pragma unroll
                for (int q4 = 0; q4 < 4; ++q4) { const f32x4 w4 = p4[q4]; acc[q4 * 4 + 0] += w4[0] * x; acc[q4 * 4 + 1] += w4[1] * x; acc[q4 * 4 + 2] += w4[2] * x; acc[q4 * 4 + 3] += w4[3] * x; } }
            u32x4 o0, o1; o0.x = pk2(acc[0], acc[1]); o0.y = pk2(acc[2], acc[3]); o0.z = pk2(acc[4], acc[5]); o0.w = pk2(acc[6], acc[7]);
            o1.x = pk2(acc[8], acc[9]); o1.y = pk2(acc[10], acc[11]); o1.z = pk2(acc[12], acc[13]); o1.w = pk2(acc[14], acc[15]);
            bf16_t* dst = WB + WO_WC / 2 + (size_t)d * 512 + g * 128 + cb * 16; *(u32x4*)dst = o0; *(u32x4*)(dst + 8) = o1;
            LDS_WAIT(); asm volatile("" ::: "memory");
        }
    }
}
__device__ __forceinline__ void tr_range(const Args& a, Ctx& c, int l, int first, int last, int w, int nw) {
    LAS bf16_t* scr = (LAS bf16_t*)(c.lds + c.wave * 16384);
#pragma unroll 1
    for (int it = first + w; it < last; it += nw) tr_one(a, c, l, it, scr);
}
constexpr int TR_SPLIT = 3000, TR_SPLIT2 = 5500;
__device__ __forceinline__ void phase_a(const Args& a, Ctx& c, int l, const bool dummy = false) {
    const int gw = c.bid * NWAVES + c.wave, NGW = c.G * NWAVES;
    bf16_t* H = (bf16_t*)(c.ws + (dummy ? WS_HMID : WS_H)); bf16_t* XB = (bf16_t*)(c.ws + WS_XB); bf16_t* XBW = (bf16_t*)(c.ws + (dummy ? WS_HMID : WS_XB));
    const int rpb = (T + c.G - 1) / c.G, rbeg = c.bid * rpb + c.wave, rend = (c.bid + 1) * rpb < T ? (c.bid + 1) * rpb : T;
    f32x4 pg[4], psh[4], pg2[4]; int cur_b = -1; u32x2 nx[4], ns0[4], ns1[4];
    for (int row = rbeg; row < rend; row += NWAVES) {
        const int br = brow_of(row);
        if (br != cur_b) { cur_b = br;
            const float* gn = a.in(6) + (size_t)l * D; const float* md = (const float*)(c.ws + WS_MODS) + ((size_t)l * 9 + br) * NMOD;
            const float* g2 = (const float*)(c.ws + WS_MODS) + ((size_t)(l > 0 ? l - 1 : 0) * 9 + br) * NMOD + 5 * D;
#pragma unroll
            for (int j = 0; j < 4; ++j) { const int col = 4 * c.lane + 256 * j; pg[j] = *(const f32x4*)(gn + col) * (1.0f + *(const f32x4*)(md + D + col)); psh[j] = *(const f32x4*)(md + col); pg2[j] = *(const f32x4*)(g2 + col); } }
        f32x4 v[4];
        if (l == 0) { const float* xs = xrow_in(a, row);
#pragma unroll
            for (int j = 0; j < 4; ++j) v[j] = *(const f32x4*)(xs + 4 * c.lane + 256 * j);
        } else {
            if (row == rbeg) { const bf16_t* xb = XB + (size_t)row * D; const bf16_t* sl = (const bf16_t*)(c.ws + WS_Z) + (size_t)row * 2 * D;
#pragma unroll
                for (int j = 0; j < 4; ++j) { const int col = 4 * c.lane + 256 * j; nx[j] = *(const u32x2*)(xb + col); ns0[j] = *(const u32x2*)(sl + col); ns1[j] = *(const u32x2*)(sl + D + col); } }
            u32x2 cx[4], cs0[4], cs1[4];
#pragma unroll
            for (int j = 0; j < 4; ++j) { cx[j] = nx[j]; cs0[j] = ns0[j]; cs1[j] = ns1[j]; }
            if (row + NWAVES < rend) { const bf16_t* xb = XB + (size_t)(row + NWAVES) * D; const bf16_t* sl = (const bf16_t*)(c.ws + WS_Z) + (size_t)(row + NWAVES) * 2 * D;
#pragma unroll
                for (int j = 0; j < 4; ++j) { const int col = 4 * c.lane + 256 * j; nx[j] = *(const u32x2*)(xb + col); ns0[j] = *(const u32x2*)(sl + col); ns1[j] = *(const u32x2*)(sl + D + col); } }
#pragma unroll
            for (int j = 0; j < 4; ++j) { const f32x4 xv = {bflo(cx[j].x), bfhi(cx[j].x), bflo(cx[j].y), bfhi(cx[j].y)};
                const f32x4 y = {bflo(cs0[j].x) + bflo(cs1[j].x), bfhi(cs0[j].x) + bfhi(cs1[j].x), bflo(cs0[j].y) + bflo(cs1[j].y), bfhi(cs0[j].y) + bfhi(cs1[j].y)};
                v[j] = xv + pg2[j] * y; } }
        float ss = 0.f;
#pragma unroll
        for (int j = 0; j < 4; ++j) { st_bf4(XBW + (size_t)row * D + 4 * c.lane + 256 * j, v[j]); ss += (v[j][0] * v[j][0] + v[j][1] * v[j][1]) + (v[j][2] * v[j][2] + v[j][3] * v[j][3]); }
        const float rstd = 1.0f / sqrtf(wave_sum(ss, c.lane) * (1.0f / D) + RMS_EPS);
#pragma unroll
        for (int j = 0; j < 4; ++j) v[j] = v[j] * rstd * pg[j] + psh[j];
        store_row_bf16(H + (size_t)row * D, c.lane, v);
    }
}

__device__ __forceinline__ float fma_v(float a, float b, float c) { float d; asm("v_fma_f32 %0, %1, %2, %3" : "=v"(d) : "v"(a), "v"(b), "v"(c)); return d; }
__device__ __forceinline__ int tok_row(int b, int tc, int i) { return tc < 4 ? TL + b * CTXL + tc * 64 + i : b * SEQ + (tc - 4) * 64 + i; }
__device__ __forceinline__ int scan_chunk(int tc, int dir) { return dir == 0 ? tc : (tc < 4 ? 3 - tc : 71 - tc); }
__device__ __forceinline__ size_t car_idx(int b, int g, int dir, int cc, int n) { return ((((size_t)b * 32 + g) * 2 + dir) * NCH + cc) * 32 + n; }

#define S5_TILE(READ, dirv, tau)                                                                                                               \
    {                                                                                                                                          \
        const int r_ = lane & 31, sq_ = (r_ >> 2) & 1, stp_ = (r_ & 3) + 4 * (r_ >> 3);                                                        \
        const int ti_ = (dirv) == 0 ? 16 * (tau) + stp_ : 16 * (tau) + 15 - stp_;                                                              \
        const bf16x8 af_ = *(const bf16x8*)(Z + (size_t)tok_row(2 * bp + sq_, tc, ti_) * NZ + 512 + 16 * g + 8 * hh);                          \
        __builtin_amdgcn_sched_barrier(0);                                                                                                     \
        const f32x16 z16_ = {0.f, 0.f, 0.f, 0.f, 0.f, 0.f, 0.f, 0.f, 0.f, 0.f, 0.f, 0.f, 0.f, 0.f, 0.f, 0.f};                                  \
        f32x16 ur0_ = __builtin_amdgcn_mfma_f32_32x32x16_bf16(af_, bfr[0], z16_, 0, 0, 0);                                               \
        f32x16 ur1_ = __builtin_amdgcn_mfma_f32_32x32x16_bf16(af_, bfr[1], z16_, 0, 0, 0);                                               \
        f32x16 ui0_ = __builtin_amdgcn_mfma_f32_32x32x16_bf16(af_, bfr[2], z16_, 0, 0, 0);                                               \
        f32x16 ui1_ = __builtin_amdgcn_mfma_f32_32x32x16_bf16(af_, bfr[3], z16_, 0, 0, 0);                                                     \
        __builtin_amdgcn_sched_barrier(0);                                                                                                     \
        asm volatile("s_nop 15\n\ts_nop 15" : "+v"(ur0_), "+v"(ur1_), "+v"(ui0_), "+v"(ui1_) : "v"(af_), "v"(bfr[0]), "v"(bfr[1]), "v"(bfr[2]), "v"(bfr[3]));   \
        __builtin_amdgcn_sched_barrier(0);                                                                                                     \
        _Pragma("unroll") for (int i_ = 0; i_ < 16; ++i_) {                                                                                    \
              \
            const float n0_ = fma_v(ar0, hr0, fma_v(nai0, hi0, ur0_[i_])), m0_ = fma_v(ar0, hi0, fma_v(ai0, hr0, ui0_[i_]));                    \
            const float n1_ = fma_v(ar1, hr1, fma_v(nai1, hi1, ur1_[i_])), m1_ = fma_v(ar1, hi1, fma_v(ai1, hr1, ui1_[i_]));                    \
            hr0 = n0_; hi0 = m0_; hr1 = n1_; hi1 = m1_;                                                                                        \
            if (READ) { u32x2 w_; w_.x = pk2(hr0, hi0); w_.y = pk2(hr1, hi1); *(LAS u32x2*)(img + (hh * 16 + i_) * IMG_STRIDE + (lane & 31) * 8) = w_; } \
        }                                                                                                                                      \
        if (READ && (dirv) == 0) *(LAS bf16x8*)(img + (sq_ * 16 + stp_) * IMG_STRIDE + 256 + hh * 16) = af_;                                   \
    }

#define S5_TILEP(READ, dirv, tau, afv)                                                                                                               \
    {                                                                                                                                          \
        const int r_ = lane & 31, sq_ = (r_ >> 2) & 1, stp_ = (r_ & 3) + 4 * (r_ >> 3);                                                        \
        const int ti_ = (dirv) == 0 ? 16 * (tau) + stp_ : 16 * (tau) + 15 - stp_;                                                              \
        const bf16x8 af_ = (afv);                          \
        __builtin_amdgcn_sched_barrier(0);                                                                                                     \
        const f32x16 z16_ = {0.f, 0.f, 0.f, 0.f, 0.f, 0.f, 0.f, 0.f, 0.f, 0.f, 0.f, 0.f, 0.f, 0.f, 0.f, 0.f};                                  \
        f32x16 ur0_ = __builtin_amdgcn_mfma_f32_32x32x16_bf16(af_, bfr[0], z16_, 0, 0, 0);                                               \
        f32x16 ur1_ = __builtin_amdgcn_mfma_f32_32x32x16_bf16(af_, bfr[1], z16_, 0, 0, 0);                                               \
        f32x16 ui0_ = __builtin_amdgcn_mfma_f32_32x32x16_bf16(af_, bfr[2], z16_, 0, 0, 0);                                               \
        f32x16 ui1_ = __builtin_amdgcn_mfma_f32_32x32x16_bf16(af_, bfr[3], z16_, 0, 0, 0);                                                     \
        __builtin_amdgcn_sched_barrier(0);                                                                                                     \
        asm volatile("s_nop 15\n\ts_nop 15" : "+v"(ur0_), "+v"(ur1_), "+v"(ui0_), "+v"(ui1_) : "v"(af_), "v"(bfr[0]), "v"(bfr[1]), "v"(bfr[2]), "v"(bfr[3]));   \
        __builtin_amdgcn_sched_barrier(0);                                                                                                     \
        _Pragma("unroll") for (int i_ = 0; i_ < 16; ++i_) {                                                                                    \
              \
            const float n0_ = fma_v(ar0, hr0, fma_v(nai0, hi0, ur0_[i_])), m0_ = fma_v(ar0, hi0, fma_v(ai0, hr0, ui0_[i_]));                    \
            const float n1_ = fma_v(ar1, hr1, fma_v(nai1, hi1, ur1_[i_])), m1_ = fma_v(ar1, hi1, fma_v(ai1, hr1, ui1_[i_]));                    \
            hr0 = n0_; hi0 = m0_; hr1 = n1_; hi1 = m1_;                                                                                        \
            if (READ) { u32x2 w_; w_.x = pk2(hr0, hi0); w_.y = pk2(hr1, hi1); *(LAS u32x2*)(img + (hh * 16 + i_) * IMG_STRIDE + (lane & 31) * 8) = w_; } \
        }                                                                                                                                      \
        if (READ && (dirv) == 0) *(LAS bf16x8*)(img + (sq_ * 16 + stp_) * IMG_STRIDE + 256 + hh * 16) = af_;                                   \
    }

__device__ __forceinline__ bf16x8 s5_afrag(const bf16_t* Z, int bp, int tc, int g, int dir, int tau, int lane) {
    const int r = lane & 31, sq = (r >> 2) & 1, stp = (r & 3) + 4 * (r >> 3), hh = lane >> 5;
    const int ti = dir == 0 ? 16 * tau + stp : 16 * tau + 15 - stp;
    return *(const bf16x8*)(Z + ((size_t)g * T + tok_row(2 * bp + sq, tc, ti)) * 16 + 8 * hh);
}
__device__ __forceinline__ bf16x8 s1_afrag(const bf16_t* Z, int bp, int tc, int g, int dir, int ks, int lane) {
    const int r = lane & 31, sq = (r >> 2) & 1, b4 = (r & 3) + 4 * (r >> 3), hh = lane >> 5;
    const int sg = 4 * b4 + ks, ti = dir == 0 ? sg : 63 - sg;
    return *(const bf16x8*)(Z + ((size_t)g * T + tok_row(2 * bp + sq, tc, ti)) * 16 + 8 * hh);
}
__device__ __forceinline__ void phase_s1(const Args& a, Ctx& c, int l, size_t dst_off = WS_CAR) {
    const bf16_t* Z = (const bf16_t*)(c.ws + WS_U); f32x4* CAR = (f32x4*)(c.ws + dst_off);
    const f32x2* AB = (const f32x2*)(c.ws + WS_AB); const bf16x8* BF = (const bf16x8*)(c.ws + WS_BF);
    const int lane = c.lane, hh = lane >> 5;
    constexpr int NT1 = 4 * NCH * 8;
    const int dir = c.wave & 1;
    int cur_ldg = -1; float qr0 = 0.f, qi0 = 0.f, qr1 = 0.f, qi1 = 0.f, nqi0 = 0.f, nqi1 = 0.f; bf16x8 W[4][4], afc[4], afn[4];
#pragma unroll
    for (int f = 0; f < 4; ++f) { afc[f] = (bf16x8){0, 0, 0, 0, 0, 0, 0, 0}; afn[f] = afc[f];
#pragma unroll
        for (int k = 0; k < 4; ++k) W[k][f] = afc[f]; }
    if (c.bid < NT1) { const int bt = c.bid, rest = bt >> 3, tc = rest % NCH, bp = rest / NCH, g = (bt & 7) * 4 + (c.wave >> 1);
#pragma unroll
        for (int ks = 0; ks < 4; ++ks) afc[ks] = s1_afrag(Z, bp, tc, g, dir, ks, lane); }
    for (int bt = c.bid; bt < NT1; bt += c.G) {
        const int gq = bt & 7, rest = bt >> 3, tc = rest % NCH, bp = rest / NCH; const int g = gq * 4 + (c.wave >> 1);
        const int ldg = (l * 2 + dir) * 32 + g;
        if (ldg != cur_ldg) { cur_ldg = ldg;
            const f32x2 a0 = AB[ldg * 64 + (lane & 31)], a1 = AB[ldg * 64 + 32 + (lane & 31)];
            u32x4 bw[4];
#pragma unroll
            for (int f = 0; f < 4; ++f) bw[f] = __builtin_bit_cast(u32x4, BF[(ldg * 4 + f) * 64 + lane]);
            f32x4 br0a, br0b, br1a, br1b, bi0a, bi0b, bi1a, bi1b; pg8::unpack8(bw[0], br0a, br0b); pg8::unpack8(bw[1], br1a, br1b); pg8::unpack8(bw[2], bi0a, bi0b); pg8::unpack8(bw[3], bi1a, bi1b);
            float pr0 = 1.f, pi0 = 0.f, pr1 = 1.f, pi1 = 0.f;
#pragma unroll
            for (int ks = 3; ks >= 0; --ks) {
                W[ks][0] = __builtin_bit_cast(bf16x8, pg8::pack8(br0a * pr0 - bi0a * pi0, br0b * pr0 - bi0b * pi0));
                W[ks][1] = __builtin_bit_cast(bf16x8, pg8::pack8(br1a * pr1 - bi1a * pi1, br1b * pr1 - bi1b * pi1));
                W[ks][2] = __builtin_bit_cast(bf16x8, pg8::pack8(bi0a * pr0 + br0a * pi0, bi0b * pr0 + br0b * pi0));
                W[ks][3] = __builtin_bit_cast(bf16x8, pg8::pack8(bi1a * pr1 + br1a * pi1, bi1b * pr1 + br1b * pi1));
                const float t0 = pr0 * a0.x - pi0 * a0.y, u0 = pr0 * a0.y + pi0 * a0.x, t1 = pr1 * a1.x - pi1 * a1.y, u1 = pr1 * a1.y + pi1 * a1.x; pr0 = t0; pi0 = u0; pr1 = t1; pi1 = u1; }
            qr0 = pr0; qi0 = pi0; nqi0 = -pi0; qr1 = pr1; qi1 = pi1; nqi1 = -pi1; }
        const int nb = bt + c.G;
        if (nb < NT1) { const int nrest = nb >> 3, ntc = nrest % NCH, nbp = nrest / NCH, ng = (nb & 7) * 4 + (c.wave >> 1);
#pragma unroll
            for (int ks = 0; ks < 4; ++ks) afn[ks] = s1_afrag(Z, nbp, ntc, ng, dir, ks, lane); }
        const f32x16 z16 = {0.f, 0.f, 0.f, 0.f, 0.f, 0.f, 0.f, 0.f, 0.f, 0.f, 0.f, 0.f, 0.f, 0.f, 0.f, 0.f};
        f32x16 cr0 = z16, cr1 = z16, ci0 = z16, ci1 = z16;
        __builtin_amdgcn_sched_barrier(0);
#pragma unroll
        for (int ks = 0; ks < 4; ++ks) {
            cr0 = __builtin_amdgcn_mfma_f32_32x32x16_bf16(afc[ks], W[ks][0], cr0, 0, 0, 0);
            cr1 = __builtin_amdgcn_mfma_f32_32x32x16_bf16(afc[ks], W[ks][1], cr1, 0, 0, 0);
            ci0 = __builtin_amdgcn_mfma_f32_32x32x16_bf16(afc[ks], W[ks][2], ci0, 0, 0, 0);
            ci1 = __builtin_amdgcn_mfma_f32_32x32x16_bf16(afc[ks], W[ks][3], ci1, 0, 0, 0); }
        __builtin_amdgcn_sched_barrier(0);
        asm volatile("s_nop 15\n\ts_nop 15" : "+v"(cr0), "+v"(cr1), "+v"(ci0), "+v"(ci1) : "v"(afc[0]), "v"(afc[1]), "v"(afc[2]), "v"(afc[3]));
        __builtin_amdgcn_sched_barrier(0);
        float hr0 = 0.f, hi0 = 0.f, hr1 = 0.f, hi1 = 0.f;
#pragma unroll
        for (int i = 0; i < 16; ++i) {
            const float n0 = fma_v(qr0, hr0, fma_v(nqi0, hi0, cr0[i])), m0 = fma_v(qr0, hi0, fma_v(qi0, hr0, ci0[i]));
            const float n1 = fma_v(qr1, hr1, fma_v(nqi1, hi1, cr1[i])), m1 = fma_v(qr1, hi1, fma_v(qi1, hr1, ci1[i]));
            hr0 = n0; hi0 = m0; hr1 = n1; hi1 = m1; }
#pragma unroll
        for (int ks = 0; ks < 4; ++ks) afc[ks] = afn[ks];
        CAR[car_idx(2 * bp + hh, g, dir, scan_chunk(tc, dir), lane & 31)] = (f32x4){hr0, hi0, hr1, hi1};
    }
}
__device__ __forceinline__ void phase_s12(const Args& a, Ctx& c, int l) {
    const bf16_t* Z = (const bf16_t*)(c.ws + WS_U); f32x4* HIN = (f32x4*)(c.ws + WS_CAR2);
    const f32x2* AB = (const f32x2*)(c.ws + WS_AB); const bf16x8* BF = (const bf16x8*)(c.ws + WS_BF);
    const int lane = c.lane, hh = lane >> 5;
    LAS f32x4* pre = (LAS f32x4*)(c.lds + c.wave * (9 * 1024));
    LAS f32x4* exch = (LAS f32x4*)(c.lds + 8 * 9 * 1024);
    const int s0 = c.wave < 4 ? 9 * c.wave : 36 + 8 * (c.wave - 4), len = c.wave < 4 ? 9 : 8;
    for (int ct = c.bid; ct < 4 * 32 * 2; ct += c.G) {
        const int bp = ct >> 6, g = (ct >> 1) & 31, dir = ct & 1; const int ldg = (l * 2 + dir) * 32 + g;
        bf16x8 W[4][4]; float qr0, qi0, qr1, qi1, nqi0, nqi1;
        {   const f32x2 a0 = AB[ldg * 64 + (lane & 31)], a1 = AB[ldg * 64 + 32 + (lane & 31)];
            u32x4 bw[4];
#pragma unroll
            for (int f = 0; f < 4; ++f) bw[f] = __builtin_bit_cast(u32x4, BF[(ldg * 4 + f) * 64 + lane]);
            f32x4 br0a, br0b, br1a, br1b, bi0a, bi0b, bi1a, bi1b; pg8::unpack8(bw[0], br0a, br0b); pg8::unpack8(bw[1], br1a, br1b); pg8::unpack8(bw[2], bi0a, bi0b); pg8::unpack8(bw[3], bi1a, bi1b);
            float pr0 = 1.f, pi0 = 0.f, pr1 = 1.f, pi1 = 0.f;
#pragma unroll
            for (int ks = 3; ks >= 0; --ks) {
                W[ks][0] = __builtin_bit_cast(bf16x8, pg8::pack8(br0a * pr0 - bi0a * pi0, br0b * pr0 - bi0b * pi0));
                W[ks][1] = __builtin_bit_cast(bf16x8, pg8::pack8(br1a * pr1 - bi1a * pi1, br1b * pr1 - bi1b * pi1));
                W[ks][2] = __builtin_bit_cast(bf16x8, pg8::pack8(bi0a * pr0 + br0a * pi0, bi0b * pr0 + br0b * pi0));
                W[ks][3] = __builtin_bit_cast(bf16x8, pg8::pack8(bi1a * pr1 + br1a * pi1, bi1b * pr1 + br1b * pi1));
                const float t0 = pr0 * a0.x - pi0 * a0.y, u0 = pr0 * a0.y + pi0 * a0.x, t1 = pr1 * a1.x - pi1 * a1.y, u1 = pr1 * a1.y + pi1 * a1.x; pr0 = t0; pi0 = u0; pr1 = t1; pi1 = u1; }
            qr0 = pr0; qi0 = pi0; nqi0 = -pi0; qr1 = pr1; qi1 = pi1; nqi1 = -pi1; }
        bf16x8 afc[4], afn[4];
        { const int cc = s0, tc = dir == 0 ? cc : (cc < 4 ? 3 - cc : 71 - cc);
#pragma unroll
            for (int ks = 0; ks < 4; ++ks) { afc[ks] = s1_afrag(Z, bp, tc, g, dir, ks, lane); afn[ks] = afc[ks]; } }
        float hr0 = 0.f, hi0 = 0.f, hr1 = 0.f, hi1 = 0.f;
        __syncthreads();
#pragma unroll 1
        for (int k = 0; k < len; ++k) {
            if (k + 1 < len) { const int cc = s0 + k + 1, tc = dir == 0 ? cc : (cc < 4 ? 3 - cc : 71 - cc);
#pragma unroll
                for (int ks = 0; ks < 4; ++ks) afn[ks] = s1_afrag(Z, bp, tc, g, dir, ks, lane); }
            const f32x16 z16 = {0.f, 0.f, 0.f, 0.f, 0.f, 0.f, 0.f, 0.f, 0.f, 0.f, 0.f, 0.f, 0.f, 0.f, 0.f, 0.f};
            f32x16 cr0 = z16, cr1 = z16, ci0 = z16, ci1 = z16;
            asm volatile("" : "+v"(cr0), "+v"(cr1), "+v"(ci0), "+v"(ci1));
            __builtin_amdgcn_sched_barrier(0);
#pragma unroll
            for (int ks = 0; ks < 4; ++ks) {
                cr0 = __builtin_amdgcn_mfma_f32_32x32x16_bf16(afc[ks], W[ks][0], cr0, 0, 0, 0);
                cr1 = __builtin_amdgcn_mfma_f32_32x32x16_bf16(afc[ks], W[ks][1], cr1, 0, 0, 0);
                ci0 = __builtin_amdgcn_mfma_f32_32x32x16_bf16(afc[ks], W[ks][2], ci0, 0, 0, 0);
                ci1 = __builtin_amdgcn_mfma_f32_32x32x16_bf16(afc[ks], W[ks][3], ci1, 0, 0, 0); }
            __builtin_amdgcn_sched_barrier(0);
            asm volatile("s_nop 15\n\ts_nop 15" : "+v"(cr0), "+v"(cr1), "+v"(ci0), "+v"(ci1) : "v"(afc[0]), "v"(afc[1]), "v"(afc[2]), "v"(afc[3]));
            __builtin_amdgcn_sched_barrier(0);
            pre[k * 64 + lane] = (f32x4){hr0, hi0, hr1, hi1};
#pragma unroll
            for (int i = 0; i < 16; ++i) {
                const float n0 = fma_v(qr0, hr0, fma_v(nqi0, hi0, cr0[i])), m0 = fma_v(qr0, hi0, fma_v(qi0, hr0, ci0[i]));
                const float n1 = fma_v(qr1, hr1, fma_v(nqi1, hi1, cr1[i])), m1 = fma_v(qr1, hi1, fma_v(qi1, hr1, ci1[i]));
                hr0 = n0; hi0 = m0; hr1 = n1; hi1 = m1; }
#pragma unroll
            for (int ks = 0; ks < 4; ++ks) afc[ks] = afn[ks];
        }
        exch[c.wave * 64 + lane] = (f32x4){hr0, hi0, hr1, hi1};
        float p0r = qr0, p0i = qi0, p1r = qr1, p1i = qi1;
#pragma unroll
        for (int sq = 0; sq < 4; ++sq) { const float t0 = p0r * p0r - p0i * p0i, u0 = 2.0f * p0r * p0i, t1 = p1r * p1r - p1i * p1i, u1 = 2.0f * p1r * p1i; p0r = t0; p0i = u0; p1r = t1; p1i = u1; }
        float e0r = p0r, e0i = p0i, e1r = p1r, e1i = p1i;
#pragma unroll
        for (int sq = 0; sq < 3; ++sq) { const float t0 = e0r * e0r - e0i * e0i, u0 = 2.0f * e0r * e0i, t1 = e1r * e1r - e1i * e1i, u1 = 2.0f * e1r * e1i; e0r = t0; e0i = u0; e1r = t1; e1i = u1; }
        const float n0r = e0r * p0r - e0i * p0i, n0i = e0r * p0i + e0i * p0r, n1r = e1r * p1r - e1i * p1i, n1i = e1r * p1i + e1i * p1r;
        __syncthreads();
        float c0r = 0.f, c0i = 0.f, c1r = 0.f, c1i = 0.f;
        for (int v = 0; v < c.wave; ++v) { const f32x4 e = exch[v * 64 + lane]; const bool nine = v < 4;
            const float m0r = nine ? n0r : e0r, m0i = nine ? n0i : e0i, m1r = nine ? n1r : e1r, m1i = nine ? n1i : e1i;
            const float t0 = m0r * c0r - m0i * c0i + e[0], u0 = m0r * c0i + m0i * c0r + e[1], t1 = m1r * c1r - m1i * c1i + e[2], u1 = m1r * c1i + m1i * c1r + e[3];
            c0r = t0; c0i = u0; c1r = t1; c1i = u1; }
#pragma unroll 1
        for (int k = 0; k < len; ++k) { const f32x4 pv = pre[k * 64 + lane]; const int cc = s0 + k;
            HIN[car_idx(2 * bp + hh, g, dir, cc, lane & 31)] = (f32x4){pv[0] + c0r, pv[1] + c0i, pv[2] + c1r, pv[3] + c1i};
            const float t0 = p0r * c0r - p0i * c0i, u0 = p0r * c0i + p0i * c0r, t1 = p1r * c1r - p1i * c1i, u1 = p1r * c1i + p1i * c1r; c0r = t0; c0i = u0; c1r = t1; c1i = u1; }
    }
    __syncthreads();
}
__device__ __forceinline__ void phase_s2(const Args& a, Ctx& c, int l) {
    if (c.tid >= 128) return;
    for (int gid = c.bid * 128 + c.tid; gid < NB * 32 * 2 * 32 * 2; gid += c.G * 128) {
    const int tile = gid & 1, n = (gid >> 1) & 31, dir = (gid >> 6) & 1, g = (gid >> 7) & 31, b = gid >> 12;
    const f32x2* AB = (const f32x2*)(c.ws + WS_AB); const f32x2* __restrict__ E = (const f32x2*)(c.ws + WS_CAR); f32x2* __restrict__ HIN = (f32x2*)(c.ws + WS_CAR2);
    f32x2 p = AB[((l * 2 + dir) * 32 + g) * 64 + tile * 32 + n];
#pragma unroll
    for (int s = 0; s < 6; ++s) { const float pr = p.x * p.x - p.y * p.y, pi = 2.0f * p.x * p.y; p.x = pr; p.y = pi; }
    float hr = 0.f, hi = 0.f; const size_t base = car_idx(b, g, dir, 0, n) * 2 + tile;
#pragma unroll 1
    for (int c0 = 0; c0 < NCH; c0 += 17) {
        f32x2 e[17];
#pragma unroll
        for (int k = 0; k < 17; ++k) e[k] = E[base + (size_t)(c0 + k) * 64];
#pragma unroll
        for (int k = 0; k < 17; ++k) { HIN[base + (size_t)(c0 + k) * 64] = (f32x2){hr, hi};
            const float nr = p.x * hr - p.y * hi + e[k].x, ni = p.x * hi + p.y * hr + e[k].y; hr = nr; hi = ni; }
    }
    }
}
__device__ __forceinline__ bf16x8 s3_afrag(const bf16_t* Z, int bp, int tc, int g, int dir, int ks, int lane) {
    const int r = lane & 31, sq = (r >> 2) & 1, i = (r & 3) + 4 * (r >> 3), hh = lane >> 5;
    const int ti = dir == 0 ? 4 * i + ks : 4 * i + 3 - ks;
    return *(const bf16x8*)(Z + ((size_t)g * T + tok_row(2 * bp + sq, tc, ti)) * 16 + 8 * hh);
}
constexpr int S3_IMG = 272;
__device__ __forceinline__ constexpr int s3_skip(int dir, int f) { return f == (dir == 0 ? 16 : 17) || f == (dir == 0 ? 22 : 23); }
__device__ __forceinline__ constexpr int s3_pidx(int dir, int f) { return f - (f > (dir == 0 ? 16 : 17) ? 1 : 0) - (f > (dir == 0 ? 22 : 23) ? 1 : 0); }
constexpr int S3_TB = 38 * 1024;
__device__ __forceinline__ void phase_s3(const Args& a, Ctx& c, int l) {
    const bf16_t* Z = (const bf16_t*)(c.ws + WS_U); const f32x4* CAR = (const f32x4*)(c.ws + WS_CAR2); bf16_t* YG = (bf16_t*)(c.ws + WS_YG);
    const f32x2* AB = (const f32x2*)(c.ws + WS_AB); const u32x4* TB = (const u32x4*)(c.ws + WS_S3T);
    const int lane = c.lane, hh = lane >> 5, col = lane & 31;
    LAS unsigned char* tbl = c.lds;
    LAS unsigned char* img = c.lds + (c.wave < 6 ? 2 * S3_TB + c.wave * (32 * S3_IMG) : c.wave == 6 ? MISC_OFF + 1024 : LDS_BYTES - 16384);
    const int tc0 = (l == DEPTH - 1) ? 4 : 0, ntc = NCH - tc0, ncombo = 4 * ntc, ngrp = (ncombo + 7) >> 3;
    int cur_g = -1;
    const f32x16 z16 = {0.f, 0.f, 0.f, 0.f, 0.f, 0.f, 0.f, 0.f, 0.f, 0.f, 0.f, 0.f, 0.f, 0.f, 0.f, 0.f};
    float qq[2][6];
    bf16x8 af[2][4]; f32x4 hc[2];
#pragma unroll
    for (int d = 0; d < 2; ++d) { hc[d] = (f32x4){0.f, 0.f, 0.f, 0.f};
#pragma unroll
        for (int k = 0; k < 6; ++k) qq[d][k] = 0.f;
#pragma unroll
        for (int ks = 0; ks < 4; ++ks) af[d][ks] = (bf16x8){0, 0, 0, 0, 0, 0, 0, 0}; }
    const bool worker = true;
    for (int wt = c.bid; wt < 32 * ngrp; wt += c.G) {
        const int g = ((wt >> 3) & 3) | ((wt & 7) << 2), grp = wt >> 5;
        if (g != cur_g) { cur_g = g; __syncthreads();
            for (int i = c.tid; i < 2 * 40 * 64; i += NTHREADS) { const int d = i / 2560, r = i - d * 2560, f = r >> 6; if (!s3_skip(d, f)) *(LAS u32x4*)(tbl + d * S3_TB + (s3_pidx(d, f) * 64 + (r & 63)) * 16) = TB[(size_t)((l * 2 + d) * 32 + g) * 2560 + r]; }
#pragma unroll
            for (int d = 0; d < 2; ++d) { const int ldg = (l * 2 + d) * 32 + g; const f32x2 a0 = AB[ldg * 64 + col], a1 = AB[ldg * 64 + 32 + col];
                const float s0r = a0.x * a0.x - a0.y * a0.y, s0i = 2.0f * a0.x * a0.y, s1r = a1.x * a1.x - a1.y * a1.y, s1i = 2.0f * a1.x * a1.y;
                qq[d][0] = s0r * s0r - s0i * s0i; qq[d][1] = 2.0f * s0r * s0i; qq[d][2] = -qq[d][1]; qq[d][3] = s1r * s1r - s1i * s1i; qq[d][4] = 2.0f * s1r * s1i; qq[d][5] = -qq[d][4]; }
            __syncthreads(); }
        const int combo = grp * 8 + c.wave;
        if (worker && combo < ncombo) {
            const int tc = tc0 + combo % ntc, bp = combo / ntc;
#pragma unroll
            for (int d = 0; d < 2; ++d) hc[d] = CAR[car_idx(2 * bp + hh, g, d, scan_chunk(tc, d), col)];
#pragma unroll
            for (int ks = 0; ks < 4; ++ks) af[0][ks] = s3_afrag(Z, bp, tc, g, 0, ks, lane);
            f32x16 y0 = z16, y1 = z16;
            asm volatile("" : "+v"(y0), "+v"(y1));
#pragma unroll
            for (int dir = 0; dir < 2; ++dir) {
                const LAS unsigned char* tb = tbl + dir * S3_TB + lane * 16;
                if (dir == 1) {
#pragma unroll
                    for (int ks = 0; ks < 2; ++ks) { const bf16x8 t = af[0][ks]; af[0][ks] = af[0][3 - ks]; af[0][3 - ks] = t; } }
                const f32x4 h0 = hc[dir];
                f32x16 cr0 = z16, cr1 = z16, ci0 = z16, ci1 = z16;
                asm volatile("" : "+v"(cr0), "+v"(cr1), "+v"(ci0), "+v"(ci1));
                __builtin_amdgcn_sched_barrier(0);
                {
                    bf16x8 bq[2][6];
#pragma unroll
                    for (int nb = 0; nb < 6; ++nb) bq[0][nb] = *(const LAS bf16x8*)(tb + s3_pidx(dir, nb) * 1024);
#pragma unroll
                    for (int ks = 0; ks < 4; ++ks) {
                        if (ks < 3) {
#pragma unroll
                            for (int nb = 0; nb < 6; ++nb) if (!s3_skip(dir, (ks + 1) * 6 + nb)) bq[(ks + 1) & 1][nb] = *(const LAS bf16x8*)(tb + s3_pidx(dir, (ks + 1) * 6 + nb) * 1024); }
                        __builtin_amdgcn_sched_barrier(0);
                        cr0 = __builtin_amdgcn_mfma_f32_32x32x16_bf16(af[0][ks], bq[ks & 1][0], cr0, 0, 0, 0); cr1 = __builtin_amdgcn_mfma_f32_32x32x16_bf16(af[0][ks], bq[ks & 1][1], cr1, 0, 0, 0);
                        ci0 = __builtin_amdgcn_mfma_f32_32x32x16_bf16(af[0][ks], bq[ks & 1][2], ci0, 0, 0, 0); ci1 = __builtin_amdgcn_mfma_f32_32x32x16_bf16(af[0][ks], bq[ks & 1][3], ci1, 0, 0, 0);
                        if (!s3_skip(dir, ks * 6 + 4)) y0 = __builtin_amdgcn_mfma_f32_32x32x16_bf16(af[0][ks], bq[ks & 1][4], y0, 0, 0, 0);
                        if (!s3_skip(dir, ks * 6 + 5)) y1 = __builtin_amdgcn_mfma_f32_32x32x16_bf16(af[0][ks], bq[ks & 1][5], y1, 0, 0, 0);
                        __builtin_amdgcn_sched_barrier(0); } }
                __builtin_amdgcn_sched_barrier(0);
                asm volatile("s_nop 15\n\ts_nop 15" : "+v"(cr0), "+v"(cr1), "+v"(ci0), "+v"(ci1) : "v"(af[0][0]), "v"(af[0][1]), "v"(af[0][2]), "v"(af[0][3]));
                __builtin_amdgcn_sched_barrier(0);
                const float q0r = qq[dir][0], q0i = qq[dir][1], nq0i = qq[dir][2], q1r = qq[dir][3], q1i = qq[dir][4], nq1i = qq[dir][5];
                float hr0 = h0[0], hi0 = h0[1], hr1 = h0[2], hi1 = h0[3];
#pragma unroll
                for (int be = 0; be < 16; ++be) { const int i = dir == 0 ? be : 15 - be; const int rho = (i & 3) + 4 * hh + 8 * (i >> 2);
                    *(LAS unsigned*)(img + rho * S3_IMG + 4 * col) = pk2(hr0, hi0); *(LAS unsigned*)(img + rho * S3_IMG + 128 + 4 * col) = pk2(hr1, hi1);
                    const float n0 = fma_v(q0r, hr0, fma_v(nq0i, hi0, cr0[i])), m0 = fma_v(q0r, hi0, fma_v(q0i, hr0, ci0[i]));
                    const float n1 = fma_v(q1r, hr1, fma_v(nq1i, hi1, cr1[i])), m1 = fma_v(q1r, hi1, fma_v(q1i, hr1, ci1[i]));
                    hr0 = n0; hi0 = m0; hr1 = n1; hi1 = m1; }
                asm volatile("" ::: "memory");
                {
                    bf16x8 hq[2][2][3];
#pragma unroll
                    for (int e = 0; e < 2; ++e) { hq[0][e][0] = *(const LAS bf16x8*)(img + col * S3_IMG + 32 * e + 16 * hh); hq[0][e][1] = *(const LAS bf16x8*)(tb + (22 + 2 * e) * 1024); hq[0][e][2] = *(const LAS bf16x8*)(tb + (23 + 2 * e) * 1024); }
#pragma unroll
                    for (int k2 = 0; k2 < 4; ++k2) {
                        if (k2 < 3) {
#pragma unroll
                            for (int e = 0; e < 2; ++e) { const int kk = 2 * (k2 + 1) + e; hq[(k2 + 1) & 1][e][0] = *(const LAS bf16x8*)(img + col * S3_IMG + 32 * kk + 16 * hh);
                                hq[(k2 + 1) & 1][e][1] = *(const LAS bf16x8*)(tb + (22 + 2 * kk) * 1024); hq[(k2 + 1) & 1][e][2] = *(const LAS bf16x8*)(tb + (23 + 2 * kk) * 1024); } }
                        __builtin_amdgcn_sched_barrier(0);
#pragma unroll
                        for (int e = 0; e < 2; ++e) { y0 = __builtin_amdgcn_mfma_f32_32x32x16_bf16(hq[k2 & 1][e][0], hq[k2 & 1][e][1], y0, 0, 0, 0); y1 = __builtin_amdgcn_mfma_f32_32x32x16_bf16(hq[k2 & 1][e][0], hq[k2 & 1][e][2], y1, 0, 0, 0); }
                        __builtin_amdgcn_sched_barrier(0); } }
                asm volatile("" ::: "memory");
            }
            __builtin_amdgcn_sched_barrier(0);
            asm volatile("s_nop 15\n\ts_nop 15" : "+v"(y0), "+v"(y1));
            __builtin_amdgcn_sched_barrier(0);
#pragma unroll
            for (int nb = 0; nb < 2; ++nb)
#pragma unroll
                for (int i = 0; i < 16; ++i) { const float v = gelu_t(nb == 0 ? y0[i] : y1[i]);
                    const int tok = 4 * i + 2 * nb + (col >> 4);
                    *(LAS bf16_t*)(img + ((hh * 64 + tok) * 16 + (col & 15)) * 2) = (bf16_t)(pk2(v, v) & 0xffffu); }
            asm volatile("" ::: "memory");
#pragma unroll
            for (int k = 0; k < 4; ++k) { const int chunk = lane + 64 * k, row = chunk >> 1, half = chunk & 1;
                const u32x4 w = *(const LAS u32x4*)(img + chunk * 16);
                *(u32x4*)(YG + ((size_t)g * T + tok_row(2 * bp + (row >> 6), tc, row & 63)) * 16 + 8 * half) = w; }
            asm volatile("" ::: "memory");
        }
    }
    __syncthreads();
}

__device__ __forceinline__ void acc8(float (&s)[8], u32x4 w) { s[0] += bflo(w.x); s[1] += bfhi(w.x); s[2] += bflo(w.y); s[3] += bfhi(w.y); s[4] += bflo(w.z); s[5] += bfhi(w.z); s[6] += bflo(w.w); s[7] += bfhi(w.w); }
__device__ __forceinline__ void sub8(float (&s)[8], u32x4 w) { s[0] -= bflo(w.x); s[1] -= bfhi(w.x); s[2] -= bflo(w.y); s[3] -= bfhi(w.y); s[4] -= bflo(w.z); s[5] -= bfhi(w.z); s[6] -= bflo(w.w); s[7] -= bfhi(w.w); }
constexpr int POOL_TASKS = NB * 8 * 4 * 2;
constexpr int PV_CSTR = 144, PV_RSTR = 64 * PV_CSTR;
__device__ __forceinline__ void phase_pool(Ctx& c, const int wi, const int nw, const int t0, const int t1, const bool ctx) {
    const bf16_t* Z = (const bf16_t*)(c.ws + WS_Z); bf16_t* PD = (bf16_t*)(c.ws + WS_H);
    LAS unsigned char* V = c.lds;
    __syncthreads();
    for (int task = t0 + wi; task < t1; task += nw) {
        const int half = task & 1, g = (task >> 1) & 3, band = (task >> 3) & 7, b = task >> 6, hw = 1 << g, r0 = band * 8;
        const int ck = c.tid & 7, chn = 128 * g + 64 * half + 8 * ck;
        {
            const int cc = c.tid >> 3; const bf16_t* base = Z + (size_t)(b * SEQ + cc) * NZ + chn; const size_t rstep = (size_t)64 * NZ;
            float sm[8];
#pragma unroll
            for (int j = 0; j < 8; ++j) sm[j] = 0.f;
            const int lo0 = r0 - hw < 0 ? 0 : r0 - hw, hi0 = r0 + hw > 64 ? 64 : r0 + hw;
            const u32x4 zz = {0u, 0u, 0u, 0u};
            u32x4 wi[16], wa[7], wb[7];
#pragma unroll
            for (int j = 0; j < 16; ++j) { const int rr = lo0 + j < hi0 ? lo0 + j : hi0 - 1; wi[j] = *(const u32x4*)(base + (size_t)rr * rstep); }
#pragma unroll
            for (int i = 1; i < 8; ++i) { const int ra = r0 + i + hw - 1 < 64 ? r0 + i + hw - 1 : 63, rs = r0 + i - hw - 1 >= 0 ? r0 + i - hw - 1 : 0;
                wa[i - 1] = *(const u32x4*)(base + (size_t)ra * rstep); wb[i - 1] = *(const u32x4*)(base + (size_t)rs * rstep); }
            __builtin_amdgcn_sched_barrier(0);
#pragma unroll
            for (int j = 0; j < 16; ++j) acc8(sm, lo0 + j < hi0 ? wi[j] : zz);
#pragma unroll
            for (int i = 0; i < 8; ++i) { const int r = r0 + i;
                if (i > 0) { acc8(sm, r + hw - 1 < 64 ? wa[i - 1] : zz); sub8(sm, r - hw - 1 >= 0 ? wb[i - 1] : zz); }
                const int lo = r - hw < 0 ? 0 : r - hw, hi = r + hw > 64 ? 64 : r + hw; const float inv = 1.0f / (float)(hi - lo);
                u32x4 o; o.x = pk2(sm[0] * inv, sm[1] * inv); o.y = pk2(sm[2] * inv, sm[3] * inv); o.z = pk2(sm[4] * inv, sm[5] * inv); o.w = pk2(sm[6] * inv, sm[7] * inv);
                *(LAS u32x4*)(V + i * PV_RSTR + cc * PV_CSTR + ck * 16) = o; }
        }
        __syncthreads();
        {
            const int cseg = (c.tid >> 3) & 7, i = c.tid >> 6, c0 = cseg * 8, r = r0 + i; const LAS unsigned char* vrow = V + i * PV_RSTR + ck * 16;
            float sm[8];
#pragma unroll
            for (int j = 0; j < 8; ++j) sm[j] = 0.f;
            const int lo0 = c0 - hw < 0 ? 0 : c0 - hw, hi0 = c0 + hw > 64 ? 64 : c0 + hw;
            for (int cc = lo0; cc < hi0; ++cc) acc8(sm, *(const LAS u32x4*)(vrow + cc * PV_CSTR));
            const size_t tok0 = (size_t)b * SEQ + r * 64 + c0;
            u32x4 vv[8];
#pragma unroll
            for (int st = 0; st < 8; ++st) vv[st] = *(const u32x4*)(Z + (tok0 + st) * NZ + chn);
#pragma unroll
            for (int st = 0; st < 8; ++st) { const int cc = c0 + st;
                if (st > 0) { if (cc + hw - 1 < 64) acc8(sm, *(const LAS u32x4*)(vrow + (cc + hw - 1) * PV_CSTR)); if (cc - hw - 1 >= 0) sub8(sm, *(const LAS u32x4*)(vrow + (cc - hw - 1) * PV_CSTR)); }
                const int lo = cc - hw < 0 ? 0 : cc - hw, hi = cc + hw > 64 ? 64 : cc + hw; const float inv = 1.0f / (float)(hi - lo); const u32x4 v0 = vv[st];
                u32x4 o; o.x = pk2(sm[0] * inv - bflo(v0.x), sm[1] * inv - bfhi(v0.x)); o.y = pk2(sm[2] * inv - bflo(v0.y), sm[3] * inv - bfhi(v0.y));
                o.z = pk2(sm[4] * inv - bflo(v0.z), sm[5] * inv - bfhi(v0.z)); o.w = pk2(sm[6] * inv - bflo(v0.w), sm[7] * inv - bfhi(v0.w));
                *(u32x4*)(PD + (tok0 + st) * 512 + chn) = o; }
        }
        __syncthreads();
    }
    if (!ctx) return;
    const int gw = wi * NWAVES + c.wave, NGW = nw * NWAVES;
    for (int it = gw; it < (TC / 4) * 4; it += NGW) {
        const int g = it & 3, row = TL + (it >> 2) * 4 + (c.lane >> 4), ck = c.lane & 15, w = 2 << g;
        const int pos = (row - TL) & 255, n = 256;
        const bf16_t* src = Z + (size_t)(row - pos) * NZ + 128 * g + 8 * ck;
        const int lo = pos - w / 2 < 0 ? 0 : pos - w / 2, hi = pos + w / 2 > n ? n : pos + w / 2;
        float sm[8];
#pragma unroll
        for (int j = 0; j < 8; ++j) sm[j] = 0.f;
        { const u32x4 zz = {0u, 0u, 0u, 0u}; u32x4 wv[16];
#pragma unroll
            for (int k = 0; k < 16; ++k) { const int p = pos - w / 2 + k; const int pc = p < 0 ? 0 : (p > n - 1 ? n - 1 : p); wv[k] = *(const u32x4*)(src + (size_t)pc * NZ); }
            __builtin_amdgcn_sched_barrier(0);
#pragma unroll
            for (int k = 0; k < 16; ++k) { const int p = pos - w / 2 + k; acc8(sm, (k < w && p >= 0 && p < n) ? wv[k] : zz); } }
        const float inv = 1.0f / (float)(hi - lo);
        const u32x4 vv = *(const u32x4*)(Z + (size_t)row * NZ + 128 * g + 8 * ck);
        u32x4 o; o.x = pk2(sm[0] * inv - bflo(vv.x), sm[1] * inv - bfhi(vv.x)); o.y = pk2(sm[2] * inv - bflo(vv.y), sm[3] * inv - bfhi(vv.y));
        o.z = pk2(sm[4] * inv - bflo(vv.z), sm[5] * inv - bfhi(vv.z)); o.w = pk2(sm[6] * inv - bflo(vv.w), sm[7] * inv - bfhi(vv.w));
        *(u32x4*)(PD + (size_t)row * 512 + 128 * g + 8 * ck) = o;
    }
}

__device__ __forceinline__ void phase_i(const Args& a, Ctx& c, int l, const bool dummy = false) {
    LAS u32x4* bh = (LAS u32x4*)c.lds; LAS u32x4* bl = bh + 2048;
    for (int i = c.tid; i < 2048; i += NTHREADS) { const int st = i >> 6, ln = i & 63, n = ln & 15, q = ln >> 4; const float* rp = a.in(24) + (size_t)(32 * st + 8 * q) * 16 + n;
        unsigned hi[4], lo[4];
#pragma unroll
        for (int e = 0; e < 4; ++e) { const float v0 = rp[(2 * e) * 16], v1 = rp[(2 * e + 1) * 16]; const unsigned h2 = pk2(v0, v1); hi[e] = h2; lo[e] = pk2(v0 - bflo(h2), v1 - bfhi(h2)); }
        bh[i] = (u32x4){hi[0], hi[1], hi[2], hi[3]}; bl[i] = (u32x4){lo[0], lo[1], lo[2], lo[3]}; }
    volatile LAS int* bcnt = c.misc + 64; volatile LAS int* bbase = c.misc + 80; LAS float* lgt = (LAS float*)(c.lds + 65536);
    if (c.tid < 16) bcnt[c.tid] = 0;
    const int Te = l == DEPTH - 1 ? TL : T;
    const int rpb = (Te + c.G - 1) / c.G, r0 = c.bid * rpb, nrows = (r0 + rpb <= Te) ? rpb : (Te - r0 > 0 ? Te - r0 : 0);
    LAS float* par = (LAS float*)(c.lds + 81920); const int b0 = brow_of(r0);
    for (int i = c.tid; i < 2 * D; i += NTHREADS) { const int bb = i >> 10, col = i & (D - 1), bt = b0 + bb < 8 ? b0 + bb : 8;
        const float* md = (const float*)(c.ws + WS_MODS) + ((size_t)l * 9 + bt) * NMOD + 3 * D;
        par[bb * 2 * D + col] = a.in(7)[(size_t)l * D + col] * (1.0f + md[D + col]); par[bb * 2 * D + D + col] = md[col]; }
    __syncthreads();
    bf16_t* H = (bf16_t*)(c.ws + WS_H); float* GW = (float*)(c.ws + WS_GW);
    const bf16_t* XB = (const bf16_t*)(c.ws + WS_XB);
    const int m = c.lane & 15, q = c.lane >> 4;
    for (int tile = c.wave; tile * 16 < nrows; tile += NWAVES) {
        const int rowl = tile * 16 + m; const bool valid = rowl < nrows; const int row = r0 + (valid ? rowl : nrows - 1);
        const bf16_t* xb = XB + (size_t)row * D + 8 * q;
        u32x4 w[32];
#pragma unroll
        for (int st = 0; st < 32; ++st) w[st] = *(const u32x4*)(xb + 32 * st);
        __builtin_amdgcn_sched_barrier(0);
        float ss = 0.f;
#pragma unroll
        for (int st = 0; st < 32; ++st) { const float x0 = bflo(w[st].x), x1 = bfhi(w[st].x), x2 = bflo(w[st].y), x3 = bfhi(w[st].y), x4 = bflo(w[st].z), x5 = bfhi(w[st].z), x6 = bflo(w[st].w), x7 = bfhi(w[st].w);
            ss += (x0 * x0 + x1 * x1) + (x2 * x2 + x3 * x3) + (x4 * x4 + x5 * x5) + (x6 * x6 + x7 * x7);
            if ((st & 3) == 3) __builtin_amdgcn_sched_barrier(0); }
        ss += shflx(ss, 16, c.lane); ss += shflx(ss, 32, c.lane);
#pragma unroll
        for (int st = 0; st < 32; ++st) asm volatile("" : "+v"(w[st].x), "+v"(w[st].y), "+v"(w[st].z), "+v"(w[st].w));
        const float rstd = 1.0f / sqrtf(ss * (1.0f / D) + RMS_EPS);
        const LAS float* pa = par + (brow_of(row) - b0) * 2 * D + 8 * q;
        bf16_t* hrow = H + (size_t)row * D + 8 * q;
        f32x4 acc = {0.f, 0.f, 0.f, 0.f};
#pragma unroll
        for (int st = 0; st < 32; ++st) {
            const int co = 32 * st;
            const f32x4 g0 = *(const LAS f32x4*)(pa + co), g1 = *(const LAS f32x4*)(pa + co + 4), s0 = *(const LAS f32x4*)(pa + D + co), s1 = *(const LAS f32x4*)(pa + D + co + 4);
            const f32x4 xa = {bflo(w[st].x), bfhi(w[st].x), bflo(w[st].y), bfhi(w[st].y)}, xc = {bflo(w[st].z), bfhi(w[st].z), bflo(w[st].w), bfhi(w[st].w)};
            const f32x4 ha = xa * rstd * g0 + s0, hc = xc * rstd * g1 + s1;
            u32x4 hi4; hi4.x = pk2(ha[0], ha[1]); hi4.y = pk2(ha[2], ha[3]); hi4.z = pk2(hc[0], hc[1]); hi4.w = pk2(hc[2], hc[3]);
            u32x4 lo4; lo4.x = pk2(ha[0] - bflo(hi4.x), ha[1] - bfhi(hi4.x)); lo4.y = pk2(ha[2] - bflo(hi4.y), ha[3] - bfhi(hi4.y));
            lo4.z = pk2(hc[0] - bflo(hi4.z), hc[1] - bfhi(hi4.z)); lo4.w = pk2(hc[2] - bflo(hi4.w), hc[3] - bfhi(hi4.w));
            if (valid) *(u32x4*)(hrow + co) = hi4;
            const bf16x8 ahi = __builtin_bit_cast(bf16x8, hi4), alo = __builtin_bit_cast(bf16x8, lo4);
            const bf16x8 bhi = __builtin_bit_cast(bf16x8, bh[st * 64 + c.lane]), blo = __builtin_bit_cast(bf16x8, bl[st * 64 + c.lane]);
            acc = __builtin_amdgcn_mfma_f32_16x16x32_bf16(ahi, bhi, acc, 0, 0, 0);
            acc = __builtin_amdgcn_mfma_f32_16x16x32_bf16(alo, bhi, acc, 0, 0, 0);
            acc = __builtin_amdgcn_mfma_f32_16x16x32_bf16(ahi, blo, acc, 0, 0, 0);
            __builtin_amdgcn_sched_barrier(0);
        }
#pragma unroll
        for (int j = 0; j < 4; ++j) lgt[(tile * 16 + 4 * q + j) * 16 + m] = acc[j];
    }
    __syncthreads();
    int e1 = 0, e2 = 0, p1 = 0, p2 = 0; const int myrow = c.tid;
    if (myrow < nrows) {
        float rb[16]; { const float* rbp = a.in(25);
#pragma unroll
            for (int q4 = 0; q4 < 4; ++q4) { const f32x4 r4 = *(const f32x4*)(rbp + 4 * q4); rb[4 * q4] = r4[0]; rb[4 * q4 + 1] = r4[1]; rb[4 * q4 + 2] = r4[2]; rb[4 * q4 + 3] = r4[3]; } }
        float sc[16], bi[16];
#pragma unroll
        for (int q4 = 0; q4 < 4; ++q4) { const f32x4 l4 = *(const LAS f32x4*)(lgt + myrow * 16 + q4 * 4);
#pragma unroll
            for (int k = 0; k < 4; ++k) { sc[q4 * 4 + k] = sigm(l4[k]); bi[q4 * 4 + k] = sc[q4 * 4 + k] + rb[q4 * 4 + k]; } }
        float gs[4];
#pragma unroll
        for (int gq = 0; gq < 4; ++gq) { const float x0 = bi[4 * gq], x1 = bi[4 * gq + 1], x2 = bi[4 * gq + 2], x3 = bi[4 * gq + 3];
            const float h1 = fmaxf(x0, x1), l1 = fminf(x0, x1), h2 = fmaxf(x2, x3), l2 = fminf(x2, x3);
            gs[gq] = fmaxf(h1, h2) + fmaxf(fminf(h1, h2), fmaxf(l1, l2)); }
        int bg = 0; float best = gs[0];
#pragma unroll
        for (int gq = 1; gq < 4; ++gq) if (gs[gq] > best) { best = gs[gq]; bg = gq; }
        float vb[4], vs[4];
#pragma unroll
        for (int i = 0; i < 4; ++i) { vb[i] = bg == 0 ? bi[i] : bg == 1 ? bi[4 + i] : bg == 2 ? bi[8 + i] : bi[12 + i]; vs[i] = bg == 0 ? sc[i] : bg == 1 ? sc[4 + i] : bg == 2 ? sc[8 + i] : sc[12 + i]; }
        int i1 = 0; float m1 = vb[0];
#pragma unroll
        for (int i = 1; i < 4; ++i) if (vb[i] > m1) { m1 = vb[i]; i1 = i; }
        int i2 = -1; float m2 = 0.f;
#pragma unroll
        for (int i = 0; i < 4; ++i) if (i != i1 && (i2 < 0 || vb[i] > m2)) { m2 = vb[i]; i2 = i; }
        const float s1 = i1 == 0 ? vs[0] : i1 == 1 ? vs[1] : i1 == 2 ? vs[2] : vs[3], s2 = i2 == 0 ? vs[0] : i2 == 1 ? vs[1] : i2 == 2 ? vs[2] : vs[3];
        const float inv = 1.0f / (s1 + s2);
        e1 = bg * 4 + i1; e2 = bg * 4 + i2;
        p1 = __hip_atomic_fetch_add((LAS int*)(bcnt + e1), 1, __ATOMIC_RELAXED, __HIP_MEMORY_SCOPE_WORKGROUP);
        p2 = __hip_atomic_fetch_add((LAS int*)(bcnt + e2), 1, __ATOMIC_RELAXED, __HIP_MEMORY_SCOPE_WORKGROUP);
        GW[(size_t)(r0 + myrow) * 2] = s1 * inv; GW[(size_t)(r0 + myrow) * 2 + 1] = s2 * inv;
    }
    __syncthreads();
    unsigned* cntw = (unsigned*)(c.ws + WS_CTL) + CW_CNT + (dummy ? l + 4 : l) * 1024;
    if (c.tid < 16) bbase[c.tid] = (int)__hip_atomic_fetch_add(cntw + c.tid * 64, (unsigned)bcnt[c.tid], __ATOMIC_RELAXED, __HIP_MEMORY_SCOPE_AGENT);
    __syncthreads();
    int* list = (int*)(c.ws + (dummy ? WS_HMID : WS_LIST));
    if (myrow < nrows) { const int row = r0 + myrow; list[(size_t)e1 * LCAP + bbase[e1] + p1] = row * 2; list[(size_t)e2 * LCAP + bbase[e2] + p2] = row * 2 + 1; }
}
__device__ __forceinline__ void moe_setup(Ctx& c, int l) {
    const unsigned* cntw = (const unsigned*)(c.ws + WS_CTL) + CW_CNT + l * 1024;
    if (c.tid < NE) c.misc[48 + c.tid] = (int)__hip_atomic_load(cntw + c.tid * 64, __ATOMIC_RELAXED, __HIP_MEMORY_SCOPE_AGENT);
    __syncthreads();
    if (c.tid == 0) { int cum = 0;
        for (int e = 0; e < NE; ++e) { c.misc[16 + e] = cum; cum += (c.misc[48 + e] + 255) >> 8; }
        c.misc[16 + NE] = cum; }
    __syncthreads();
}

struct FinRow { u32x2 x[4], s0[4], s1[4]; f32x4 g[4]; };
__device__ __forceinline__ void fin_load(FinRow& r, const bf16_t* XB, const bf16_t* SL, const float* G2, int row, int lane) {
#pragma unroll
    for (int j = 0; j < 4; ++j) { const int col = 4 * lane + 256 * j; r.x[j] = *(const u32x2*)(XB + (size_t)row * D + col); r.s0[j] = *(const u32x2*)(SL + (size_t)row * 2 * D + col); r.s1[j] = *(const u32x2*)(SL + (size_t)row * 2 * D + D + col);
        r.g[j] = *(const f32x4*)(G2 + (size_t)(row >> 12) * NMOD + col); }
}
__device__ __forceinline__ void fin_row(const FinRow& r, const f32x4 (&fg)[4], float* outp, int row, int lane) {
    f32x4 v[4]; float s = 0.f;
#pragma unroll
    for (int j = 0; j < 4; ++j) { const f32x4 xv = {bflo(r.x[j].x), bfhi(r.x[j].x), bflo(r.x[j].y), bfhi(r.x[j].y)};
        const f32x4 y = (f32x4){bflo(r.s0[j].x) + bflo(r.s1[j].x), bfhi(r.s0[j].x) + bfhi(r.s1[j].x), bflo(r.s0[j].y) + bflo(r.s1[j].y), bfhi(r.s0[j].y) + bfhi(r.s1[j].y)};
        v[j] = xv + r.g[j] * y; s += (v[j][0] * v[j][0] + v[j][1] * v[j][1]) + (v[j][2] * v[j][2] + v[j][3] * v[j][3]); }
    const float rstd = 1.0f / sqrtf(wave_sum(s, lane) * (1.0f / D) + RMS_EPS);
#pragma unroll
    for (int j = 0; j < 4; ++j) *(f32x4*)(outp + (size_t)row * D + 4 * lane + 256 * j) = v[j] * rstd * fg[j];
}
__device__ __forceinline__ void phase_fin(const Args& a, Ctx& c) {
    const int gw = c.bid * NWAVES + c.wave, NGW = c.G * NWAVES;
    const bf16_t* XB = (const bf16_t*)(c.ws + WS_XB); const bf16_t* SL = (const bf16_t*)(c.ws + WS_Z); const float* G2 = (const float*)(c.ws + WS_MODS) + (size_t)(DEPTH - 1) * 9 * NMOD + 5 * D;
    f32x4 fg[4];
#pragma unroll
    for (int j = 0; j < 4; ++j) fg[j] = *(const f32x4*)(a.in(29) + 4 * c.lane + 256 * j);
    float* outp = a.out();
    FinRow ra, rb;
    if (gw < TL) fin_load(ra, XB, SL, G2, gw, c.lane);
    for (int row = gw; row < TL; row += 2 * NGW) {
        const bool hb = row + NGW < TL;
        if (hb) fin_load(rb, XB, SL, G2, row + NGW, c.lane);
        fin_row(ra, fg, outp, row, c.lane);
        if (row + 2 * NGW < TL) fin_load(ra, XB, SL, G2, row + 2 * NGW, c.lane);
        if (hb) fin_row(rb, fg, outp, row + NGW, c.lane);
    }
}

constexpr int STEPS_PER_LAYER = 11, NSTEPS = 1 + DEPTH * STEPS_PER_LAYER + 1;
__device__ __forceinline__ Ctx mkctx(LAS unsigned char* lds, const Args& a, const int wv) {
    unsigned lb = (unsigned)(unsigned long long)lds; asm volatile("" : "+s"(lb));
    Ctx c; c.lds = (LAS unsigned char*)lb; c.misc = (volatile LAS int*)(c.lds + MISC_OFF);
    int g = gridDim.x, b = blockIdx.x; asm volatile("" : "+s"(g), "+s"(b));
    c.wave = wv; c.lane = lane_id_v(); c.tid = wv * 64 + c.lane; c.G = g; c.bid = b; c.ws = a.ws();
    return c;
}
__global__ void __launch_bounds__(NTHREADS, 2) mk_fwd(KArgs ka) {
    extern __shared__ __attribute__((aligned(16))) unsigned char lds_raw[];
    LAS unsigned char* lds = (LAS unsigned char*)lds_raw;
    volatile LAS int* misc = (volatile LAS int*)(lds + MISC_OFF);
#if (MK_DIAG_ZERO & 1)
    for (int i = MISC_OFF / 4 + threadIdx.x; i < LDS_BYTES / 4; i += NTHREADS) ((volatile LAS int*)lds)[i] = 0x7fc12345;
    __syncthreads();
#endif
    if (threadIdx.x < 16) misc[threadIdx.x] = 0;
    if ((threadIdx.x & 63) == 0) misc[WTAB + hw_key()] = (int)(threadIdx.x >> 6);
    if (threadIdx.x == 64) {
#pragma unroll
        for (int k = 0; k < 30; ++k) { const unsigned long long p = (unsigned long long)ka.in[k]; misc[PTAB + 2 * k] = (int)(unsigned)p; misc[PTAB + 2 * k + 1] = (int)(unsigned)(p >> 32); }
        { const unsigned long long p = (unsigned long long)ka.out; misc[PTAB + 60] = (int)(unsigned)p; misc[PTAB + 61] = (int)(unsigned)(p >> 32); }
        { const unsigned long long p = (unsigned long long)ka.ws; misc[PTAB + 62] = (int)(unsigned)p; misc[PTAB + 63] = (int)(unsigned)(p >> 32); }
        misc[PTAB + 64] = ka.lo; misc[PTAB + 65] = ka.hi;
    }
    __syncthreads();
    Args a; a.tab = misc + PTAB;
    int wv = __builtin_amdgcn_readfirstlane((int)(threadIdx.x >> 6)); asm volatile("" : "+s"(wv));
    const int lo = __builtin_amdgcn_readfirstlane(misc[PTAB + 64]), hi = __builtin_amdgcn_readfirstlane(misc[PTAB + 65]);
    XcdBarrier bar; bar.bar = (unsigned*)(a.ws() + WS_CTL) + CW_BAR; bar.x = 0; bar.st = (volatile LAS unsigned*)misc;
    if (hi - lo > 1) bar = xcd_barrier_post((unsigned*)(a.ws() + WS_CTL) + CW_BAR, (volatile LAS unsigned*)misc);
#define IN(s) (lo <= (s) && (s) < hi)
#define SEAM(s) do { if (IN(s) && IN((s) + 1)) { bar.bar = (unsigned*)(a.ws() + WS_CTL) + CW_BAR; xcd_barrier(bar, wv * 64 + lane_id_v()); } } while (0)
    if (IN(0)) { Ctx c = mkctx(lds, a, wv); phase_p0(a, c); __syncthreads(); tr_range(a, c, 0, 0, TR_NITEMS, c.bid * NWAVES + c.wave, c.G * NWAVES);
        if (MK_DBL & 1) { __syncthreads(); phase_p0(a, c); __syncthreads(); tr_range(a, c, 0, 0, TR_NITEMS, c.bid * NWAVES + c.wave, c.G * NWAVES); } } SEAM(0);
    for (int l = 0; l < DEPTH; ++l) {
        const int sb = 1 + l * STEPS_PER_LAYER;
        if (IN(sb + 0)) { Ctx c = mkctx(lds, a, wv); if (MK_DBL & (1 << 11)) { phase_a(a, c, l, true); __syncthreads(); } phase_a(a, c, l); } SEAM(sb + 0);
        if (IN(sb + 1)) {
            Ctx c = mkctx(lds, a, wv);
            pg8::StaticOrder S; S.init(T, NZ, c.G, c.bid); pg8::EpiIn E{(bf16_t*)(c.ws + WS_Z), (bf16_t*)(c.ws + WS_U)};
            pg8::gemm_phase<pg8::EpiIn, pg8::StaticOrder, false>(c.lds, c.tid, (const bf16_t*)(c.ws + WS_H), (const bf16_t*)(c.ws + wbuf_off(l) + WO_WIN), D, S, E);
            if (MK_DBL & (1 << 1)) { __syncthreads(); pg8::gemm_phase<pg8::EpiIn, pg8::StaticOrder, false>(c.lds, c.tid, (const bf16_t*)(c.ws + WS_H), (const bf16_t*)(c.ws + wbuf_off(l) + WO_WIN), D, S, E); }
            { const int tail0 = S.nwg % c.G; if (l + 1 < DEPTH && tail0 != 0 && c.bid >= tail0) tr_range(a, c, l + 1, 0, TR_SPLIT, (c.bid - tail0) * NWAVES + c.wave, (c.G - tail0) * NWAVES);
                if (l == 0) { Ctx c2 = mkctx(lds, a, wv); if (tail0 == 0) s3_tables(a, c2, c2.bid, c2.G); else if (c2.bid >= tail0) s3_tables(a, c2, c2.bid - tail0, c2.G - tail0); } }
        } SEAM(sb + 1);
        if (IN(sb + 2)) { Ctx c = mkctx(lds, a, wv); phase_s12(a, c, l);
            if (MK_DBL & (1 << 2)) { __syncthreads(); phase_s12(a, c, l); }
#if MK_SELFTEST
            if (l == 0) { asm volatile("" ::: "memory"); phase_s1(a, c, l, WS_HMID); bar.bar = (unsigned*)(a.ws() + WS_CTL) + CW_BAR; xcd_barrier(bar, c.tid);
                const u32x4* p = (const u32x4*)(c.ws + WS_CAR); const u32x4* q = (const u32x4*)(c.ws + WS_HMID); unsigned bad = 0;
                for (size_t i = (size_t)c.bid * NTHREADS + c.tid; i < (size_t)NB * 32 * 2 * NCH * 32; i += (size_t)c.G * NTHREADS) { const u32x4 x = p[i], y = q[i]; bad |= (x.x ^ y.x) | (x.y ^ y.y) | (x.z ^ y.z) | (x.w ^ y.w); }
                if (bad) __hip_atomic_fetch_or((unsigned*)(c.ws + WS_CTL) + 8, 1u, __ATOMIC_RELAXED, __HIP_MEMORY_SCOPE_AGENT); }
#endif
        } SEAM(sb + 2);
        if (IN(sb + 4)) { Ctx c = mkctx(lds, a, wv);
#pragma unroll 1
            for (int rep = 0; rep < ((MK_DBL & (1 << 4)) ? 2 : 1); ++rep) { phase_s3(a, c, l); __syncthreads(); }
            { const int nt3 = 32 * ((4 * (l == DEPTH - 1 ? NCH - 4 : NCH) + 7) >> 3), tail0 = nt3 % c.G;
                if (tail0 == 0) phase_pool(c, c.bid, c.G, 0, POOL_TASKS / 2, false); else if (c.bid >= tail0) phase_pool(c, c.bid - tail0, c.G - tail0, 0, POOL_TASKS / 2, false); }
        } SEAM(sb + 4);
        if (IN(sb + 5)) {
            Ctx c = mkctx(lds, a, wv);
            pg8::StaticOrder S; S.init(l == DEPTH - 1 ? TL : T, 512, c.G, c.bid); pg8::EpiGlu E{(const bf16_t*)(c.ws + WS_YG), (bf16_t*)(c.ws + WS_H) + (size_t)T * 512, a.in(20) + (size_t)l * 512};
            pg8::gemm_phase<pg8::EpiGlu, pg8::StaticOrder, false, true>(c.lds, c.tid, (const bf16_t*)(c.ws + WS_YG), (const bf16_t*)(c.ws + wbuf_off(l) + WO_GLU), 512, S, E);
            if (MK_DBL & (1 << 5)) { __syncthreads(); pg8::gemm_phase<pg8::EpiGlu, pg8::StaticOrder, false, true>(c.lds, c.tid, (const bf16_t*)(c.ws + WS_YG), (const bf16_t*)(c.ws + wbuf_off(l) + WO_GLU), 512, S, E); }
            { const int tail0 = S.nwg % c.G; Ctx c2 = mkctx(lds, a, wv);
                if (tail0 == 0) phase_pool(c2, c2.bid, c2.G, POOL_TASKS / 2, POOL_TASKS, l != DEPTH - 1); else if (c2.bid >= tail0) phase_pool(c2, c2.bid - tail0, c2.G - tail0, POOL_TASKS / 2, POOL_TASKS, l != DEPTH - 1); }
        } SEAM(sb + 5);
        if (IN(sb + 6)) {
            Ctx c = mkctx(lds, a, wv); pg8::PairOrder S; S.so.init(l == DEPTH - 1 ? TL : T, D, c.G, c.bid);
            pg8::EpiM12 E{(const bf16_t*)(c.ws + WS_Z), (bf16_t*)(c.ws + WS_HMID)};
            pg8::gemm_phase<pg8::EpiM12, pg8::PairOrder, false>(c.lds, c.tid, (const bf16_t*)(c.ws + WS_H), (const bf16_t*)(c.ws + wbuf_off(l) + WO_WC), 512, S, E);
            if (MK_DBL & (1 << 6)) { __syncthreads(); pg8::gemm_phase<pg8::EpiM12, pg8::PairOrder, false>(c.lds, c.tid, (const bf16_t*)(c.ws + WS_H), (const bf16_t*)(c.ws + wbuf_off(l) + WO_WC), 512, S, E); }
            { const int tail0 = S.so.nwg % c.G; if (l + 1 < DEPTH && tail0 != 0 && c.bid >= tail0) tr_range(a, c, l + 1, TR_SPLIT, TR_SPLIT2, (c.bid - tail0) * NWAVES + c.wave, (c.G - tail0) * NWAVES); }
        } SEAM(sb + 6);
        if (IN(sb + 7)) {
            Ctx c = mkctx(lds, a, wv);
            pg8::StaticOrder S; S.init(l == DEPTH - 1 ? TL : T, D, c.G, c.bid);
            pg8::EpiOut E{(bf16_t*)(c.ws + WS_XB), (const float*)(c.ws + WS_MODS) + (size_t)l * 9 * NMOD + 2 * D, (bf16_t*)(c.ws + WS_XB)};
            if (MK_DBL & (1 << 7)) { pg8::EpiOut E2{(bf16_t*)(c.ws + WS_XB), (const float*)(c.ws + WS_MODS) + (size_t)l * 9 * NMOD + 2 * D, (bf16_t*)(c.ws + WS_H)};
                pg8::gemm_phase<pg8::EpiOut, pg8::StaticOrder, false>(c.lds, c.tid, (const bf16_t*)(c.ws + WS_HMID), (const bf16_t*)(c.ws + wbuf_off(l) + WO_WOUT), D, S, E2); __syncthreads(); }
            pg8::gemm_phase<pg8::EpiOut, pg8::StaticOrder, false>(c.lds, c.tid, (const bf16_t*)(c.ws + WS_HMID), (const bf16_t*)(c.ws + wbuf_off(l) + WO_WOUT), D, S, E);
            { const int tail0 = S.nwg % c.G; if (l + 1 < DEPTH && tail0 != 0 && c.bid >= tail0) tr_range(a, c, l + 1, TR_SPLIT2, TR_NITEMS, (c.bid - tail0) * NWAVES + c.wave, (c.G - tail0) * NWAVES); }
        } SEAM(sb + 7);
        if (IN(sb + 8)) { Ctx c = mkctx(lds, a, wv); phase_i(a, c, l); if (MK_DBL & (1 << 8)) { __syncthreads(); phase_i(a, c, l, true); } } SEAM(sb + 8);
        if (IN(sb + 9)) {
            Ctx c = mkctx(lds, a, wv);
            moe_setup(c, l);
            pg8::MoeOrder S{(const LAS int*)(c.misc + 16), (const LAS int*)(c.misc + 48), (const int*)(c.ws + WS_LIST), c.G, c.bid}; pg8::EpiUp E{(bf16_t*)(c.ws + WS_HMID)};
            pg8::gemm_phase<pg8::EpiUp, pg8::MoeOrder, true>(c.lds, c.tid, (const bf16_t*)(c.ws + WS_H), (const bf16_t*)(c.ws + wbuf_off(l) + WO_W13), D, S, E);
            if (MK_DBL & (1 << 9)) { __syncthreads(); pg8::gemm_phase<pg8::EpiUp, pg8::MoeOrder, true>(c.lds, c.tid, (const bf16_t*)(c.ws + WS_H), (const bf16_t*)(c.ws + wbuf_off(l) + WO_W13), D, S, E); }
        } SEAM(sb + 9);
        if (IN(sb + 10)) {
            Ctx c = mkctx(lds, a, wv);
            moe_setup(c, l);
            pg8::MoeOrder S{(const LAS int*)(c.misc + 16), (const LAS int*)(c.misc + 48), (const int*)(c.ws + WS_LIST), c.G, c.bid};
            pg8::EpiDown E{(bf16_t*)(c.ws + WS_Z), (const int*)(c.ws + WS_LIST), (const float*)(c.ws + WS_GW), (const LAS int*)(c.misc + 16), (const LAS int*)(c.misc + 48)};
            pg8::gemm_phase<pg8::EpiDown, pg8::MoeOrder, false>(c.lds, c.tid, (const bf16_t*)(c.ws + WS_HMID), (const bf16_t*)(c.ws + wbuf_off(l) + WO_W2), DE, S, E);
            if (MK_DBL & (1 << 10)) { __syncthreads(); pg8::gemm_phase<pg8::EpiDown, pg8::MoeOrder, false>(c.lds, c.tid, (const bf16_t*)(c.ws + WS_HMID), (const bf16_t*)(c.ws + wbuf_off(l) + WO_W2), DE, S, E); }
        } SEAM(sb + 10);
    }
    if (IN(NSTEPS - 1)) { Ctx c = mkctx(lds, a, wv); phase_fin(a, c); }
#undef IN
#undef SEAM
}

extern "C" void kernel_launch(void* const* d_in, const int* in_sizes, int n_in, void* d_out, int out_size, void* d_ws, size_t ws_size, hipStream_t stream) {
    static int grid = 0;
    if (grid == 0) {
        if (n_in != 30 || out_size != TL * D || ws_size < WS_END) { fprintf(stderr, "kernel_launch: unexpected shapes (n_in %d out %d ws %zu)\n", n_in, out_size, ws_size); grid = -1; return; }
        int dev = 0, cus = 0, per_cu = 0;
        if (hipGetDevice(&dev) != hipSuccess || hipDeviceGetAttribute(&cus, hipDeviceAttributeMultiprocessorCount, dev) != hipSuccess) { grid = -1; return; }
        if (hipFuncSetAttribute((const void*)mk_fwd, hipFuncAttributeMaxDynamicSharedMemorySize, LDS_BYTES) != hipSuccess) { fprintf(stderr, "kernel_launch: hipFuncSetAttribute failed\n"); grid = -1; return; }
        if (hipOccupancyMaxActiveBlocksPerMultiprocessor(&per_cu, (const void*)mk_fwd, NTHREADS, LDS_BYTES) != hipSuccess || per_cu < 1) { fprintf(stderr, "kernel_launch: occupancy query says %d\n", per_cu); per_cu = 1; }
        (void)hipGetLastError();
        grid = cus;
    }
    if (grid < 0) return;
    (void)hipMemsetAsync((char*)d_ws + WS_CTL, 0, CTL_ZERO_BYTES, stream);
#if (MK_DIAG_ZERO & 2)
    (void)hipMemsetAsync((char*)d_ws, 0, WS_END, stream);
#endif
#if (MK_DIAG_ZERO & 4)
    (void)hipMemsetAsync((char*)d_out, 0, (size_t)TL * D * 4, stream);
#endif
    KArgs a{};
    for (int i = 0; i < 30; ++i) a.in[i] = (const float*)d_in[i];
    a.out = (float*)d_out; a.ws = (unsigned char*)d_ws;
#if MK_MULTI
    for (int s = 0; s < NSTEPS; ++s) { a.lo = s; a.hi = s + 1; hipLaunchKernelGGL(mk_fwd, dim3(grid), dim3(NTHREADS), LDS_BYTES, stream, a); }
#else
    a.lo = 0; a.hi = NSTEPS; hipLaunchKernelGGL(mk_fwd, dim3(grid), dim3(NTHREADS), LDS_BYTES, stream, a);
#endif
}
```

```cpp
#include <hip/hip_runtime.h>
#include <cstdio>

#ifndef MK_MULTI
#define MK_MULTI 0
#endif
#ifndef MK_SELFTEST
#ifndef MK_DBL
#define MK_DBL 0
#endif
#define MK_SELFTEST 0
#endif
#define MK_DIAG_ZERO 0

#define LAS __attribute__((address_space(3)))
#define GAS __attribute__((address_space(1)))
typedef unsigned short bf16_t;
typedef short bf16x8 __attribute__((ext_vector_type(8)));
typedef float f32x2 __attribute__((ext_vector_type(2)));
typedef float f32x4 __attribute__((ext_vector_type(4)));
typedef float f32x16 __attribute__((ext_vector_type(16)));
typedef unsigned u32x2 __attribute__((ext_vector_type(2)));
typedef unsigned u32x4 __attribute__((ext_vector_type(4)));

constexpr int D = 1024, NB = 8, SEQ = 4096, CTXL = 256, DEPTH = 4;
constexpr int TL = NB * SEQ, TC = NB * CTXL, T = TL + TC;
constexpr int NZ = 3072, NMOD = 6 * D;
constexpr int NE = 16, DE = 512;
constexpr int LCAP = 2 * T;
constexpr int HM_ROWS = 2 * T + NE * 256;
constexpr float RMS_EPS = 1e-6f;
constexpr int NCH = 68;
constexpr int IMG_STRIDE = 336;

constexpr size_t MiB = 1u << 20;
constexpr size_t WS_CTL = 0, CTL_ZERO_BYTES = 2 * MiB;
constexpr size_t WS_MODS = 2 * MiB;
constexpr size_t WS_AB = 3 * MiB;
constexpr size_t WS_BF = 4 * MiB;
constexpr size_t WS_CF = 5 * MiB;
constexpr size_t WS_LIST = 7 * MiB;
constexpr size_t WS_GW = 12 * MiB;
constexpr size_t WS_XCTX = 13 * MiB;
constexpr size_t WS_CAR = 21 * MiB;
constexpr size_t WS_W = 39 * MiB;
constexpr size_t WO_WIN = 0, WO_WC = 6 * MiB, WO_WBS = 7 * MiB, WO_WOUT = 8 * MiB, WO_GLU = 10 * MiB, WO_W13 = 11 * MiB, WO_W2 = 43 * MiB;
constexpr size_t WS_H = 98 * MiB;
constexpr size_t WS_YG = 166 * MiB;
constexpr size_t WS_HMID = 200 * MiB;
constexpr size_t WS_Z = 272 * MiB;
constexpr size_t WS_XB = 476 * MiB;
constexpr size_t WS_W2ND = 544 * MiB;
constexpr size_t WS_CAR2 = 604 * MiB;
constexpr size_t WS_S3T = 621 * MiB;
constexpr size_t WS_U = 631 * MiB;
constexpr size_t WS_END = 665 * MiB;
static_assert((size_t)HM_ROWS * 512 * 2 <= 72 * MiB && (size_t)T * NZ * 2 <= 204 * MiB && (size_t)T * D * 2 == 68 * MiB, "ws map");
constexpr int CW_TMO = 0, CW_BAR = 4096, CW_CNT = 16384;

__device__ __forceinline__ unsigned f2bf(float f) { unsigned u = __builtin_bit_cast(unsigned, f); return (u + 0x7fffu + ((u >> 16) & 1u)) >> 16; }
typedef __bf16 bf16v2 __attribute__((ext_vector_type(2)));
__device__ __forceinline__ unsigned pk2(float lo, float hi) { const f32x2 v = {lo, hi}; const bf16v2 b = __builtin_convertvector(v, bf16v2); return __builtin_bit_cast(unsigned, b); }
__device__ __forceinline__ float bflo(unsigned w) { return __builtin_bit_cast(float, w << 16); }
__device__ __forceinline__ float bfhi(unsigned w) { return __builtin_bit_cast(float, w & 0xffff0000u); }
__device__ __forceinline__ float sigm(float x) { return __builtin_amdgcn_rcpf(1.0f + __builtin_amdgcn_exp2f(-1.44269504f * x)); }
__device__ __forceinline__ float gelu_t(float x) { const float u = 1.5957691216f * (x + 0.044715f * x * x * x); return x * sigm(u); }
__device__ __forceinline__ int lane_id_v() { int l; asm volatile("v_mbcnt_lo_u32_b32 %0, -1, 0\n\tv_mbcnt_hi_u32_b32 %0, -1, %0" : "=v"(l)); return l; }
__device__ __forceinline__ int hw_key() { return (int)(__builtin_amdgcn_s_getreg((5 << 11) | 4) & 0x3fu); }
__device__ __forceinline__ float shflx(float v, int o, int lane) { return __builtin_bit_cast(float, __builtin_amdgcn_ds_bpermute((lane ^ o) << 2, __builtin_bit_cast(int, v))); }
__device__ __forceinline__ float wave_sum(float v, int lane) {
#pragma unroll
    for (int o = 1; o < 64; o <<= 1) v += shflx(v, o, lane);
    return v;
}
__device__ __forceinline__ f32x4 ld_bf4(const bf16_t* p) { const u32x2 w = *(const u32x2*)p; return (f32x4){bflo(w.x), bfhi(w.x), bflo(w.y), bfhi(w.y)}; }
__device__ __forceinline__ void st_bf4(bf16_t* p, f32x4 v) { u32x2 w; w.x = pk2(v[0], v[1]); w.y = pk2(v[2], v[3]); *(u32x2*)p = w; }
#define LDS_WAIT() asm volatile("s_waitcnt lgkmcnt(0)" ::: "memory")
#define VM_WAIT() asm volatile("s_waitcnt vmcnt(0)" ::: "memory")

namespace pg8 {
constexpr int BM = 256, BK = 64, HALF = 128, HTB = HALF * BK * 2, STAGE_BYTES = 8 * HTB, NXCD = 8, WGM = 8;
__host__ __device__ __forceinline__ int lds_byte(int r, int c) { const int st = (r >> 4) * 2 + (c >> 5), rr = r & 15, cc = c & 31, ob = rr * 64 + cc * 2; return st * 1024 + (ob ^ (((ob >> 9) & 1) << 5)); }
__host__ __device__ __forceinline__ void stage_rc(int b, int& R, int& C) { const int st = b / 1024, sb = b % 1024, swz = sb ^ (((sb >> 9) & 1) << 5); R = (st >> 1) * 16 + swz / 64; C = (st & 1) * 32 + (swz % 64) / 2; }
__host__ __device__ __forceinline__ int perm32(int rho) { const int n = rho >> 4, i = rho & 15; return 8 * (i >> 2) + 4 * n + (i & 3); }

struct Unit { int pm, pn, e, pnl; };

struct StaticOrder {
    int nM, nN, nwg, G, c;
    __device__ void init(int M, int N, int G_, int c_) { nM = M / BM; nN = N / BM; nwg = nM * nN; G = G_; c = c_; }
    __device__ bool next(int i, Unit& u) const {
        const long L = (long)i * G + c; if (L >= nwg) return false;
        int wgid = (int)L; { const int q = nwg / NXCD, r = nwg % NXCD, xcd = wgid % NXCD, off = wgid / NXCD; wgid = (xcd < r ? xcd * (q + 1) : r * (q + 1) + (xcd - r) * q) + off; }
        const int nig = WGM * nN, gid = wgid / nig, fm = gid * WGM, gsz = (nM - fm) < WGM ? (nM - fm) : WGM;
        u.pm = fm + ((wgid % nig) % gsz); u.pn = (wgid % nig) / gsz; u.pnl = u.pn; u.e = 0; return true;
    }
    __device__ __forceinline__ int arow(const Unit&, int) const { return 0; }
};
struct ComboOrder {
    int G, c;
    __device__ bool next(int i, Unit& u) const {
        const int L = i * G + c; constexpr int NM = (T / BM) * 4, NG = (T / BM) * 2;
        if (L >= NM + NG) return false;
        if (L < NM) { u.pm = L >> 2; u.pn = L & 3; u.pnl = L & 3; u.e = 0; }
        else { const int q = L - NM; u.pm = (q >> 1) + (int)((WS_YG - WS_H) / ((size_t)BM * 1024)); u.pn = (q & 1) + (int)((WO_GLU - WO_WC) / ((size_t)BM * 1024)); u.pnl = q & 1; u.e = 1; }
        return true;
    }
    __device__ __forceinline__ int arow(const Unit&, int) const { return 0; }
};
struct PairOrder {
    StaticOrder so;
    __device__ bool next(int i, Unit& u) const {
        if (!so.next(i >> 1, u)) return false;
        u.e = i & 1; u.pnl = u.pn;
        if (u.e == 0) { u.pm += T / BM; u.pn += 4; }
        return true;
    }
    __device__ __forceinline__ int arow(const Unit&, int) const { return 0; }
};
struct MoeOrder {
    const LAS int* cum; const LAS int* cnt; const int* list; int G, c;
    __device__ bool next(int i, Unit& u) const {
        const int ntot = cum[NE]; int L;
        if ((G & 7) == 0) { const int x = c & 7, k = i * (G >> 3) + (c >> 3); const int rt = x + 8 * (k >> 2); if (rt >= ntot) return false; L = rt * 4 + (k & 3); }
        else { L = i * G + c; if (L >= ntot * 4) return false; }
        const int rtg = L >> 2; int e = 0;
#pragma unroll
        for (int k = 1; k < NE; ++k) e += (rtg >= cum[k]) ? 1 : 0;
        u.pm = rtg; u.e = e; u.pnl = L & 3; u.pn = e * 4 + (L & 3); return true;
    }
    __device__ __forceinline__ int arow(const Unit& u, int rl) const {
        const int pos = (u.pm - cum[u.e]) * BM + rl;
        int tok = 0; if (pos < cnt[u.e]) tok = list[u.e * LCAP + pos] >> 1;
        return tok;
    }
};

template <class Epi, class Sched, bool GATHER, bool AGRP = false>
__device__ __forceinline__ void gemm_phase(LAS unsigned char* lds, const int tid_in, const bf16_t* A, const bf16_t* Bt, const int K, const Sched& S, const Epi& E) {
    const int tid = tid_in, wid = __builtin_amdgcn_readfirstlane(tid >> 6), lane = tid & 63, wr = wid >> 2, wc = wid & 3, fr = lane & 15, fq = lane >> 4;
    const int nt = K / BK;
    unsigned voffB[2];
#pragma unroll
    for (int i = 0; i < 2; ++i) { int R, C; stage_rc(tid * 16 + i * 8192, R, C); const int Rb = Epi::PERM ? ((R & ~31) + perm32(R & 31)) : R; voffB[i] = (unsigned)(Rb * K + C) * 2u; }
    const size_t kstep = (size_t)(BK * 2);
    const size_t kstepA = AGRP ? (size_t)(BK / 16) * T * 32 : kstep;
    const size_t hstep = (size_t)HALF * K * 2;
    const size_t tstep = 2 * hstep;
    const unsigned ldsw = (unsigned)wid * 1024u;
    const int aoff = lds_byte(wr * 64 + fr, fq * 8), boff = lds_byte(wc * 32 + fr, fq * 8);
#define PG8_SA(b, h) (((b) * 2 + (h)) * HTB)
#define PG8_SB(b, h) ((4 + (b) * 2 + (h)) * HTB)
#define PG8_STAGE(bufoff, gbase, voff) do { _Pragma("unroll") for (int _i = 0; _i < 2; ++_i) \
        __builtin_amdgcn_global_load_lds((const unsigned*)((const char*)(gbase) + (voff)[_i]), (LAS unsigned*)(lds + (bufoff) + ldsw + _i * 8192), 16, 0, 0); } while (0)
#define PG8_STAGEA(bufoff, kt, o0, o1) do { const char* _g = (const char*)A + (size_t)(kt) * kstepA; \
        __builtin_amdgcn_global_load_lds((const unsigned*)(_g + (o0)), (LAS unsigned*)(lds + (bufoff) + ldsw), 16, 0, 0); \
        __builtin_amdgcn_global_load_lds((const unsigned*)(_g + (o1)), (LAS unsigned*)(lds + (bufoff) + ldsw + 8192), 16, 0, 0); } while (0)
#define PG8_LDA(dst, b, h) do { _Pragma("unroll") for (int m = 0; m < 4; ++m) _Pragma("unroll") for (int k = 0; k < 2; ++k) dst[m][k] = *(const LAS bf16x8*)(lds + PG8_SA(b, h) + aoff + m * 2048 + k * 1024); } while (0)
#define PG8_LDB(dst, b, h) do { _Pragma("unroll") for (int n = 0; n < 2; ++n) _Pragma("unroll") for (int k = 0; k < 2; ++k) dst[n][k] = *(const LAS bf16x8*)(lds + PG8_SB(b, h) + boff + n * 2048 + k * 1024); } while (0)
#define PG8_MMA(ai, bj, At, Bt_) do { __builtin_amdgcn_s_setprio(1); _Pragma("unroll") for (int m = 0; m < 4; ++m) _Pragma("unroll") for (int n = 0; n < 2; ++n) _Pragma("unroll") for (int k = 0; k < 2; ++k) \
        acc[ai][bj][m][n] = __builtin_amdgcn_mfma_f32_16x16x32_bf16(Bt_[n][k], At[m][k], acc[ai][bj][m][n], 0, 0, 0); __builtin_amdgcn_s_setprio(0); } while (0)
#define PG8_WAIT_V(n) asm volatile("s_waitcnt vmcnt(" #n ")" ::: "memory")
#define PG8_WAIT_L(n) asm volatile("s_waitcnt lgkmcnt(" #n ")" ::: "memory")
#define PG8_BAR __builtin_amdgcn_s_barrier()
#define PG8_SCHED __builtin_amdgcn_sched_barrier(0)
#define PG8_CALC_OFF(dst, U) do { _Pragma("unroll") for (int _h = 0; _h < 2; ++_h) _Pragma("unroll") for (int _i = 0; _i < 2; ++_i) { int _R, _C; stage_rc(tid * 16 + _i * 8192, _R, _C); const int _rl = _h * HALF + _R; \
        const unsigned _row = GATHER ? (unsigned)S.arow((U), _rl) : (unsigned)((U).pm * BM + _rl); dst[_h * 2 + _i] = AGRP ? (((unsigned)(_C >> 4) * (unsigned)T + _row) * 32u + (unsigned)((_C & 15) * 2)) : _row * (unsigned)(K * 2) + (unsigned)(_C * 2); } } while (0)
    Unit cur, nxt; int ui = 0;
    if (!S.next(0, cur)) return;
    f32x4 acc[2][2][4][2];
#pragma unroll
    for (int a = 0; a < 2; ++a)
#pragma unroll
        for (int b = 0; b < 2; ++b)
#pragma unroll
            for (int m = 0; m < 4; ++m)
#pragma unroll
                for (int n = 0; n < 2; ++n) acc[a][b][m][n] = (f32x4){0.f, 0.f, 0.f, 0.f};
    bf16x8 At[4][2], B0[2][2], B1[2][2];
    unsigned oc[4], on[4];
    PG8_CALC_OFF(oc, cur);
    const char* cB = (const char*)Bt + (size_t)cur.pn * tstep;
    PG8_STAGE(PG8_SB(0, 0), cB, voffB); PG8_STAGE(PG8_SB(0, 1), cB + hstep, voffB); PG8_STAGEA(PG8_SA(0, 0), 0, oc[0], oc[1]); PG8_STAGEA(PG8_SA(0, 1), 0, oc[2], oc[3]);
    if (wr == 1) PG8_BAR;
    PG8_WAIT_V(2); PG8_BAR;
    PG8_STAGE(PG8_SB(1, 0), cB + kstep, voffB); PG8_STAGEA(PG8_SA(1, 0), 1, oc[0], oc[1]); PG8_STAGE(PG8_SB(1, 1), cB + hstep + kstep, voffB);
    PG8_WAIT_V(6); PG8_BAR;
    for (;;) {
        const bool has_next = S.next(ui + 1, nxt);
        if (has_next) { PG8_CALC_OFF(on, nxt); } else {
#pragma unroll
            for (int q = 0; q < 4; ++q) on[q] = oc[q]; }
        const char* nB = has_next ? (const char*)Bt + (size_t)nxt.pn * tstep : cB;
        for (int t = 0; t < nt; t += 2) {
            const bool last = (t == nt - 2);
            const int k2 = last ? 0 : t + 2, k3 = k2 + 1;
            const unsigned s0 = last ? on[0] : oc[0], s1 = last ? on[1] : oc[1], s2 = last ? on[2] : oc[2], s3 = last ? on[3] : oc[3];
            const char* b2 = last ? nB : cB + (size_t)(t + 2) * kstep; const char* b3 = b2 + kstep;
            PG8_LDB(B0, 0, 0); PG8_LDB(B1, 0, 1); PG8_SCHED; PG8_LDA(At, 0, 0); PG8_STAGEA(PG8_SA(1, 1), t + 1, oc[2], oc[3]);
            PG8_WAIT_V(8); PG8_WAIT_L(0); PG8_BAR; PG8_MMA(0, 0, At, B0); PG8_MMA(0, 1, At, B1); PG8_BAR; PG8_SCHED;
            PG8_LDA(At, 0, 1); PG8_STAGE(PG8_SB(0, 0), b2, voffB); PG8_STAGE(PG8_SB(0, 1), b2 + hstep, voffB); PG8_STAGEA(PG8_SA(0, 0), k2, s0, s1);
            PG8_WAIT_V(8); PG8_WAIT_L(0); PG8_BAR; PG8_MMA(1, 0, At, B0); PG8_MMA(1, 1, At, B1); PG8_BAR; PG8_SCHED;
            PG8_LDB(B0, 1, 0); PG8_LDB(B1, 1, 1); PG8_SCHED; PG8_LDA(At, 1, 0); PG8_STAGEA(PG8_SA(0, 1), k2, s2, s3);
            PG8_WAIT_V(8); PG8_WAIT_L(0); PG8_BAR; PG8_MMA(0, 0, At, B0); PG8_MMA(0, 1, At, B1); PG8_BAR; PG8_SCHED;
            PG8_LDA(At, 1, 1); PG8_STAGE(PG8_SB(1, 0), b3, voffB); PG8_STAGE(PG8_SB(1, 1), b3 + hstep, voffB); PG8_STAGEA(PG8_SA(1, 0), k3, s0, s1);
            PG8_WAIT_V(8); PG8_WAIT_L(0); PG8_BAR; PG8_MMA(1, 0, At, B0); PG8_MMA(1, 1, At, B1); PG8_BAR; PG8_SCHED;
        }
        if (wr == 0) PG8_BAR;
        bool keep = false;
        if constexpr (Epi::KEEPS) keep = E.apply(acc, cur, wr, wc, fr, fq); else E(acc, cur, wr, wc, fr, fq);
        if (!has_next) break;
        if (!keep) {
#pragma unroll
        for (int a = 0; a < 2; ++a)
#pragma unroll
            for (int b = 0; b < 2; ++b)
#pragma unroll
                for (int m = 0; m < 4; ++m)
#pragma unroll
                    for (int n = 0; n < 2; ++n) acc[a][b][m][n] = (f32x4){0.f, 0.f, 0.f, 0.f};
        }
        cur = nxt; cB = nB; ++ui;
#pragma unroll
        for (int q = 0; q < 4; ++q) oc[q] = on[q];
        if (wr == 1) PG8_BAR;
    }
    PG8_WAIT_V(0);
    PG8_BAR;
#undef PG8_SA
#undef PG8_SB
#undef PG8_STAGE
#undef PG8_STAGEA
#undef PG8_LDA
#undef PG8_LDB
#undef PG8_MMA
#undef PG8_WAIT_V
#undef PG8_WAIT_L
#undef PG8_BAR
#undef PG8_SCHED
#undef PG8_CALC_OFF
}

typedef const f32x4 (&AccRef)[2][2][4][2];
__device__ __forceinline__ u32x4 pack8(f32x4 v0, f32x4 v1) { u32x4 w; w.x = pk2(v0[0], v0[1]); w.y = pk2(v0[2], v0[3]); w.z = pk2(v1[0], v1[1]); w.w = pk2(v1[2], v1[3]); return w; }
__device__ __forceinline__ void unpack8(u32x4 w, f32x4& v0, f32x4& v1) { v0 = (f32x4){bflo(w.x), bfhi(w.x), bflo(w.y), bfhi(w.y)}; v1 = (f32x4){bflo(w.z), bfhi(w.z), bflo(w.w), bfhi(w.w)}; }
__device__ __forceinline__ f32x4 sigm4(f32x4 v) { return (f32x4){sigm(v[0]), sigm(v[1]), sigm(v[2]), sigm(v[3])}; }

struct EpiIn {
    static constexpr bool PERM = true, KEEPS = false; bf16_t* Z; bf16_t* U;
    __device__ __forceinline__ void operator()(AccRef acc, const Unit& u, int wr, int wc, int fr, int fq) const {
        const int row0 = u.pm * BM + wr * 64 + fr; const bool gate = u.pnl >= 4;
        const int col0 = gate ? 1024 + (u.pnl - 4) * HALF + wc * 32 + 8 * fq : u.pnl * BM + wc * 32 + 8 * fq, cstep = gate ? 1024 : HALF;
#pragma unroll
        for (int ai = 0; ai < 2; ++ai)
#pragma unroll
            for (int m = 0; m < 4; ++m) { bf16_t* rowp = Z + (size_t)(row0 + ai * HALF + m * 16) * NZ + col0;
                f32x4 v0 = acc[ai][0][m][0], v1 = acc[ai][0][m][1], w0 = acc[ai][1][m][0], w1 = acc[ai][1][m][1];
                u32x4 pa = pack8(v0, v1);
                if (gate) { pa = pack8(sigm4(v0), sigm4(v1)); f32x4 p0, p1; unpack8(pa, p0, p1); w0 = sigm4(w0); w1 = sigm4(w1);
#pragma unroll
                    for (int k = 0; k < 4; ++k) { w0[k] *= __builtin_amdgcn_rcpf(fmaxf(p0[k], 1e-30f)); w1[k] *= __builtin_amdgcn_rcpf(fmaxf(p1[k], 1e-30f)); } }
                if (u.pnl == 2 || u.pnl == 3) {
                    const int uc = (u.pnl - 2) * BM + wc * 32 + 8 * fq; const size_t tok = (size_t)(row0 + ai * HALF + m * 16);
                    *(u32x4*)(U + ((size_t)(uc >> 4) * T + tok) * 16 + (uc & 8)) = pa; *(u32x4*)(U + ((size_t)((uc + HALF) >> 4) * T + tok) * 16 + (uc & 8)) = pack8(w0, w1);
                } else { *(u32x4*)rowp = pa; *(u32x4*)(rowp + cstep) = pack8(w0, w1); } }
    }
};
struct EpiGlu {
    static constexpr bool PERM = true, KEEPS = false; const bf16_t* YG; bf16_t* S; const float* gb;
    __device__ __forceinline__ void operator()(AccRef acc, const Unit& u, int wr, int wc, int fr, int fq) const {
        const int row0 = u.pm * BM + wr * 64 + fr, col0 = u.pnl * BM + wc * 32 + 8 * fq;
        f32x4 bv[2][2];
#pragma unroll
        for (int bj = 0; bj < 2; ++bj)
#pragma unroll
            for (int n = 0; n < 2; ++n) bv[bj][n] = *(const f32x4*)(gb + col0 + bj * HALF + 4 * n);
        u32x4 yv[2][4][2];
#pragma unroll
        for (int ai = 0; ai < 2; ++ai)
#pragma unroll
            for (int m = 0; m < 4; ++m)
#pragma unroll
                for (int bj = 0; bj < 2; ++bj) yv[ai][m][bj] = *(const u32x4*)(YG + ((size_t)((col0 + bj * HALF) >> 4) * T + (row0 + ai * HALF + m * 16)) * 16 + ((col0 + bj * HALF) & 8));
        __builtin_amdgcn_sched_barrier(0);
#pragma unroll
        for (int ai = 0; ai < 2; ++ai)
#pragma unroll
            for (int m = 0; m < 4; ++m) { const size_t off = (size_t)(row0 + ai * HALF + m * 16) * 512 + col0;
#pragma unroll
                for (int bj = 0; bj < 2; ++bj) { f32x4 y0, y1; unpack8(yv[ai][m][bj], y0, y1);
                    const f32x4 v0 = y0 * sigm4(acc[ai][bj][m][0] + bv[bj][0]), v1 = y1 * sigm4(acc[ai][bj][m][1] + bv[bj][1]);
                    *(u32x4*)(S + off + bj * HALF) = pack8(v0, v1); } }
    }
};
template <int MODE> struct EpiMerge {
    static constexpr bool PERM = true, KEEPS = false; bf16_t* Z; bf16_t* M;
    __device__ __forceinline__ void operator()(AccRef acc, const Unit& u, int wr, int wc, int fr, int fq) const {
        const int row0 = u.pm * BM + wr * 64 + fr, col0 = u.pnl * BM + wc * 32 + 8 * fq;
#pragma unroll
        for (int ai = 0; ai < 2; ++ai)
#pragma unroll
            for (int m = 0; m < 4; ++m) { bf16_t* rowp = Z + (size_t)(row0 + ai * HALF + m * 16) * NZ + col0;
#pragma unroll
                for (int bj = 0; bj < 2; ++bj) {
                    if (MODE == 0) { f32x4 g0, g1; unpack8(*(const u32x4*)(rowp + 1024 + bj * HALF), g0, g1);
                        *(u32x4*)(rowp + 1024 + bj * HALF) = pack8(g0 * acc[ai][bj][m][0], g1 * acc[ai][bj][m][1]); }
                    else { f32x4 g0, g1, t0, t1; unpack8(*(const u32x4*)(rowp + 2048 + bj * HALF), g0, g1); unpack8(*(const u32x4*)(rowp + 1024 + bj * HALF), t0, t1);
                        *(u32x4*)(M + (size_t)(row0 + ai * HALF + m * 16) * D + col0 + bj * HALF) = pack8(t0 + g0 * acc[ai][bj][m][0], t1 + g1 * acc[ai][bj][m][1]); } } }
    }
};
struct EpiM12 {
    static constexpr bool PERM = true, KEEPS = true; const bf16_t* Z; bf16_t* M;
    __device__ __forceinline__ bool apply(f32x4 (&acc)[2][2][4][2], const Unit& u, int wr, int wc, int fr, int fq) const {
        const int pmr = u.e == 0 ? u.pm - T / BM : u.pm; const int row0_ = pmr * BM + wr * 64 + fr, col0 = u.pnl * BM + wc * 32 + 8 * fq;
        if (u.e == 0) {
            const int row0 = row0_;
            u32x4 qv[2][4][2];
#pragma unroll
            for (int ai = 0; ai < 2; ++ai)
#pragma unroll
                for (int m = 0; m < 4; ++m)
#pragma unroll
                    for (int bj = 0; bj < 2; ++bj) qv[ai][m][bj] = *(const u32x4*)(Z + (size_t)(row0 + ai * HALF + m * 16) * NZ + col0 + bj * HALF + 2048);
            __builtin_amdgcn_sched_barrier(0);
#pragma unroll
            for (int ai = 0; ai < 2; ++ai)
#pragma unroll
                for (int m = 0; m < 4; ++m)
#pragma unroll
                    for (int bj = 0; bj < 2; ++bj) { f32x4 q0, q1; unpack8(qv[ai][m][bj], q0, q1); acc[ai][bj][m][0] *= q0; acc[ai][bj][m][1] *= q1; }
        } else {
            const int row0 = row0_;
            u32x4 pv[2][4][2];
#pragma unroll
            for (int ai = 0; ai < 2; ++ai)
#pragma unroll
                for (int m = 0; m < 4; ++m)
#pragma unroll
                    for (int bj = 0; bj < 2; ++bj) pv[ai][m][bj] = *(const u32x4*)(Z + (size_t)(row0 + ai * HALF + m * 16) * NZ + col0 + bj * HALF + 1024);
            __builtin_amdgcn_sched_barrier(0);
#pragma unroll
            for (int ai = 0; ai < 2; ++ai)
#pragma unroll
                for (int m = 0; m < 4; ++m)
#pragma unroll
                    for (int bj = 0; bj < 2; ++bj) { f32x4 p0, p1; unpack8(pv[ai][m][bj], p0, p1);
                        *(u32x4*)(M + (size_t)(row0 + ai * HALF + m * 16) * D + col0 + bj * HALF) = pack8(acc[ai][bj][m][0] * p0, acc[ai][bj][m][1] * p1); }
        }
        return u.e == 0;
    }
};
struct EpiCombo {
    static constexpr bool PERM = true, KEEPS = false; EpiMerge<0> em; EpiGlu eg;
    __device__ __forceinline__ void operator()(AccRef acc, const Unit& u, int wr, int wc, int fr, int fq) const {
        if (u.e == 0) em(acc, u, wr, wc, fr, fq);
        else { Unit v = u; v.pm = u.pm - (int)((WS_YG - WS_H) / ((size_t)BM * 1024)); eg(acc, v, wr, wc, fr, fq); }
    }
};
struct EpiOut {
    static constexpr bool PERM = true, KEEPS = false; bf16_t* XB; const float* g1; bf16_t* XBW;
    __device__ __forceinline__ void operator()(AccRef acc, const Unit& u, int wr, int wc, int fr, int fq) const {
        const bool lat = u.pm < TL / BM; const int brow = lat ? (u.pm >> 4) : 8;
        bf16_t* xb = XB + (size_t)u.pm * BM * D; bf16_t* xw = XBW + (size_t)u.pm * BM * D;
        const int row0 = wr * 64 + fr, col0 = u.pnl * BM + wc * 32 + 8 * fq;
        f32x4 gv[2][2];
#pragma unroll
        for (int bj = 0; bj < 2; ++bj)
#pragma unroll
            for (int n = 0; n < 2; ++n) gv[bj][n] = *(const f32x4*)(g1 + (size_t)brow * NMOD + col0 + bj * HALF + 4 * n);
#pragma unroll
        for (int ai = 0; ai < 2; ++ai) { u32x4 xv[4][2];
#pragma unroll
            for (int m = 0; m < 4; ++m)
#pragma unroll
                for (int bj = 0; bj < 2; ++bj) xv[m][bj] = *(const u32x4*)(xb + (size_t)(row0 + ai * HALF + m * 16) * D + col0 + bj * HALF);
            __builtin_amdgcn_sched_barrier(0);
#pragma unroll
            for (int m = 0; m < 4; ++m)
#pragma unroll
                for (int bj = 0; bj < 2; ++bj) { f32x4 p0, p1; unpack8(xv[m][bj], p0, p1);
                    *(u32x4*)(xw + (size_t)(row0 + ai * HALF + m * 16) * D + col0 + bj * HALF) = pack8(p0 + gv[bj][0] * acc[ai][bj][m][0], p1 + gv[bj][1] * acc[ai][bj][m][1]); } }
    }
};
struct EpiUp {
    static constexpr bool PERM = true, KEEPS = false; bf16_t* HM;
    __device__ __forceinline__ void operator()(AccRef acc, const Unit& u, int wr, int wc, int fr, int fq) const {
        const int row0 = u.pm * BM + wr * 64 + fr, col0 = u.pnl * HALF + wc * 32 + 8 * fq;
#pragma unroll
        for (int ai = 0; ai < 2; ++ai)
#pragma unroll
            for (int m = 0; m < 4; ++m) { f32x4 a0 = acc[ai][0][m][0], a1 = acc[ai][0][m][1]; const f32x4 b0 = acc[ai][1][m][0], b1 = acc[ai][1][m][1];
                a0 = a0 * sigm4(a0) * b0; a1 = a1 * sigm4(a1) * b1;
                *(u32x4*)(HM + (size_t)(row0 + ai * HALF + m * 16) * DE + col0) = pack8(a0, a1); }
    }
};
struct EpiDown {
    static constexpr bool PERM = true, KEEPS = false; bf16_t* SL; const int* list; const float* gw; const LAS int* cum; const LAS int* cnt;
    __device__ __forceinline__ void operator()(AccRef acc, const Unit& u, int wr, int wc, int fr, int fq) const {
        const int col0 = u.pnl * BM + wc * 32 + 8 * fq; const int pos0 = (u.pm - cum[u.e]) * BM + wr * 64 + fr, n_e = cnt[u.e];
        int ent[2][4]; float w[2][4];
#pragma unroll
        for (int ai = 0; ai < 2; ++ai)
#pragma unroll
            for (int m = 0; m < 4; ++m) { const int pos = pos0 + ai * HALF + m * 16; ent[ai][m] = pos < n_e ? list[u.e * LCAP + pos] : -1; }
#pragma unroll
        for (int ai = 0; ai < 2; ++ai)
#pragma unroll
            for (int m = 0; m < 4; ++m) w[ai][m] = ent[ai][m] >= 0 ? gw[ent[ai][m]] : 0.f;
#pragma unroll
        for (int ai = 0; ai < 2; ++ai)
#pragma unroll
            for (int m = 0; m < 4; ++m) asm volatile("" : "+v"(w[ai][m]));
#pragma unroll
        for (int ai = 0; ai < 2; ++ai)
#pragma unroll
            for (int m = 0; m < 4; ++m) if (ent[ai][m] >= 0) { bf16_t* rowp = SL + (size_t)ent[ai][m] * D + col0;
#pragma unroll
                for (int bj = 0; bj < 2; ++bj) *(u32x4*)(rowp + bj * HALF) = pack8(acc[ai][bj][m][0] * w[ai][m], acc[ai][bj][m][1] * w[ai][m]); }
    }
};
}

#define XB_TMO      128
#define XB_XCNT(j)  (256  + 64 * (j))
#define XB_XSUB(j)  (1280 + 64 * (j))
#define XB_XGEN(j)  (2304 + 64 * (j))
#define XB_TOP      3328
#define XB_TOPGEN   3392
#define XCD_BAR_WORDS 3456
#define XB_SPIN_CAP (1u << 22)

__device__ __forceinline__ unsigned xb_ld(unsigned* p)              { return __hip_atomic_load(p, __ATOMIC_RELAXED, __HIP_MEMORY_SCOPE_AGENT); }
__device__ __forceinline__ unsigned xb_add(unsigned* p, unsigned v) { return __hip_atomic_fetch_add(p, v, __ATOMIC_RELAXED, __HIP_MEMORY_SCOPE_AGENT); }
__device__ __forceinline__ unsigned xb_xcc_id() { return (unsigned)__builtin_amdgcn_s_getreg((3 << 11) | 20) & 0xFu; }
#define XB_SPIN(cond, bar) do { unsigned _sp = 0; while (cond) { __builtin_amdgcn_s_sleep(1); \
    if ((++_sp & 255u) == 0u) { if (xb_ld(&(bar)[XB_TMO])) break; if (_sp > XB_SPIN_CAP) { atomicAdd(&(bar)[XB_TMO], 1u); break; } } } } while (0)

struct XcdBarrier { unsigned* bar; unsigned x; volatile LAS unsigned* st; };
__device__ __forceinline__ XcdBarrier xcd_barrier_post(unsigned* bar, volatile LAS unsigned* st) {
    XcdBarrier b; b.bar = bar; b.x = xb_xcc_id(); b.st = st;
    if (threadIdx.x == 0) (void)xb_add(&bar[XB_XCNT(b.x)], 1u);
    return b;
}
__device__ __forceinline__ void xcd_barrier_complete(unsigned* bar, unsigned x_in, unsigned& nloc, unsigned& nx) {
    unsigned x = x_in;
    const unsigned G = gridDim.x * gridDim.y * gridDim.z;
    asm volatile("" : "+s"(x));
    unsigned sum, cnt, mine, sp = 0u;
    for (;;) {
        sum = 0u; cnt = 0u; mine = 0u;
#pragma unroll
        for (unsigned j = 0; j < 16; ++j) { const unsigned c = xb_ld(&bar[XB_XCNT(j)]); sum += c; cnt += (c > 0u) ? 1u : 0u; mine = (j == x) ? c : mine; }
        if (sum == G) break;
        __builtin_amdgcn_s_sleep(1);
        if ((++sp & 255u) == 0u) { if (xb_ld(&bar[XB_TMO])) break; if (sp > XB_SPIN_CAP) { atomicAdd(&bar[XB_TMO], 1u); break; } }
    }
    nloc = mine > 0u ? mine : 1u; nx = cnt > 0u ? cnt : 1u;
}
__device__ __forceinline__ void xcd_barrier(const XcdBarrier& b, const int tid) {
    asm volatile("s_waitcnt vmcnt(0)" ::: "memory");
    __syncthreads();
    if (tid == 0) {
        unsigned* bar = b.bar;
        __builtin_amdgcn_s_waitcnt(0);
        unsigned nloc = b.st[0], nx = b.st[1];
        if (nloc == 0u) { xcd_barrier_complete(bar, b.x, nloc, nx); b.st[0] = nloc; b.st[1] = nx; }
        const unsigned old = xb_add(&bar[XB_XSUB(b.x)], 1u);
        const unsigned gen = old / nloc;
        if (old + 1u == (gen + 1u) * nloc) {
            __builtin_amdgcn_fence(__ATOMIC_RELEASE, "agent");
            asm volatile("s_waitcnt vmcnt(0)" ::: "memory");
            const unsigned og = xb_add(&bar[XB_TOP], 1u);
            const unsigned tg = og / nx;
            if (og + 1u == (tg + 1u) * nx) xb_add(&bar[XB_TOPGEN], 1u);
            else XB_SPIN(xb_ld(&bar[XB_TOPGEN]) == tg, bar);
            __builtin_amdgcn_fence(__ATOMIC_ACQUIRE, "agent");
            xb_add(&bar[XB_XGEN(b.x)], 1u);
            asm volatile("s_waitcnt vmcnt(0)" ::: "memory");
        } else {
            XB_SPIN(xb_ld(&bar[XB_XGEN(b.x)]) == gen, bar);
            __builtin_amdgcn_fence(__ATOMIC_ACQUIRE, "agent");
            asm volatile("s_waitcnt vmcnt(0)" ::: "memory");
        }
    }
    __syncthreads();
}

constexpr int NWAVES = 8, NTHREADS = 512;
constexpr int RING_BYTES = 131072, MISC_OFF = RING_BYTES, LDS_BYTES = 163840;

struct KArgs {
    const float* in[30]; float* out; unsigned char* ws; int lo, hi;
};
constexpr int PTAB = 3072, WTAB = 3200;
constexpr int PTAB_DUMMY = 0;
struct Args {
    volatile LAS int* tab;
    __device__ __forceinline__ unsigned long long ld(int k) const { const unsigned lo = (unsigned)__builtin_amdgcn_readfirstlane(tab[2 * k]), hi = (unsigned)__builtin_amdgcn_readfirstlane(tab[2 * k + 1]); return ((unsigned long long)hi << 32) | lo; }
    __device__ __forceinline__ const float* in(int k) const { return (const float*)(const GAS float*)ld(k); }
    __device__ __forceinline__ float* out() const { return (float*)(GAS float*)ld(30); }
    __device__ __forceinline__ unsigned char* ws() const { return (unsigned char*)(GAS unsigned char*)ld(31); }
};

struct Ctx {
    LAS unsigned char* lds; volatile LAS int* misc;
    int tid, lane, wave, G, bid;
    unsigned char* ws;
};

__device__ __forceinline__ const float* xrow_in(const Args& a, int row) { return row < TL ? a.in(0) + (size_t)row * D : a.in(2) + (size_t)(row - TL) * D; }
__device__ __forceinline__ int brow_of(int row) { return row < TL ? (row >> 12) : 8; }

__device__ __forceinline__ void zoh(const Args& a, int idx  , float& abr, float& abi, float& fr_, float& fi_) {
    const float are = a.in(11)[idx], aim = a.in(12)[idx]; const float dt = expf(a.in(13)[idx >> 6]);
    const float mag = expf(are * dt); abr = mag * cosf(aim * dt); abi = mag * sinf(aim * dt);
    const float nr = abr - 1.0f, ni = abi, den = are * are + aim * aim;
    fr_ = (nr * are + ni * aim) / den; fi_ = (ni * are - nr * aim) / den;
}
__device__ __forceinline__ void zoh_fast(const Args& a, int idx, float& abr, float& abi, float& fr_, float& fi_) {
    const float are = a.in(11)[idx], aim = a.in(12)[idx]; const float dt = __expf(a.in(13)[idx >> 6]);
    const float mag = __expf(are * dt); abr = mag * __cosf(aim * dt); abi = mag * __sinf(aim * dt);
    const float nr = abr - 1.0f, ni = abi, den = __builtin_amdgcn_rcpf(are * are + aim * aim);
    fr_ = (nr * are + ni * aim) * den; fi_ = (ni * are - nr * aim) * den;
}
__device__ __forceinline__ void phase_p0(const Args& a, Ctx& c) {
    LAS float* sl = (LAS float*)c.lds;
    LAS float* part = (LAS float*)(c.lds + 9 * 1024 * 4);
    for (int i = c.tid; i < 9 * 1024; i += NTHREADS) { const float v = i < 8 * 1024 ? a.in(1)[i] : a.in(3)[i - 8 * 1024]; sl[i] = v * sigm(v); }
    __syncthreads();
    float* mods = (float*)(c.ws + WS_MODS);
    for (int it = c.bid; it < DEPTH * 96; it += c.G) {
        const int l = it / 96, col = (it % 96) * 64 + c.lane;
        const float* w = a.in(4) + (size_t)l * D * NMOD + col;
        float acc[9];
#pragma unroll
        for (int r = 0; r < 9; ++r) acc[r] = 0.f;
#pragma unroll 8
        for (int kk = 0; kk < 128; ++kk) { const int k = c.wave * 128 + kk; const float wv = w[(size_t)k * NMOD];
#pragma unroll
            for (int r = 0; r < 9; ++r) acc[r] += sl[r * 1024 + k] * wv; }
#pragma unroll
        for (int r = 0; r < 9; ++r) part[(c.wave * 9 + r) * 64 + c.lane] = acc[r];
        __syncthreads();
        for (int o = c.tid; o < 9 * 64; o += NTHREADS) { float s = 0.f;
#pragma unroll
            for (int w8 = 0; w8 < 8; ++w8) s += part[w8 * 576 + o];
            const int r = o >> 6, cc = (it % 96) * 64 + (o & 63); mods[((size_t)l * 9 + r) * NMOD + cc] = s + a.in(5)[(size_t)l * NMOD + cc]; }
        __syncthreads();
    }
    const int gt = c.bid * NTHREADS + c.tid, GT = c.G * NTHREADS;
    f32x2* AB = (f32x2*)(c.ws + WS_AB);
    for (int i = gt; i < DEPTH * 2 * 32 * 64; i += GT) { float abr, abi, fr_, fi_; zoh(a, i, abr, abi, fr_, fi_); AB[i] = (f32x2){abr, abi}; }
    u32x4* BF = (u32x4*)(c.ws + WS_BF);
    for (int i = gt; i < DEPTH * 2 * 32 * 4 * 64; i += GT) {
        const int ln = i & 63, f = (i >> 6) & 3, ldg = i >> 8; const int ri = f >> 1, tile = f & 1, p = tile * 32 + (ln & 31), hh = ln >> 5;
        float abr, abi, fr_, fi_; zoh(a, ldg * 64 + p, abr, abi, fr_, fi_);
        const float* bre = a.in(14) + ((size_t)ldg * 64 + p) * 16 + 8 * hh; const float* bim = a.in(15) + ((size_t)ldg * 64 + p) * 16 + 8 * hh;
        float v[8];
#pragma unroll
        for (int j = 0; j < 8; ++j) v[j] = ri == 0 ? fr_ * bre[j] - fi_ * bim[j] : fr_ * bim[j] + fi_ * bre[j];
        u32x4 o; o.x = f2bf(v[0]) | (f2bf(v[1]) << 16); o.y = f2bf(v[2]) | (f2bf(v[3]) << 16); o.z = f2bf(v[4]) | (f2bf(v[5]) << 16); o.w = f2bf(v[6]) | (f2bf(v[7]) << 16);
        BF[i] = o;
    }
    u32x4* CF = (u32x4*)(c.ws + WS_CF);
    for (int i = gt; i < DEPTH * 2 * 32 * 5 * 64; i += GT) {
        const int ln = i & 63, ks = (i >> 6) % 5, ldg = (i >> 6) / 5; const int j = ln & 15, q = ln >> 4; const int l = ldg >> 6, g = ldg & 31;
        const float* cre = a.in(16) + ((size_t)ldg * 16 + j) * 64; const float* cim = a.in(17) + ((size_t)ldg * 16 + j) * 64;
        float v[8];
#pragma unroll
        for (int e = 0; e < 8; ++e) { const int k = 32 * ks + 8 * q + e; float x;
            if (k < 128) { const int n = k >> 2, cm = k & 3; x = cm == 0 ? cre[n] : cm == 1 ? -cim[n] : cm == 2 ? cre[n + 32] : -cim[n + 32]; }
            else { const int jj = k - 128; x = (jj == j) ? a.in(18)[l * 512 + g * 16 + j] : 0.f; }
            v[e] = x; }
        u32x4 o; o.x = f2bf(v[0]) | (f2bf(v[1]) << 16); o.y = f2bf(v[2]) | (f2bf(v[3]) << 16); o.z = f2bf(v[4]) | (f2bf(v[5]) << 16); o.w = f2bf(v[6]) | (f2bf(v[7]) << 16);
        CF[i] = o;
    }
}

__device__ __forceinline__ void s3_tables(const Args& a, Ctx& c, const int wi, const int nw) {
    u32x4* TB = (u32x4*)(c.ws + WS_S3T);
    __syncthreads();
    LAS float* sC = (LAS float*)c.lds;
    LAS float* sB = sC + 2 * 16 * 65;
    LAS float* sA = sB + 2048;
    LAS float* sK = sA + 256;
    for (int ldg = wi; ldg < DEPTH * 2 * 32; ldg += nw) {
        const int l = ldg >> 6, dir = (ldg >> 5) & 1, g = ldg & 31;
        __syncthreads();
        for (int i = c.tid; i < 1024; i += NTHREADS) { const int o = i >> 6, n = i & 63; sC[o * 65 + n] = a.in(16)[(size_t)ldg * 1024 + i]; sC[16 * 65 + o * 65 + n] = a.in(17)[(size_t)ldg * 1024 + i]; }
        if (c.tid < 64) { float abr, abi, fr_, fi_; zoh(a, ldg * 64 + c.tid, abr, abi, fr_, fi_); sA[4 * c.tid] = abr; sA[4 * c.tid + 1] = abi; sA[4 * c.tid + 2] = fr_; sA[4 * c.tid + 3] = fi_; }
        __syncthreads();
        for (int i = c.tid; i < 1024; i += NTHREADS) { const int n = i >> 4; const float br = a.in(14)[(size_t)ldg * 1024 + i], bi = a.in(15)[(size_t)ldg * 1024 + i], fr_ = sA[4 * n + 2], fi_ = sA[4 * n + 3];
            sB[i] = fr_ * br - fi_ * bi; sB[1024 + i] = fr_ * bi + fi_ * br; }
        __syncthreads();
        for (int idx = c.tid; idx < 1024; idx += NTHREADS) { const int dd = idx >> 8, o = (idx >> 4) & 15, j = idx & 15; float acc = 0.f;
#pragma unroll 1
            for (int n0 = 0; n0 < 64; n0 += 8) {
                f32x4 ab[8]; float cr[8], ci[8], br[8], bi[8];
#pragma unroll
                for (int q = 0; q < 8; ++q) { const int n = n0 + q; ab[q] = *(const LAS f32x4*)(sA + 4 * n); cr[q] = sC[o * 65 + n]; ci[q] = sC[16 * 65 + o * 65 + n]; br[q] = sB[n * 16 + j]; bi[q] = sB[1024 + n * 16 + j]; }
                __builtin_amdgcn_sched_barrier(0);
#pragma unroll
                for (int q = 0; q < 8; ++q) { float pr = 1.f, pi = 0.f;
#pragma unroll
                    for (int e = 0; e < 3; ++e) if (e < dd) { const float t = pr * ab[q][0] - pi * ab[q][1], u = pr * ab[q][1] + pi * ab[q][0]; pr = t; pi = u; }
                    const float Gr = cr[q] * pr - ci[q] * pi, Gi = cr[q] * pi + ci[q] * pr; acc += Gr * br[q] - Gi * bi[q]; } }
            sK[idx] = acc; }
        __syncthreads();
        for (int en = c.tid; en < 40 * 64; en += NTHREADS) {
        const int ln = en & 63, f = en >> 6; const int col = ln & 31, kh = ln >> 5;
        float v[8];
#pragma unroll
        for (int j = 0; j < 8; ++j) v[j] = 0.f;
        if (f < 24) { const int ks = f / 6, nb = f % 6;
            if (nb < 4) { const int pst = (nb & 1) * 32 + col, comp = nb >> 1; const f32x4 ab = *(const LAS f32x4*)(sA + 4 * pst);
                const f32x4 br0 = *(const LAS f32x4*)(sB + pst * 16 + 8 * kh), br1 = *(const LAS f32x4*)(sB + pst * 16 + 8 * kh + 4), bi0 = *(const LAS f32x4*)(sB + 1024 + pst * 16 + 8 * kh), bi1 = *(const LAS f32x4*)(sB + 1024 + pst * 16 + 8 * kh + 4);
                float pr = 1.f, pi = 0.f; for (int e = 0; e < 3 - ks; ++e) { const float t = pr * ab[0] - pi * ab[1], u = pr * ab[1] + pi * ab[0]; pr = t; pi = u; }
#pragma unroll
                for (int j = 0; j < 4; ++j) { v[j] = comp == 0 ? pr * br0[j] - pi * bi0[j] : pr * bi0[j] + pi * br0[j]; v[4 + j] = comp == 0 ? pr * br1[j] - pi * bi1[j] : pr * bi1[j] + pi * br1[j]; }
            } else { const int sp = 2 * (nb - 4) + (col >> 4), o = col & 15, s1 = dir == 0 ? sp : 3 - sp;
                const int dd = s1 - ks;
                if (dd >= 0) { const f32x4 k0 = *(const LAS f32x4*)(sK + (dd * 16 + o) * 16 + 8 * kh), k1 = *(const LAS f32x4*)(sK + (dd * 16 + o) * 16 + 8 * kh + 4);
#pragma unroll
                    for (int j = 0; j < 4; ++j) { v[j] = k0[j]; v[4 + j] = k1[j]; } }
                if (dir == 0 && dd == 0) {
#pragma unroll
                    for (int j = 0; j < 8; ++j) if (8 * kh + j == o) v[j] += a.in(18)[l * 512 + g * 16 + o]; } }
        } else { const int kk = (f - 24) >> 1, nb = (f - 24) & 1; const int sp = 2 * nb + (col >> 4), o = col & 15, s1 = dir == 0 ? sp : 3 - sp;
            f32x4 ab[4]; float cr[4], ci[4];
#pragma unroll
            for (int q = 0; q < 4; ++q) { const int n = 8 * kk + 4 * kh + q; ab[q] = *(const LAS f32x4*)(sA + 4 * n); cr[q] = sC[o * 65 + n]; ci[q] = sC[16 * 65 + o * 65 + n]; }
            __builtin_amdgcn_sched_barrier(0);
#pragma unroll
            for (int q = 0; q < 4; ++q) { float pr = ab[q][0], pi = ab[q][1];
#pragma unroll
                for (int e = 0; e < 3; ++e) if (e < s1) { const float t = pr * ab[q][0] - pi * ab[q][1], u = pr * ab[q][1] + pi * ab[q][0]; pr = t; pi = u; }
                const float Gr = cr[q] * pr - ci[q] * pi, Gi = cr[q] * pi + ci[q] * pr; v[2 * q] = Gr; v[2 * q + 1] = -Gi; } }
        u32x4 o4; o4.x = f2bf(v[0]) | (f2bf(v[1]) << 16); o4.y = f2bf(v[2]) | (f2bf(v[3]) << 16); o4.z = f2bf(v[4]) | (f2bf(v[5]) << 16); o4.w = f2bf(v[6]) | (f2bf(v[7]) << 16);
        TB[(size_t)ldg * 2560 + en] = o4;
        }
    }
    __syncthreads();
}

template <class RowMap>
__device__ __forceinline__ void tr_item(const float* W, int ldn, int K, bf16_t* WT, const RowMap& rm, LAS bf16_t* scr, int kb, int nb, int lane) {
    const int k0 = 64 * kb, n0 = 64 * nb;
    f32x4 x[16];
#pragma unroll
    for (int i = 0; i < 16; ++i) x[i] = __builtin_nontemporal_load((const f32x4*)(W + (size_t)(k0 + 4 * i + (lane >> 4)) * ldn + n0 + (lane & 15) * 4));
#pragma unroll
    for (int i = 0; i < 16; ++i) { u32x2 w; w.x = pk2(x[i][0], x[i][1]); w.y = pk2(x[i][2], x[i][3]); *(LAS u32x2*)(scr + (4 * i + (lane >> 4)) * 72 + (lane & 15) * 4) = w; }
    LDS_WAIT(); asm volatile("" ::: "memory");
    const int cch = lane & 7;
#pragma unroll
    for (int j = 0; j < 8; ++j) { const int n = (lane >> 3) + 8 * j; const LAS bf16_t* sp = scr + (8 * cch) * 72 + n;
        u32x4 o; o.x = (unsigned)sp[0] | ((unsigned)sp[72] << 16); o.y = (unsigned)sp[2 * 72] | ((unsigned)sp[3 * 72] << 16); o.z = (unsigned)sp[4 * 72] | ((unsigned)sp[5 * 72] << 16); o.w = (unsigned)sp[6 * 72] | ((unsigned)sp[7 * 72] << 16);
        *(u32x4*)(WT + (size_t)rm(n0 + n) * K + k0 + 8 * cch) = o; }
    LDS_WAIT(); asm volatile("" ::: "memory");
}
struct RmId { int off; __device__ __forceinline__ int operator()(int n) const { return off + n; } };
struct RmW13 { int off; __device__ __forceinline__ int operator()(int n) const { return off + 256 * (n >> 7) + (n & 127); } };

__device__ __forceinline__ void norm_row(const Args& a, Ctx& c, int l, int row, int which  , f32x4 (&v)[4]) {
    float s = 0.f;
#pragma unroll
    for (int j = 0; j < 4; ++j) s += (v[j][0] * v[j][0] + v[j][1] * v[j][1]) + (v[j][2] * v[j][2] + v[j][3] * v[j][3]);
    const float rstd = 1.0f / sqrtf(wave_sum(s, c.lane) * (1.0f / D) + RMS_EPS);
    const float* gn = a.in(which ? 7 : 6) + (size_t)l * D; const float* md = (const float*)(c.ws + WS_MODS) + ((size_t)l * 9 + brow_of(row)) * NMOD + (which ? 3 * D : 0);
#pragma unroll
    for (int j = 0; j < 4; ++j) { const int col = 4 * c.lane + 256 * j; const f32x4 g = *(const f32x4*)(gn + col), sh = *(const f32x4*)(md + col), sc = *(const f32x4*)(md + D + col);
        v[j] = v[j] * rstd * g * (1.0f + sc) + sh; }
}
__device__ __forceinline__ void store_row_bf16(bf16_t* dst, int lane, const f32x4 (&v)[4]) {
#pragma unroll
    for (int j = 0; j < 4; ++j) { u32x2 w; w.x = pk2(v[j][0], v[j][1]); w.y = pk2(v[j][2], v[j][3]); *(u32x2*)(dst + 4 * lane + 256 * j) = w; }
}
__device__ __forceinline__ void load_x_row(const Args& a, Ctx& c, int l, int row, f32x4 (&v)[4]) {
    if (l == 0) { const float* xs = xrow_in(a, row); bf16_t* xb = (bf16_t*)(c.ws + WS_XB) + (size_t)row * D;
#pragma unroll
        for (int j = 0; j < 4; ++j) { v[j] = *(const f32x4*)(xs + 4 * c.lane + 256 * j); st_bf4(xb + 4 * c.lane + 256 * j, v[j]); }
    } else {
        bf16_t* xb = (bf16_t*)(c.ws + WS_XB) + (size_t)row * D;
        const bf16_t* sl = (const bf16_t*)(c.ws + WS_Z) + (size_t)row * 2 * D; const float* g2 = (const float*)(c.ws + WS_MODS) + ((size_t)(l - 1) * 9 + brow_of(row)) * NMOD + 5 * D;
#pragma unroll
        for (int j = 0; j < 4; ++j) { const int col = 4 * c.lane + 256 * j; const f32x4 g = *(const f32x4*)(g2 + col);
            v[j] = ld_bf4(xb + col) + g * (ld_bf4(sl + col) + ld_bf4(sl + D + col)); }
#pragma unroll
        for (int j = 0; j < 4; ++j) st_bf4(xb + 4 * c.lane + 256 * j, v[j]);
    }
}
constexpr int TR_I_IN = 16 * 48, TR_I_BS = 8 * 16, TR_I_OUT = 16 * 16, TR_I_GLU = 8 * 8, TR_I_W1 = 16 * 16 * 8, TR_I_W3 = TR_I_W1, TR_I_W2 = 16 * 8 * 16, TR_I_WC = 512;
constexpr int TR_NITEMS = TR_I_IN + TR_I_BS + TR_I_OUT + TR_I_GLU + TR_I_W1 + TR_I_W3 + TR_I_W2 + TR_I_WC;
struct RmGen { int off, w13; __device__ __forceinline__ int operator()(int n) const { return off + (w13 == 1 ? 256 * (n >> 7) + (n & 127) : (w13 == 2 && n >= 1024) ? 1024 + 256 * (((n - 1024) & 1023) >> 7) + 128 * ((n - 1024) >> 10) + (n & 127) : n); } };
__device__ __forceinline__ size_t wbuf_off(int l) { return (l & 1) ? WS_W2ND : WS_W; }
__device__ __forceinline__ void tr_one(const Args& a, Ctx& c, int l, int it, LAS bf16_t* scr) {
    bf16_t* WB = (bf16_t*)(c.ws + wbuf_off(l));
    int r = it;
    if (r < TR_NITEMS - TR_I_WC) {
        const float* src; int ldn, K, kb, nb; bf16_t* dst; RmGen rm{0, 0};
        if (r < TR_I_IN) { src = a.in(8) + (size_t)l * D * NZ; ldn = NZ; K = D; dst = WB + WO_WIN / 2; rm = RmGen{0, 2}; kb = r % 16; nb = r / 16; }
        else if ((r -= TR_I_IN) < TR_I_BS) { src = a.in(22) + (size_t)l * 512 * D; ldn = D; K = 512; dst = WB + WO_WBS / 2; kb = r % 8; nb = r / 8; }
        else if ((r -= TR_I_BS) < TR_I_OUT) { src = a.in(23) + (size_t)l * D * D; ldn = D; K = D; dst = WB + WO_WOUT / 2; kb = r % 16; nb = r / 16; }
        else if ((r -= TR_I_OUT) < TR_I_GLU) { src = a.in(19) + (size_t)l * 512 * 512; ldn = 512; K = 512; dst = WB + WO_GLU / 2; kb = r % 8; nb = r / 8; }
        else if ((r -= TR_I_GLU) < TR_I_W1) { const int e = r >> 7, q = r & 127; src = a.in(26) + ((size_t)l * NE + e) * D * DE; ldn = DE; K = D; dst = WB + WO_W13 / 2; rm = RmGen{e * 1024, 1}; kb = q % 16; nb = q / 16; }
        else if ((r -= TR_I_W1) < TR_I_W3) { const int e = r >> 7, q = r & 127; src = a.in(27) + ((size_t)l * NE + e) * D * DE; ldn = DE; K = D; dst = WB + WO_W13 / 2; rm = RmGen{e * 1024 + 128, 1}; kb = q % 16; nb = q / 16; }
        else { r -= TR_I_W3; const int e = r >> 7, q = r & 127; src = a.in(28) + ((size_t)l * NE + e) * DE * D; ldn = D; K = DE; dst = WB + WO_W2 / 2; rm = RmGen{e * 1024, 0}; kb = q % 8; nb = q / 8; }
        tr_item(src, ldn, K, dst, rm, scr, kb, nb, c.lane);
    } else {
        r -= TR_NITEMS - TR_I_WC;
        {
            const int g = r >> 7, cb = (r >> 4) & 7, db = r & 15, d = db * 64 + c.lane;
            const float* pw = a.in(9) + ((size_t)l * 4 + g) * 128 * 128 + (size_t)(cb * 16) * 128; const float* ps = a.in(10) + (size_t)l * 512 + g * 128;
            const float* wb = a.in(21) + ((size_t)l * 512 + g * 128) * D + d;
            LAS float* pl = (LAS float*)scr;
#pragma unroll
            for (int i = 0; i < 8; ++i) { const int e = i * 256 + c.lane * 4, q = e >> 7, c2 = e & 127; const f32x4 x = *(const f32x4*)(pw + e), sc4 = *(const f32x4*)(ps + c2);
                pl[(c2 + 0) * 16 + q] = x[0] * sc4[0]; pl[(c2 + 1) * 16 + q] = x[1] * sc4[1]; pl[(c2 + 2) * 16 + q] = x[2] * sc4[2]; pl[(c2 + 3) * 16 + q] = x[3] * sc4[3]; }
            LDS_WAIT(); asm volatile("" ::: "memory");
            float acc[16];
#pragma unroll
            for (int q = 0; q < 16; ++q) acc[q] = 0.f;
#pragma unroll 8
            for (int c2 = 0; c2 < 128; ++c2) { const float x = wb[(size_t)c2 * D]; const LAS f32x4* p4 = (const LAS f32x4*)(pl + c2 * 16);
#pragma unroll
                for (int q4 = 0; q4 < 4; ++q4) { const f32x4 w4 = p4[q4]; acc[q4 * 4 + 0] += w4[0] * x; acc[q4 * 4 + 1] += w4[1] * x; acc[q4 * 4 + 2] += w4[2] * x; acc[q4 * 4 + 3] += w4[3] * x; } }
            u32x4 o0, o1; o0.x = pk2(acc[0], acc[1]); o0.y = pk2(acc[2], acc[3]); o0.z = pk2(acc[4], acc[5]); o0.w = pk2(acc[6], acc[7]);
            o1.x = pk2(acc[8], acc[9]); o1.y = pk2(acc[10], acc[11]); o1.z = pk2(acc[12], acc[13]); o1.w = pk2(acc[14], acc[15]);
            bf16_t* dst = WB + WO_WC / 2 + (size_t)d * 512 + g * 128 + cb * 16; *(u32x4*)dst = o0; *(u32x4*)(dst + 8) = o1;
            LDS_WAIT(); asm volatile("" ::: "memory");
        }
    }
}
__device__ __forceinline__ void tr_range(const Args& a, Ctx& c, int l, int first, int last, int w, int nw) {
    LAS bf16_t* scr = (LAS bf16_t*)(c.lds + c.wave * 16384);
#pragma unroll 1
    for (int it = first + w; it < last; it += nw) tr_one(a, c, l, it, scr);
}
constexpr int TR_SPLIT = 3000, TR_SPLIT2 = 5500;
__device__ __forceinline__ int ncol(int lane, int j) { return 8 * lane + 512 * (j >> 1) + 4 * (j & 1); }
__device__ __forceinline__ void phase_a(const Args& a, Ctx& c, int l, const bool dummy = false) {
    bf16_t* H = (bf16_t*)(c.ws + (dummy ? WS_HMID : WS_H)); bf16_t* XB = (bf16_t*)(c.ws + WS_XB); bf16_t* XBW = (bf16_t*)(c.ws + (dummy ? WS_HMID : WS_XB));
    const int rpb = (T + c.G - 1) / c.G, rbeg = c.bid * rpb + c.wave, rend = (c.bid + 1) * rpb < T ? (c.bid + 1) * rpb : T;
    f32x4 pg[4], psh[4], pg2[4]; int cur_b = -1; u32x4 nx[2], ns0[2], ns1[2];
    for (int row = rbeg; row < rend; row += NWAVES) {
        const int br = brow_of(row);
        if (br != cur_b) { cur_b = br;
            const float* gn = a.in(6) + (size_t)l * D; const float* md = (const float*)(c.ws + WS_MODS) + ((size_t)l * 9 + br) * NMOD;
            const float* g2 = (const float*)(c.ws + WS_MODS) + ((size_t)(l > 0 ? l - 1 : 0) * 9 + br) * NMOD + 5 * D;
#pragma unroll
            for (int j = 0; j < 4; ++j) { const int col = ncol(c.lane, j); pg[j] = *(const f32x4*)(gn + col) * (1.0f + *(const f32x4*)(md + D + col)); psh[j] = *(const f32x4*)(md + col); pg2[j] = *(const f32x4*)(g2 + col); } }
        f32x4 v[4];
        if (l == 0) { const float* xs = xrow_in(a, row);
#pragma unroll
            for (int j = 0; j < 4; ++j) v[j] = *(const f32x4*)(xs + ncol(c.lane, j));
        } else {
            if (row == rbeg) { const bf16_t* xb = XB + (size_t)row * D; const bf16_t* sl = (const bf16_t*)(c.ws + WS_Z) + (size_t)row * 2 * D;
#pragma unroll
                for (int k = 0; k < 2; ++k) { const int col = 8 * c.lane + 512 * k; nx[k] = *(const u32x4*)(xb + col); ns0[k] = *(const u32x4*)(sl + col); ns1[k] = *(const u32x4*)(sl + D + col); } }
            u32x4 cx[2], cs0[2], cs1[2];
#pragma unroll
            for (int k = 0; k < 2; ++k) { cx[k] = nx[k]; cs0[k] = ns0[k]; cs1[k] = ns1[k]; }
            if (row + NWAVES < rend) { const bf16_t* xb = XB + (size_t)(row + NWAVES) * D; const bf16_t* sl = (const bf16_t*)(c.ws + WS_Z) + (size_t)(row + NWAVES) * 2 * D;
#pragma unroll
                for (int k = 0; k < 2; ++k) { const int col = 8 * c.lane + 512 * k; nx[k] = *(const u32x4*)(xb + col); ns0[k] = *(const u32x4*)(sl + col); ns1[k] = *(const u32x4*)(sl + D + col); } }
#pragma unroll
            for (int k = 0; k < 2; ++k) { f32x4 xa, xc, sa, sc, ta, tc2; pg8::unpack8(cx[k], xa, xc); pg8::unpack8(cs0[k], sa, sc); pg8::unpack8(cs1[k], ta, tc2);
                v[2 * k] = xa + pg2[2 * k] * (sa + ta); v[2 * k + 1] = xc + pg2[2 * k + 1] * (sc + tc2); } }
        float ss = 0.f;
#pragma unroll
        for (int k = 0; k < 2; ++k) { *(u32x4*)(XBW + (size_t)row * D + 8 * c.lane + 512 * k) = pg8::pack8(v[2 * k], v[2 * k + 1]); }
#pragma unroll
        for (int j = 0; j < 4; ++j) ss += (v[j][0] * v[j][0] + v[j][1] * v[j][1]) + (v[j][2] * v[j][2] + v[j][3] * v[j][3]);
        const float rstd = 1.0f / sqrtf(wave_sum(ss, c.lane) * (1.0f / D) + RMS_EPS);
#pragma unroll
        for (int j = 0; j < 4; ++j) v[j] = v[j] * rstd * pg[j] + psh[j];
#pragma unroll
        for (int k = 0; k < 2; ++k) *(u32x4*)(H + (size_t)row * D + 8 * c.lane + 512 * k) = pg8::pack8(v[2 * k], v[2 * k + 1]);
    }
}

__device__ __forceinline__ float fma_v(float a, float b, float c) { float d; asm("v_fma_f32 %0, %1, %2, %3" : "=v"(d) : "v"(a), "v"(b), "v"(c)); return d; }
__device__ __forceinline__ int tok_row(int b, int tc, int i) { return tc < 4 ? TL + b * CTXL + tc * 64 + i : b * SEQ + (tc - 4) * 64 + i; }
__device__ __forceinline__ int scan_chunk(int tc, int dir) { return dir == 0 ? tc : (tc < 4 ? 3 - tc : 71 - tc); }
__device__ __forceinline__ size_t car_idx(int b, int g, int dir, int cc, int n) { return ((((size_t)b * 32 + g) * 2 + dir) * NCH + cc) * 32 + n; }

#define S5_TILE(READ, dirv, tau)                                                                                                               \
    {                                                                                                                                          \
        const int r_ = lane & 31, sq_ = (r_ >> 2) & 1, stp_ = (r_ & 3) + 4 * (r_ >> 3);                                                        \
        const int ti_ = (dirv) == 0 ? 16 * (tau) + stp_ : 16 * (tau) + 15 - stp_;                                                              \
        const bf16x8 af_ = *(const bf16x8*)(Z + (size_t)tok_row(2 * bp + sq_, tc, ti_) * NZ + 512 + 16 * g + 8 * hh);                          \
        __builtin_amdgcn_sched_barrier(0);                                                                                                     \
        const f32x16 z16_ = {0.f, 0.f, 0.f, 0.f, 0.f, 0.f, 0.f, 0.f, 0.f, 0.f, 0.f, 0.f, 0.f, 0.f, 0.f, 0.f};                                  \
        f32x16 ur0_ = __builtin_amdgcn_mfma_f32_32x32x16_bf16(af_, bfr[0], z16_, 0, 0, 0);                                               \
        f32x16 ur1_ = __builtin_amdgcn_mfma_f32_32x32x16_bf16(af_, bfr[1], z16_, 0, 0, 0);                                               \
        f32x16 ui0_ = __builtin_amdgcn_mfma_f32_32x32x16_bf16(af_, bfr[2], z16_, 0, 0, 0);                                               \
        f32x16 ui1_ = __builtin_amdgcn_mfma_f32_32x32x16_bf16(af_, bfr[3], z16_, 0, 0, 0);                                                     \
        __builtin_amdgcn_sched_barrier(0);                                                                                                     \
        asm volatile("s_nop 15\n\ts_nop 15" : "+v"(ur0_), "+v"(ur1_), "+v"(ui0_), "+v"(ui1_) : "v"(af_), "v"(bfr[0]), "v"(bfr[1]), "v"(bfr[2]), "v"(bfr[3]));   \
        __builtin_amdgcn_sched_barrier(0);                                                                                                     \
        _Pragma("unroll") for (int i_ = 0; i_ < 16; ++i_) {                                                                                    \
              \
            const float n0_ = fma_v(ar0, hr0, fma_v(nai0, hi0, ur0_[i_])), m0_ = fma_v(ar0, hi0, fma_v(ai0, hr0, ui0_[i_]));                    \
            const float n1_ = fma_v(ar1, hr1, fma_v(nai1, hi1, ur1_[i_])), m1_ = fma_v(ar1, hi1, fma_v(ai1, hr1, ui1_[i_]));                    \
            hr0 = n0_; hi0 = m0_; hr1 = n1_; hi1 = m1_;                                                                                        \
            if (READ) { u32x2 w_; w_.x = pk2(hr0, hi0); w_.y = pk2(hr1, hi1); *(LAS u32x2*)(img + (hh * 16 + i_) * IMG_STRIDE + (lane & 31) * 8) = w_; } \
        }                                                                                                                                      \
        if (READ && (dirv) == 0) *(LAS bf16x8*)(img + (sq_ * 16 + stp_) * IMG_STRIDE + 256 + hh * 16) = af_;                                   \
    }

#define S5_TILEP(READ, dirv, tau, afv)                                                                                                               \
    {                                                                                                                                          \
        const int r_ = lane & 31, sq_ = (r_ >> 2) & 1, stp_ = (r_ & 3) + 4 * (r_ >> 3);                                                        \
        const int ti_ = (dirv) == 0 ? 16 * (tau) + stp_ : 16 * (tau) + 15 - stp_;                                                              \
        const bf16x8 af_ = (afv);                          \
        __builtin_amdgcn_sched_barrier(0);                                                                                                     \
        const f32x16 z16_ = {0.f, 0.f, 0.f, 0.f, 0.f, 0.f, 0.f, 0.f, 0.f, 0.f, 0.f, 0.f, 0.f, 0.f, 0.f, 0.f};                                  \
        f32x16 ur0_ = __builtin_amdgcn_mfma_f32_32x32x16_bf16(af_, bfr[0], z16_, 0, 0, 0);                                               \
        f32x16 ur1_ = __builtin_amdgcn_mfma_f32_32x32x16_bf16(af_, bfr[1], z16_, 0, 0, 0);                                               \
        f32x16 ui0_ = __builtin_amdgcn_mfma_f32_32x32x16_bf16(af_, bfr[2], z16_, 0, 0, 0);                                               \
        f32x16 ui1_ = __builtin_amdgcn_mfma_f32_32x32x16_bf16(af_, bfr[3], z16_, 0, 0, 0);                                                     \
        __builtin_amdgcn_sched_barrier(0);                                                                                                     \
        asm volatile("s_nop 15\n\ts_nop 15" : "+v"(ur0_), "+v"(ur1_), "+v"(ui0_), "+v"(ui1_) : "v"(af_), "v"(bfr[0]), "v"(bfr[1]), "v"(bfr[2]), "v"(bfr[3]));   \
        __builtin_amdgcn_sched_barrier(0);                                                                                                     \
        _Pragma("unroll") for (int i_ = 0; i_ < 16; ++i_) {                                                                                    \
              \
            const float n0_ = fma_v(ar0, hr0, fma_v(nai0, hi0, ur0_[i_])), m0_ = fma_v(ar0, hi0, fma_v(ai0, hr0, ui0_[i_]));                    \
            const float n1_ = fma_v(ar1, hr1, fma_v(nai1, hi1, ur1_[i_])), m1_ = fma_v(ar1, hi1, fma_v(ai1, hr1, ui1_[i_]));                    \
            hr0 = n0_; hi0 = m0_; hr1 = n1_; hi1 = m1_;                                                                                        \
            if (READ) { u32x2 w_; w_.x = pk2(hr0, hi0); w_.y = pk2(hr1, hi1); *(LAS u32x2*)(img + (hh * 16 + i_) * IMG_STRIDE + (lane & 31) * 8) = w_; } \
        }                                                                                                                                      \
        if (READ && (dirv) == 0) *(LAS bf16x8*)(img + (sq_ * 16 + stp_) * IMG_STRIDE + 256 + hh * 16) = af_;                                   \
    }

__device__ __forceinline__ bf16x8 s5_afrag(const bf16_t* Z, int bp, int tc, int g, int dir, int tau, int lane) {
    const int r = lane & 31, sq = (r >> 2) & 1, stp = (r & 3) + 4 * (r >> 3), hh = lane >> 5;
    const int ti = dir == 0 ? 16 * tau + stp : 16 * tau + 15 - stp;
    return *(const bf16x8*)(Z + ((size_t)g * T + tok_row(2 * bp + sq, tc, ti)) * 16 + 8 * hh);
}
__device__ __forceinline__ bf16x8 s1_afrag(const bf16_t* Z, int bp, int tc, int g, int dir, int ks, int lane) {
    const int r = lane & 31, sq = (r >> 2) & 1, b4 = (r & 3) + 4 * (r >> 3), hh = lane >> 5;
    const int sg = 4 * b4 + ks, ti = dir == 0 ? sg : 63 - sg;
    return *(const bf16x8*)(Z + ((size_t)g * T + tok_row(2 * bp + sq, tc, ti)) * 16 + 8 * hh);
}
__device__ __forceinline__ void phase_s1(const Args& a, Ctx& c, int l, size_t dst_off = WS_CAR) {
    const bf16_t* Z = (const bf16_t*)(c.ws + WS_U); f32x4* CAR = (f32x4*)(c.ws + dst_off);
    const f32x2* AB = (const f32x2*)(c.ws + WS_AB); const bf16x8* BF = (const bf16x8*)(c.ws + WS_BF);
    const int lane = c.lane, hh = lane >> 5;
    constexpr int NT1 = 4 * NCH * 8;
    const int dir = c.wave & 1;
    int cur_ldg = -1; float qr0 = 0.f, qi0 = 0.f, qr1 = 0.f, qi1 = 0.f, nqi0 = 0.f, nqi1 = 0.f; bf16x8 W[4][4], afc[4], afn[4];
#pragma unroll
    for (int f = 0; f < 4; ++f) { afc[f] = (bf16x8){0, 0, 0, 0, 0, 0, 0, 0}; afn[f] = afc[f];
#pragma unroll
        for (int k = 0; k < 4; ++k) W[k][f] = afc[f]; }
    if (c.bid < NT1) { const int bt = c.bid, rest = bt >> 3, tc = rest % NCH, bp = rest / NCH, g = (bt & 7) * 4 + (c.wave >> 1);
#pragma unroll
        for (int ks = 0; ks < 4; ++ks) afc[ks] = s1_afrag(Z, bp, tc, g, dir, ks, lane); }
    for (int bt = c.bid; bt < NT1; bt += c.G) {
        const int gq = bt & 7, rest = bt >> 3, tc = rest % NCH, bp = rest / NCH; const int g = gq * 4 + (c.wave >> 1);
        const int ldg = (l * 2 + dir) * 32 + g;
        if (ldg != cur_ldg) { cur_ldg = ldg;
            const f32x2 a0 = AB[ldg * 64 + (lane & 31)], a1 = AB[ldg * 64 + 32 + (lane & 31)];
            u32x4 bw[4];
#pragma unroll
            for (int f = 0; f < 4; ++f) bw[f] = __builtin_bit_cast(u32x4, BF[(ldg * 4 + f) * 64 + lane]);
            f32x4 br0a, br0b, br1a, br1b, bi0a, bi0b, bi1a, bi1b; pg8::unpack8(bw[0], br0a, br0b); pg8::unpack8(bw[1], br1a, br1b); pg8::unpack8(bw[2], bi0a, bi0b); pg8::unpack8(bw[3], bi1a, bi1b);
            float pr0 = 1.f, pi0 = 0.f, pr1 = 1.f, pi1 = 0.f;
#pragma unroll
            for (int ks = 3; ks >= 0; --ks) {
                W[ks][0] = __builtin_bit_cast(bf16x8, pg8::pack8(br0a * pr0 - bi0a * pi0, br0b * pr0 - bi0b * pi0));
                W[ks][1] = __builtin_bit_cast(bf16x8, pg8::pack8(br1a * pr1 - bi1a * pi1, br1b * pr1 - bi1b * pi1));
                W[ks][2] = __builtin_bit_cast(bf16x8, pg8::pack8(bi0a * pr0 + br0a * pi0, bi0b * pr0 + br0b * pi0));
                W[ks][3] = __builtin_bit_cast(bf16x8, pg8::pack8(bi1a * pr1 + br1a * pi1, bi1b * pr1 + br1b * pi1));
                const float t0 = pr0 * a0.x - pi0 * a0.y, u0 = pr0 * a0.y + pi0 * a0.x, t1 = pr1 * a1.x - pi1 * a1.y, u1 = pr1 * a1.y + pi1 * a1.x; pr0 = t0; pi0 = u0; pr1 = t1; pi1 = u1; }
            qr0 = pr0; qi0 = pi0; nqi0 = -pi0; qr1 = pr1; qi1 = pi1; nqi1 = -pi1; }
        const int nb = bt + c.G;
        if (nb < NT1) { const int nrest = nb >> 3, ntc = nrest % NCH, nbp = nrest / NCH, ng = (nb & 7) * 4 + (c.wave >> 1);
#pragma unroll
            for (int ks = 0; ks < 4; ++ks) afn[ks] = s1_afrag(Z, nbp, ntc, ng, dir, ks, lane); }
        const f32x16 z16 = {0.f, 0.f, 0.f, 0.f, 0.f, 0.f, 0.f, 0.f, 0.f, 0.f, 0.f, 0.f, 0.f, 0.f, 0.f, 0.f};
        f32x16 cr0 = z16, cr1 = z16, ci0 = z16, ci1 = z16;
        __builtin_amdgcn_sched_barrier(0);
#pragma unroll
        for (int ks = 0; ks < 4; ++ks) {
            cr0 = __builtin_amdgcn_mfma_f32_32x32x16_bf16(afc[ks], W[ks][0], cr0, 0, 0, 0);
            cr1 = __builtin_amdgcn_mfma_f32_32x32x16_bf16(afc[ks], W[ks][1], cr1, 0, 0, 0);
            ci0 = __builtin_amdgcn_mfma_f32_32x32x16_bf16(afc[ks], W[ks][2], ci0, 0, 0, 0);
            ci1 = __builtin_amdgcn_mfma_f32_32x32x16_bf16(afc[ks], W[ks][3], ci1, 0, 0, 0); }
        __builtin_amdgcn_sched_barrier(0);
        asm volatile("s_nop 15\n\ts_nop 15" : "+v"(cr0), "+v"(cr1), "+v"(ci0), "+v"(ci1) : "v"(afc[0]), "v"(afc[1]), "v"(afc[2]), "v"(afc[3]));
        __builtin_amdgcn_sched_barrier(0);
        float hr0 = 0.f, hi0 = 0.f, hr1 = 0.f, hi1 = 0.f;
#pragma unroll
        for (int i = 0; i < 16; ++i) {
            const float n0 = fma_v(qr0, hr0, fma_v(nqi0, hi0, cr0[i])), m0 = fma_v(qr0, hi0, fma_v(qi0, hr0, ci0[i]));
            const float n1 = fma_v(qr1, hr1, fma_v(nqi1, hi1, cr1[i])), m1 = fma_v(qr1, hi1, fma_v(qi1, hr1, ci1[i]));
            hr0 = n0; hi0 = m0; hr1 = n1; hi1 = m1; }
#pragma unroll
        for (int ks = 0; ks < 4; ++ks) afc[ks] = afn[ks];
        CAR[car_idx(2 * bp + hh, g, dir, scan_chunk(tc, dir), lane & 31)] = (f32x4){hr0, hi0, hr1, hi1};
    }
}
__device__ __forceinline__ void phase_s12(const Args& a, Ctx& c, int l) {
    const bf16_t* Z = (const bf16_t*)(c.ws + WS_U); f32x4* HIN = (f32x4*)(c.ws + WS_CAR2);
    const f32x2* AB = (const f32x2*)(c.ws + WS_AB); const bf16x8* BF = (const bf16x8*)(c.ws + WS_BF);
    const int lane = c.lane, hh = lane >> 5;
    LAS f32x4* pre = (LAS f32x4*)(c.lds + c.wave * (9 * 1024));
    LAS f32x4* exch = (LAS f32x4*)(c.lds + 8 * 9 * 1024);
    const int s0 = c.wave < 4 ? 9 * c.wave : 36 + 8 * (c.wave - 4), len = c.wave < 4 ? 9 : 8;
    for (int ct = c.bid; ct < 4 * 32 * 2; ct += c.G) {
        const int bp = ct >> 6, g = (ct >> 1) & 31, dir = ct & 1; const int ldg = (l * 2 + dir) * 32 + g;
        bf16x8 W[4][4]; float qr0, qi0, qr1, qi1, nqi0, nqi1;
        {   const f32x2 a0 = AB[ldg * 64 + (lane & 31)], a1 = AB[ldg * 64 + 32 + (lane & 31)];
            u32x4 bw[4];
#pragma unroll
            for (int f = 0; f < 4; ++f) bw[f] = __builtin_bit_cast(u32x4, BF[(ldg * 4 + f) * 64 + lane]);
            f32x4 br0a, br0b, br1a, br1b, bi0a, bi0b, bi1a, bi1b; pg8::unpack8(bw[0], br0a, br0b); pg8::unpack8(bw[1], br1a, br1b); pg8::unpack8(bw[2], bi0a, bi0b); pg8::unpack8(bw[3], bi1a, bi1b);
            float pr0 = 1.f, pi0 = 0.f, pr1 = 1.f, pi1 = 0.f;
#pragma unroll
            for (int ks = 3; ks >= 0; --ks) {
                W[ks][0] = __builtin_bit_cast(bf16x8, pg8::pack8(br0a * pr0 - bi0a * pi0, br0b * pr0 - bi0b * pi0));
                W[ks][1] = __builtin_bit_cast(bf16x8, pg8::pack8(br1a * pr1 - bi1a * pi1, br1b * pr1 - bi1b * pi1));
                W[ks][2] = __builtin_bit_cast(bf16x8, pg8::pack8(bi0a * pr0 + br0a * pi0, bi0b * pr0 + br0b * pi0));
                W[ks][3] = __builtin_bit_cast(bf16x8, pg8::pack8(bi1a * pr1 + br1a * pi1, bi1b * pr1 + br1b * pi1));
                const float t0 = pr0 * a0.x - pi0 * a0.y, u0 = pr0 * a0.y + pi0 * a0.x, t1 = pr1 * a1.x - pi1 * a1.y, u1 = pr1 * a1.y + pi1 * a1.x; pr0 = t0; pi0 = u0; pr1 = t1; pi1 = u1; }
            qr0 = pr0; qi0 = pi0; nqi0 = -pi0; qr1 = pr1; qi1 = pi1; nqi1 = -pi1; }
        bf16x8 afc[4], afn[4];
        { const int cc = s0, tc = dir == 0 ? cc : (cc < 4 ? 3 - cc : 71 - cc);
#pragma unroll
            for (int ks = 0; ks < 4; ++ks) { afc[ks] = s1_afrag(Z, bp, tc, g, dir, ks, lane); afn[ks] = afc[ks]; } }
        float hr0 = 0.f, hi0 = 0.f, hr1 = 0.f, hi1 = 0.f;
        __syncthreads();
#pragma unroll 1
        for (int k = 0; k < len; ++k) {
            if (k + 1 < len) { const int cc = s0 + k + 1, tc = dir == 0 ? cc : (cc < 4 ? 3 - cc : 71 - cc);
#pragma unroll
                for (int ks = 0; ks < 4; ++ks) afn[ks] = s1_afrag(Z, bp, tc, g, dir, ks, lane); }
            const f32x16 z16 = {0.f, 0.f, 0.f, 0.f, 0.f, 0.f, 0.f, 0.f, 0.f, 0.f, 0.f, 0.f, 0.f, 0.f, 0.f, 0.f};
            f32x16 cr0 = z16, cr1 = z16, ci0 = z16, ci1 = z16;
            asm volatile("" : "+v"(cr0), "+v"(cr1), "+v"(ci0), "+v"(ci1));
            __builtin_amdgcn_sched_barrier(0);
#pragma unroll
            for (int ks = 0; ks < 4; ++ks) {
                cr0 = __builtin_amdgcn_mfma_f32_32x32x16_bf16(afc[ks], W[ks][0], cr0, 0, 0, 0);
                cr1 = __builtin_amdgcn_mfma_f32_32x32x16_bf16(afc[ks], W[ks][1], cr1, 0, 0, 0);
                ci0 = __builtin_amdgcn_mfma_f32_32x32x16_bf16(afc[ks], W[ks][2], ci0, 0, 0, 0);
                ci1 = __builtin_amdgcn_mfma_f32_32x32x16_bf16(afc[ks], W[ks][3], ci1, 0, 0, 0); }
            __builtin_amdgcn_sched_barrier(0);
            asm volatile("s_nop 15\n\ts_nop 15" : "+v"(cr0), "+v"(cr1), "+v"(ci0), "+v"(ci1) : "v"(afc[0]), "v"(afc[1]), "v"(afc[2]), "v"(afc[3]));
            __builtin_amdgcn_sched_barrier(0);
            pre[k * 64 + lane] = (f32x4){hr0, hi0, hr1, hi1};
#pragma unroll
            for (int i = 0; i < 16; ++i) {
                const float n0 = fma_v(qr0, hr0, fma_v(nqi0, hi0, cr0[i])), m0 = fma_v(qr0, hi0, fma_v(qi0, hr0, ci0[i]));
                const float n1 = fma_v(qr1, hr1, fma_v(nqi1, hi1, cr1[i])), m1 = fma_v(qr1, hi1, fma_v(qi1, hr1, ci1[i]));
                hr0 = n0; hi0 = m0; hr1 = n1; hi1 = m1; }
#pragma unroll
            for (int ks = 0; ks < 4; ++ks) afc[ks] = afn[ks];
        }
        exch[c.wave * 64 + lane] = (f32x4){hr0, hi0, hr1, hi1};
        float p0r = qr0, p0i = qi0, p1r = qr1, p1i = qi1;
#pragma unroll
        for (int sq = 0; sq < 4; ++sq) { const float t0 = p0r * p0r - p0i * p0i, u0 = 2.0f * p0r * p0i, t1 = p1r * p1r - p1i * p1i, u1 = 2.0f * p1r * p1i; p0r = t0; p0i = u0; p1r = t1; p1i = u1; }
        float e0r = p0r, e0i = p0i, e1r = p1r, e1i = p1i;
#pragma unroll
        for (int sq = 0; sq < 3; ++sq) { const float t0 = e0r * e0r - e0i * e0i, u0 = 2.0f * e0r * e0i, t1 = e1r * e1r - e1i * e1i, u1 = 2.0f * e1r * e1i; e0r = t0; e0i = u0; e1r = t1; e1i = u1; }
        const float n0r = e0r * p0r - e0i * p0i, n0i = e0r * p0i + e0i * p0r, n1r = e1r * p1r - e1i * p1i, n1i = e1r * p1i + e1i * p1r;
        __syncthreads();
        float c0r = 0.f, c0i = 0.f, c1r = 0.f, c1i = 0.f;
        for (int v = 0; v < c.wave; ++v) { const f32x4 e = exch[v * 64 + lane]; const bool nine = v < 4;
            const float m0r = nine ? n0r : e0r, m0i = nine ? n0i : e0i, m1r = nine ? n1r : e1r, m1i = nine ? n1i : e1i;
            const float t0 = m0r * c0r - m0i * c0i + e[0], u0 = m0r * c0i + m0i * c0r + e[1], t1 = m1r * c1r - m1i * c1i + e[2], u1 = m1r * c1i + m1i * c1r + e[3];
            c0r = t0; c0i = u0; c1r = t1; c1i = u1; }
#pragma unroll 1
        for (int k = 0; k < len; ++k) { const f32x4 pv = pre[k * 64 + lane]; const int cc = s0 + k;
            HIN[car_idx(2 * bp + hh, g, dir, cc, lane & 31)] = (f32x4){pv[0] + c0r, pv[1] + c0i, pv[2] + c1r, pv[3] + c1i};
            const float t0 = p0r * c0r - p0i * c0i, u0 = p0r * c0i + p0i * c0r, t1 = p1r * c1r - p1i * c1i, u1 = p1r * c1i + p1i * c1r; c0r = t0; c0i = u0; c1r = t1; c1i = u1; }
    }
    __syncthreads();
}
__device__ __forceinline__ void phase_s2(const Args& a, Ctx& c, int l) {
    if (c.tid >= 128) return;
    for (int gid = c.bid * 128 + c.tid; gid < NB * 32 * 2 * 32 * 2; gid += c.G * 128) {
    const int tile = gid & 1, n = (gid >> 1) & 31, dir = (gid >> 6) & 1, g = (gid >> 7) & 31, b = gid >> 12;
    const f32x2* AB = (const f32x2*)(c.ws + WS_AB); const f32x2* __restrict__ E = (const f32x2*)(c.ws + WS_CAR); f32x2* __restrict__ HIN = (f32x2*)(c.ws + WS_CAR2);
    f32x2 p = AB[((l * 2 + dir) * 32 + g) * 64 + tile * 32 + n];
#pragma unroll
    for (int s = 0; s < 6; ++s) { const float pr = p.x * p.x - p.y * p.y, pi = 2.0f * p.x * p.y; p.x = pr; p.y = pi; }
    float hr = 0.f, hi = 0.f; const size_t base = car_idx(b, g, dir, 0, n) * 2 + tile;
#pragma unroll 1
    for (int c0 = 0; c0 < NCH; c0 += 17) {
        f32x2 e[17];
#pragma unroll
        for (int k = 0; k < 17; ++k) e[k] = E[base + (size_t)(c0 + k) * 64];
#pragma unroll
        for (int k = 0; k < 17; ++k) { HIN[base + (size_t)(c0 + k) * 64] = (f32x2){hr, hi};
            const float nr = p.x * hr - p.y * hi + e[k].x, ni = p.x * hi + p.y * hr + e[k].y; hr = nr; hi = ni; }
    }
    }
}
__device__ __forceinline__ bf16x8 s3_afrag(const bf16_t* Z, int bp, int tc, int g, int dir, int ks, int lane) {
    const int r = lane & 31, sq = (r >> 2) & 1, i = (r & 3) + 4 * (r >> 3), hh = lane >> 5;
    const int ti = dir == 0 ? 4 * i + ks : 4 * i + 3 - ks;
    return *(const bf16x8*)(Z + ((size_t)g * T + tok_row(2 * bp + sq, tc, ti)) * 16 + 8 * hh);
}
constexpr int S3_IMG = 272;
__device__ __forceinline__ constexpr int s3_skip(int dir, int f) { return f == (dir == 0 ? 16 : 17) || f == (dir == 0 ? 22 : 23); }
__device__ __forceinline__ constexpr int s3_pidx(int dir, int f) { return f - (f > (dir == 0 ? 16 : 17) ? 1 : 0) - (f > (dir == 0 ? 22 : 23) ? 1 : 0); }
constexpr int S3_TB = 38 * 1024;
__device__ __forceinline__ void phase_s3(const Args& a, Ctx& c, int l) {
    const bf16_t* Z = (const bf16_t*)(c.ws + WS_U); const f32x4* CAR = (const f32x4*)(c.ws + WS_CAR2); bf16_t* YG = (bf16_t*)(c.ws + WS_YG);
    const f32x2* AB = (const f32x2*)(c.ws + WS_AB); const u32x4* TB = (const u32x4*)(c.ws + WS_S3T);
    const int lane = c.lane, hh = lane >> 5, col = lane & 31;
    LAS unsigned char* tbl = c.lds;
    LAS unsigned char* img = c.lds + (c.wave < 6 ? 2 * S3_TB + c.wave * (32 * S3_IMG) : c.wave == 6 ? MISC_OFF + 1024 : LDS_BYTES - 16384);
    const int tc0 = (l == DEPTH - 1) ? 4 : 0, ntc = NCH - tc0, ncombo = 4 * ntc, ngrp = (ncombo + 7) >> 3;
    int cur_g = -1;
    const f32x16 z16 = {0.f, 0.f, 0.f, 0.f, 0.f, 0.f, 0.f, 0.f, 0.f, 0.f, 0.f, 0.f, 0.f, 0.f, 0.f, 0.f};
    float qq[2][6];
    bf16x8 af[2][4]; f32x4 hc[2];
#pragma unroll
    for (int d = 0; d < 2; ++d) { hc[d] = (f32x4){0.f, 0.f, 0.f, 0.f};
#pragma unroll
        for (int k = 0; k < 6; ++k) qq[d][k] = 0.f;
#pragma unroll
        for (int ks = 0; ks < 4; ++ks) af[d][ks] = (bf16x8){0, 0, 0, 0, 0, 0, 0, 0}; }
    const bool worker = true;
    for (int wt = c.bid; wt < 32 * ngrp; wt += c.G) {
        const int g = ((wt >> 3) & 3) | ((wt & 7) << 2), grp = wt >> 5;
        if (g != cur_g) { cur_g = g; __syncthreads();
            for (int i = c.tid; i < 2 * 40 * 64; i += NTHREADS) { const int d = i / 2560, r = i - d * 2560, f = r >> 6; if (!s3_skip(d, f)) *(LAS u32x4*)(tbl + d * S3_TB + (s3_pidx(d, f) * 64 + (r & 63)) * 16) = TB[(size_t)((l * 2 + d) * 32 + g) * 2560 + r]; }
#pragma unroll
            for (int d = 0; d < 2; ++d) { const int ldg = (l * 2 + d) * 32 + g; const f32x2 a0 = AB[ldg * 64 + col], a1 = AB[ldg * 64 + 32 + col];
                const float s0r = a0.x * a0.x - a0.y * a0.y, s0i = 2.0f * a0.x * a0.y, s1r = a1.x * a1.x - a1.y * a1.y, s1i = 2.0f * a1.x * a1.y;
                qq[d][0] = s0r * s0r - s0i * s0i; qq[d][1] = 2.0f * s0r * s0i; qq[d][2] = -qq[d][1]; qq[d][3] = s1r * s1r - s1i * s1i; qq[d][4] = 2.0f * s1r * s1i; qq[d][5] = -qq[d][4]; }
            __syncthreads(); }
        const int combo = grp * 8 + c.wave;
        if (worker && combo < ncombo) {
            const int tc = tc0 + combo % ntc, bp = combo / ntc;
#pragma unroll
            for (int d = 0; d < 2; ++d) hc[d] = CAR[car_idx(2 * bp + hh, g, d, scan_chunk(tc, d), col)];
#pragma unroll
            for (int ks = 0; ks < 4; ++ks) af[0][ks] = s3_afrag(Z, bp, tc, g, 0, ks, lane);
            f32x16 y0 = z16, y1 = z16;
            asm volatile("" : "+v"(y0), "+v"(y1));
#pragma unroll
            for (int dir = 0; dir < 2; ++dir) {
                const LAS unsigned char* tb = tbl + dir * S3_TB + lane * 16;
                if (dir == 1) {
#pragma unroll
                    for (int ks = 0; ks < 2; ++ks) { const bf16x8 t = af[0][ks]; af[0][ks] = af[0][3 - ks]; af[0][3 - ks] = t; } }
                const f32x4 h0 = hc[dir];
                f32x16 cr0 = z16, cr1 = z16, ci0 = z16, ci1 = z16;
                asm volatile("" : "+v"(cr0), "+v"(cr1), "+v"(ci0), "+v"(ci1));
                __builtin_amdgcn_sched_barrier(0);
                {
                    bf16x8 bq[2][6];
#pragma unroll
                    for (int nb = 0; nb < 6; ++nb) bq[0][nb] = *(const LAS bf16x8*)(tb + s3_pidx(dir, nb) * 1024);
#pragma unroll
                    for (int ks = 0; ks < 4; ++ks) {
                        if (ks < 3) {
#pragma unroll
                            for (int nb = 0; nb < 6; ++nb) if (!s3_skip(dir, (ks + 1) * 6 + nb)) bq[(ks + 1) & 1][nb] = *(const LAS bf16x8*)(tb + s3_pidx(dir, (ks + 1) * 6 + nb) * 1024); }
                        __builtin_amdgcn_sched_barrier(0);
                        cr0 = __builtin_amdgcn_mfma_f32_32x32x16_bf16(af[0][ks], bq[ks & 1][0], cr0, 0, 0, 0); cr1 = __builtin_amdgcn_mfma_f32_32x32x16_bf16(af[0][ks], bq[ks & 1][1], cr1, 0, 0, 0);
                        ci0 = __builtin_amdgcn_mfma_f32_32x32x16_bf16(af[0][ks], bq[ks & 1][2], ci0, 0, 0, 0); ci1 = __builtin_amdgcn_mfma_f32_32x32x16_bf16(af[0][ks], bq[ks & 1][3], ci1, 0, 0, 0);
                        if (!s3_skip(dir, ks * 6 + 4)) y0 = __builtin_amdgcn_mfma_f32_32x32x16_bf16(af[0][ks], bq[ks & 1][4], y0, 0, 0, 0);
                        if (!s3_skip(dir, ks * 6 + 5)) y1 = __builtin_amdgcn_mfma_f32_32x32x16_bf16(af[0][ks], bq[ks & 1][5], y1, 0, 0, 0);
                        __builtin_amdgcn_sched_barrier(0); } }
                __builtin_amdgcn_sched_barrier(0);
                asm volatile("s_nop 15\n\ts_nop 15" : "+v"(cr0), "+v"(cr1), "+v"(ci0), "+v"(ci1) : "v"(af[0][0]), "v"(af[0][1]), "v"(af[0][2]), "v"(af[0][3]));
                __builtin_amdgcn_sched_barrier(0);
                const float q0r = qq[dir][0], q0i = qq[dir][1], nq0i = qq[dir][2], q1r = qq[dir][3], q1i = qq[dir][4], nq1i = qq[dir][5];
                float hr0 = h0[0], hi0 = h0[1], hr1 = h0[2], hi1 = h0[3];
#pragma unroll
                for (int be = 0; be < 16; ++be) { const int i = dir == 0 ? be : 15 - be; const int rho = (i & 3) + 4 * hh + 8 * (i >> 2);
                    *(LAS unsigned*)(img + rho * S3_IMG + 4 * col) = pk2(hr0, hi0); *(LAS unsigned*)(img + rho * S3_IMG + 128 + 4 * col) = pk2(hr1, hi1);
                    const float n0 = fma_v(q0r, hr0, fma_v(nq0i, hi0, cr0[i])), m0 = fma_v(q0r, hi0, fma_v(q0i, hr0, ci0[i]));
                    const float n1 = fma_v(q1r, hr1, fma_v(nq1i, hi1, cr1[i])), m1 = fma_v(q1r, hi1, fma_v(q1i, hr1, ci1[i]));
                    hr0 = n0; hi0 = m0; hr1 = n1; hi1 = m1; }
                asm volatile("" ::: "memory");
                {
                    bf16x8 hq[2][2][3];
#pragma unroll
                    for (int e = 0; e < 2; ++e) { hq[0][e][0] = *(const LAS bf16x8*)(img + col * S3_IMG + 32 * e + 16 * hh); hq[0][e][1] = *(const LAS bf16x8*)(tb + (22 + 2 * e) * 1024); hq[0][e][2] = *(const LAS bf16x8*)(tb + (23 + 2 * e) * 1024); }
#pragma unroll
                    for (int k2 = 0; k2 < 4; ++k2) {
                        if (k2 < 3) {
#pragma unroll
                            for (int e = 0; e < 2; ++e) { const int kk = 2 * (k2 + 1) + e; hq[(k2 + 1) & 1][e][0] = *(const LAS bf16x8*)(img + col * S3_IMG + 32 * kk + 16 * hh);
                                hq[(k2 + 1) & 1][e][1] = *(const LAS bf16x8*)(tb + (22 + 2 * kk) * 1024); hq[(k2 + 1) & 1][e][2] = *(const LAS bf16x8*)(tb + (23 + 2 * kk) * 1024); } }
                        __builtin_amdgcn_sched_barrier(0);
#pragma unroll
                        for (int e = 0; e < 2; ++e) { y0 = __builtin_amdgcn_mfma_f32_32x32x16_bf16(hq[k2 & 1][e][0], hq[k2 & 1][e][1], y0, 0, 0, 0); y1 = __builtin_amdgcn_mfma_f32_32x32x16_bf16(hq[k2 & 1][e][0], hq[k2 & 1][e][2], y1, 0, 0, 0); }
                        __builtin_amdgcn_sched_barrier(0); } }
                asm volatile("" ::: "memory");
            }
            __builtin_amdgcn_sched_barrier(0);
            asm volatile("s_nop 15\n\ts_nop 15" : "+v"(y0), "+v"(y1));
            __builtin_amdgcn_sched_barrier(0);
#pragma unroll
            for (int nb = 0; nb < 2; ++nb)
#pragma unroll
                for (int i = 0; i < 16; ++i) { const float v = gelu_t(nb == 0 ? y0[i] : y1[i]);
                    const int tok = 4 * i + 2 * nb + (col >> 4);
                    *(LAS bf16_t*)(img + ((hh * 64 + tok) * 16 + (col & 15)) * 2) = (bf16_t)(pk2(v, v) & 0xffffu); }
            asm volatile("" ::: "memory");
#pragma unroll
            for (int k = 0; k < 4; ++k) { const int chunk = lane + 64 * k, row = chunk >> 1, half = chunk & 1;
                const u32x4 w = *(const LAS u32x4*)(img + chunk * 16);
                *(u32x4*)(YG + ((size_t)g * T + tok_row(2 * bp + (row >> 6), tc, row & 63)) * 16 + 8 * half) = w; }
            asm volatile("" ::: "memory");
        }
    }
    __syncthreads();
}

__device__ __forceinline__ void acc8(float (&s)[8], u32x4 w) { s[0] += bflo(w.x); s[1] += bfhi(w.x); s[2] += bflo(w.y); s[3] += bfhi(w.y); s[4] += bflo(w.z); s[5] += bfhi(w.z); s[6] += bflo(w.w); s[7] += bfhi(w.w); }
__device__ __forceinline__ void sub8(float (&s)[8], u32x4 w) { s[0] -= bflo(w.x); s[1] -= bfhi(w.x); s[2] -= bflo(w.y); s[3] -= bfhi(w.y); s[4] -= bflo(w.z); s[5] -= bfhi(w.z); s[6] -= bflo(w.w); s[7] -= bfhi(w.w); }
constexpr int POOL_TASKS = NB * 8 * 4 * 2;
constexpr int PV_CSTR = 144, PV_RSTR = 64 * PV_CSTR;
__device__ __forceinline__ void phase_pool(Ctx& c, const int wi, const int nw, const int t0, const int t1, const bool ctx) {
    const bf16_t* Z = (const bf16_t*)(c.ws + WS_Z); bf16_t* PD = (bf16_t*)(c.ws + WS_H);
    LAS unsigned char* V = c.lds;
    __syncthreads();
    for (int task = t0 + wi; task < t1; task += nw) {
        const int half = task & 1, g = (task >> 1) & 3, band = (task >> 3) & 7, b = task >> 6, hw = 1 << g, r0 = band * 8;
        const int ck = c.tid & 7, chn = 128 * g + 64 * half + 8 * ck;
        {
            const int cc = c.tid >> 3; const bf16_t* base = Z + (size_t)(b * SEQ + cc) * NZ + chn; const size_t rstep = (size_t)64 * NZ;
            float sm[8];
#pragma unroll
            for (int j = 0; j < 8; ++j) sm[j] = 0.f;
            const int lo0 = r0 - hw < 0 ? 0 : r0 - hw, hi0 = r0 + hw > 64 ? 64 : r0 + hw;
            const u32x4 zz = {0u, 0u, 0u, 0u};
            u32x4 wi[16], wa[7], wb[7];
#pragma unroll
            for (int j = 0; j < 16; ++j) { const int rr = lo0 + j < hi0 ? lo0 + j : hi0 - 1; wi[j] = *(const u32x4*)(base + (size_t)rr * rstep); }
#pragma unroll
            for (int i = 1; i < 8; ++i) { const int ra = r0 + i + hw - 1 < 64 ? r0 + i + hw - 1 : 63, rs = r0 + i - hw - 1 >= 0 ? r0 + i - hw - 1 : 0;
                wa[i - 1] = *(const u32x4*)(base + (size_t)ra * rstep); wb[i - 1] = *(const u32x4*)(base + (size_t)rs * rstep); }
            __builtin_amdgcn_sched_barrier(0);
#pragma unroll
            for (int j = 0; j < 16; ++j) acc8(sm, lo0 + j < hi0 ? wi[j] : zz);
#pragma unroll
            for (int i = 0; i < 8; ++i) { const int r = r0 + i;
                if (i > 0) { acc8(sm, r + hw - 1 < 64 ? wa[i - 1] : zz); sub8(sm, r - hw - 1 >= 0 ? wb[i - 1] : zz); }
                const int lo = r - hw < 0 ? 0 : r - hw, hi = r + hw > 64 ? 64 : r + hw; const float inv = 1.0f / (float)(hi - lo);
                u32x4 o; o.x = pk2(sm[0] * inv, sm[1] * inv); o.y = pk2(sm[2] * inv, sm[3] * inv); o.z = pk2(sm[4] * inv, sm[5] * inv); o.w = pk2(sm[6] * inv, sm[7] * inv);
                *(LAS u32x4*)(V + i * PV_RSTR + cc * PV_CSTR + ck * 16) = o; }
        }
        __syncthreads();
        {
            const int cseg = (c.tid >> 3) & 7, i = c.tid >> 6, c0 = cseg * 8, r = r0 + i; const LAS unsigned char* vrow = V + i * PV_RSTR + ck * 16;
            float sm[8];
#pragma unroll
            for (int j = 0; j < 8; ++j) sm[j] = 0.f;
            const int lo0 = c0 - hw < 0 ? 0 : c0 - hw, hi0 = c0 + hw > 64 ? 64 : c0 + hw;
            for (int cc = lo0; cc < hi0; ++cc) acc8(sm, *(const LAS u32x4*)(vrow + cc * PV_CSTR));
            const size_t tok0 = (size_t)b * SEQ + r * 64 + c0;
            u32x4 vv[8];
#pragma unroll
            for (int st = 0; st < 8; ++st) vv[st] = *(const u32x4*)(Z + (tok0 + st) * NZ + chn);
#pragma unroll
            for (int st = 0; st < 8; ++st) { const int cc = c0 + st;
                if (st > 0) { if (cc + hw - 1 < 64) acc8(sm, *(const LAS u32x4*)(vrow + (cc + hw - 1) * PV_CSTR)); if (cc - hw - 1 >= 0) sub8(sm, *(const LAS u32x4*)(vrow + (cc - hw - 1) * PV_CSTR)); }
                const int lo = cc - hw < 0 ? 0 : cc - hw, hi = cc + hw > 64 ? 64 : cc + hw; const float inv = 1.0f / (float)(hi - lo); const u32x4 v0 = vv[st];
                u32x4 o; o.x = pk2(sm[0] * inv - bflo(v0.x), sm[1] * inv - bfhi(v0.x)); o.y = pk2(sm[2] * inv - bflo(v0.y), sm[3] * inv - bfhi(v0.y));
                o.z = pk2(sm[4] * inv - bflo(v0.z), sm[5] * inv - bfhi(v0.z)); o.w = pk2(sm[6] * inv - bflo(v0.w), sm[7] * inv - bfhi(v0.w));
                *(u32x4*)(PD + (tok0 + st) * 512 + chn) = o; }
        }
        __syncthreads();
    }
    if (!ctx) return;
    const int gw = wi * NWAVES + c.wave, NGW = nw * NWAVES;
    for (int it = gw; it < (TC / 4) * 4; it += NGW) {
        const int g = it & 3, row = TL + (it >> 2) * 4 + (c.lane >> 4), ck = c.lane & 15, w = 2 << g;
        const int pos = (row - TL) & 255, n = 256;
        const bf16_t* src = Z + (size_t)(row - pos) * NZ + 128 * g + 8 * ck;
        const int lo = pos - w / 2 < 0 ? 0 : pos - w / 2, hi = pos + w / 2 > n ? n : pos + w / 2;
        float sm[8];
#pragma unroll
        for (int j = 0; j < 8; ++j) sm[j] = 0.f;
        { const u32x4 zz = {0u, 0u, 0u, 0u}; u32x4 wv[16];
#pragma unroll
            for (int k = 0; k < 16; ++k) { const int p = pos - w / 2 + k; const int pc = p < 0 ? 0 : (p > n - 1 ? n - 1 : p); wv[k] = *(const u32x4*)(src + (size_t)pc * NZ); }
            __builtin_amdgcn_sched_barrier(0);
#pragma unroll
            for (int k = 0; k < 16; ++k) { const int p = pos - w / 2 + k; acc8(sm, (k < w && p >= 0 && p < n) ? wv[k] : zz); } }
        const float inv = 1.0f / (float)(hi - lo);
        const u32x4 vv = *(const u32x4*)(Z + (size_t)row * NZ + 128 * g + 8 * ck);
        u32x4 o; o.x = pk2(sm[0] * inv - bflo(vv.x), sm[1] * inv - bfhi(vv.x)); o.y = pk2(sm[2] * inv - bflo(vv.y), sm[3] * inv - bfhi(vv.y));
        o.z = pk2(sm[4] * inv - bflo(vv.z), sm[5] * inv - bfhi(vv.z)); o.w = pk2(sm[6] * inv - bflo(vv.w), sm[7] * inv - bfhi(vv.w));
        *(u32x4*)(PD + (size_t)row * 512 + 128 * g + 8 * ck) = o;
    }
}

__device__ __forceinline__ void phase_i(const Args& a, Ctx& c, int l, const bool dummy = false) {
    LAS u32x4* bh = (LAS u32x4*)c.lds; LAS u32x4* bl = bh + 2048;
    for (int i = c.tid; i < 2048; i += NTHREADS) { const int st = i >> 6, ln = i & 63, n = ln & 15, q = ln >> 4; const float* rp = a.in(24) + (size_t)(32 * st + 8 * q) * 16 + n;
        unsigned hi[4], lo[4];
#pragma unroll
        for (int e = 0; e < 4; ++e) { const float v0 = rp[(2 * e) * 16], v1 = rp[(2 * e + 1) * 16]; const unsigned h2 = pk2(v0, v1); hi[e] = h2; lo[e] = pk2(v0 - bflo(h2), v1 - bfhi(h2)); }
        bh[i] = (u32x4){hi[0], hi[1], hi[2], hi[3]}; bl[i] = (u32x4){lo[0], lo[1], lo[2], lo[3]}; }
    volatile LAS int* bcnt = c.misc + 64; volatile LAS int* bbase = c.misc + 80; LAS float* lgt = (LAS float*)(c.lds + 65536);
    if (c.tid < 16) bcnt[c.tid] = 0;
    const int Te = l == DEPTH - 1 ? TL : T;
    const int rpb = (Te + c.G - 1) / c.G, r0 = c.bid * rpb, nrows = (r0 + rpb <= Te) ? rpb : (Te - r0 > 0 ? Te - r0 : 0);
    LAS float* par = (LAS float*)(c.lds + 81920); const int b0 = brow_of(r0);
    for (int i = c.tid; i < 2 * D; i += NTHREADS) { const int bb = i >> 10, col = i & (D - 1), bt = b0 + bb < 8 ? b0 + bb : 8;
        const float* md = (const float*)(c.ws + WS_MODS) + ((size_t)l * 9 + bt) * NMOD + 3 * D;
        par[bb * 2 * D + col] = a.in(7)[(size_t)l * D + col] * (1.0f + md[D + col]); par[bb * 2 * D + D + col] = md[col]; }
    __syncthreads();
    bf16_t* H = (bf16_t*)(c.ws + WS_H); float* GW = (float*)(c.ws + WS_GW);
    const bf16_t* XB = (const bf16_t*)(c.ws + WS_XB);
    const int m = c.lane & 15, q = c.lane >> 4;
    for (int tile = c.wave; tile * 16 < nrows; tile += NWAVES) {
        const int rowl = tile * 16 + m; const bool valid = rowl < nrows; const int row = r0 + (valid ? rowl : nrows - 1);
        const bf16_t* xb = XB + (size_t)row * D + 8 * q;
        u32x4 w[32];
#pragma unroll
        for (int st = 0; st < 32; ++st) w[st] = *(const u32x4*)(xb + 32 * st);
        __builtin_amdgcn_sched_barrier(0);
        float ss = 0.f;
#pragma unroll
        for (int st = 0; st < 32; ++st) { const float x0 = bflo(w[st].x), x1 = bfhi(w[st].x), x2 = bflo(w[st].y), x3 = bfhi(w[st].y), x4 = bflo(w[st].z), x5 = bfhi(w[st].z), x6 = bflo(w[st].w), x7 = bfhi(w[st].w);
            ss += (x0 * x0 + x1 * x1) + (x2 * x2 + x3 * x3) + (x4 * x4 + x5 * x5) + (x6 * x6 + x7 * x7);
            if ((st & 3) == 3) __builtin_amdgcn_sched_barrier(0); }
        ss += shflx(ss, 16, c.lane); ss += shflx(ss, 32, c.lane);
#pragma unroll
        for (int st = 0; st < 32; ++st) asm volatile("" : "+v"(w[st].x), "+v"(w[st].y), "+v"(w[st].z), "+v"(w[st].w));
        const float rstd = 1.0f / sqrtf(ss * (1.0f / D) + RMS_EPS);
        const LAS float* pa = par + (brow_of(row) - b0) * 2 * D + 8 * q;
        bf16_t* hrow = H + (size_t)row * D + 8 * q;
        f32x4 acc = {0.f, 0.f, 0.f, 0.f};
#pragma unroll
        for (int st = 0; st < 32; ++st) {
            const int co = 32 * st;
            const f32x4 g0 = *(const LAS f32x4*)(pa + co), g1 = *(const LAS f32x4*)(pa + co + 4), s0 = *(const LAS f32x4*)(pa + D + co), s1 = *(const LAS f32x4*)(pa + D + co + 4);
            const f32x4 xa = {bflo(w[st].x), bfhi(w[st].x), bflo(w[st].y), bfhi(w[st].y)}, xc = {bflo(w[st].z), bfhi(w[st].z), bflo(w[st].w), bfhi(w[st].w)};
            const f32x4 ha = xa * rstd * g0 + s0, hc = xc * rstd * g1 + s1;
            u32x4 hi4; hi4.x = pk2(ha[0], ha[1]); hi4.y = pk2(ha[2], ha[3]); hi4.z = pk2(hc[0], hc[1]); hi4.w = pk2(hc[2], hc[3]);
            u32x4 lo4; lo4.x = pk2(ha[0] - bflo(hi4.x), ha[1] - bfhi(hi4.x)); lo4.y = pk2(ha[2] - bflo(hi4.y), ha[3] - bfhi(hi4.y));
            lo4.z = pk2(hc[0] - bflo(hi4.z), hc[1] - bfhi(hi4.z)); lo4.w = pk2(hc[2] - bflo(hi4.w), hc[3] - bfhi(hi4.w));
            if (valid) *(u32x4*)(hrow + co) = hi4;
            const bf16x8 ahi = __builtin_bit_cast(bf16x8, hi4), alo = __builtin_bit_cast(bf16x8, lo4);
            const bf16x8 bhi = __builtin_bit_cast(bf16x8, bh[st * 64 + c.lane]), blo = __builtin_bit_cast(bf16x8, bl[st * 64 + c.lane]);
            acc = __builtin_amdgcn_mfma_f32_16x16x32_bf16(ahi, bhi, acc, 0, 0, 0);
            acc = __builtin_amdgcn_mfma_f32_16x16x32_bf16(alo, bhi, acc, 0, 0, 0);
            acc = __builtin_amdgcn_mfma_f32_16x16x32_bf16(ahi, blo, acc, 0, 0, 0);
            __builtin_amdgcn_sched_barrier(0);
        }
#pragma unroll
        for (int j = 0; j < 4; ++j) lgt[(tile * 16 + 4 * q + j) * 16 + m] = acc[j];
    }
    __syncthreads();
    int e1 = 0, e2 = 0, p1 = 0, p2 = 0; const int myrow = c.tid;
    if (myrow < nrows) {
        float rb[16]; { const float* rbp = a.in(25);
#pragma unroll
            for (int q4 = 0; q4 < 4; ++q4) { const f32x4 r4 = *(const f32x4*)(rbp + 4 * q4); rb[4 * q4] = r4[0]; rb[4 * q4 + 1] = r4[1]; rb[4 * q4 + 2] = r4[2]; rb[4 * q4 + 3] = r4[3]; } }
        float sc[16], bi[16];
#pragma unroll
        for (int q4 = 0; q4 < 4; ++q4) { const f32x4 l4 = *(const LAS f32x4*)(lgt + myrow * 16 + q4 * 4);
#pragma unroll
            for (int k = 0; k < 4; ++k) { sc[q4 * 4 + k] = sigm(l4[k]); bi[q4 * 4 + k] = sc[q4 * 4 + k] + rb[q4 * 4 + k]; } }
        float gs[4];
#pragma unroll
        for (int gq = 0; gq < 4; ++gq) { const float x0 = bi[4 * gq], x1 = bi[4 * gq + 1], x2 = bi[4 * gq + 2], x3 = bi[4 * gq + 3];
            const float h1 = fmaxf(x0, x1), l1 = fminf(x0, x1), h2 = fmaxf(x2, x3), l2 = fminf(x2, x3);
            gs[gq] = fmaxf(h1, h2) + fmaxf(fminf(h1, h2), fmaxf(l1, l2)); }
        int bg = 0; float best = gs[0];
#pragma unroll
        for (int gq = 1; gq < 4; ++gq) if (gs[gq] > best) { best = gs[gq]; bg = gq; }
        float vb[4], vs[4];
#pragma unroll
        for (int i = 0; i < 4; ++i) { vb[i] = bg == 0 ? bi[i] : bg == 1 ? bi[4 + i] : bg == 2 ? bi[8 + i] : bi[12 + i]; vs[i] = bg == 0 ? sc[i] : bg == 1 ? sc[4 + i] : bg == 2 ? sc[8 + i] : sc[12 + i]; }
        int i1 = 0; float m1 = vb[0];
#pragma unroll
        for (int i = 1; i < 4; ++i) if (vb[i] > m1) { m1 = vb[i]; i1 = i; }
        int i2 = -1; float m2 = 0.f;
#pragma unroll
        for (int i = 0; i < 4; ++i) if (i != i1 && (i2 < 0 || vb[i] > m2)) { m2 = vb[i]; i2 = i; }
        const float s1 = i1 == 0 ? vs[0] : i1 == 1 ? vs[1] : i1 == 2 ? vs[2] : vs[3], s2 = i2 == 0 ? vs[0] : i2 == 1 ? vs[1] : i2 == 2 ? vs[2] : vs[3];
        const float inv = 1.0f / (s1 + s2);
        e1 = bg * 4 + i1; e2 = bg * 4 + i2;
        p1 = __hip_atomic_fetch_add((LAS int*)(bcnt + e1), 1, __ATOMIC_RELAXED, __HIP_MEMORY_SCOPE_WORKGROUP);
        p2 = __hip_atomic_fetch_add((LAS int*)(bcnt + e2), 1, __ATOMIC_RELAXED, __HIP_MEMORY_SCOPE_WORKGROUP);
        GW[(size_t)(r0 + myrow) * 2] = s1 * inv; GW[(size_t)(r0 + myrow) * 2 + 1] = s2 * inv;
    }
    __syncthreads();
    unsigned* cntw = (unsigned*)(c.ws + WS_CTL) + CW_CNT + (dummy ? l + 4 : l) * 1024;
    if (c.tid < 16) bbase[c.tid] = (int)__hip_atomic_fetch_add(cntw + c.tid * 64, (unsigned)bcnt[c.tid], __ATOMIC_RELAXED, __HIP_MEMORY_SCOPE_AGENT);
    __syncthreads();
    int* list = (int*)(c.ws + (dummy ? WS_HMID : WS_LIST));
    if (myrow < nrows) { const int row = r0 + myrow; list[(size_t)e1 * LCAP + bbase[e1] + p1] = row * 2; list[(size_t)e2 * LCAP + bbase[e2] + p2] = row * 2 + 1; }
}
__device__ __forceinline__ void moe_setup(Ctx& c, int l) {
    const unsigned* cntw = (const unsigned*)(c.ws + WS_CTL) + CW_CNT + l * 1024;
    if (c.tid < NE) c.misc[48 + c.tid] = (int)__hip_atomic_load(cntw + c.tid * 64, __ATOMIC_RELAXED, __HIP_MEMORY_SCOPE_AGENT);
    __syncthreads();
    if (c.tid == 0) { int cum = 0;
        for (int e = 0; e < NE; ++e) { c.misc[16 + e] = cum; cum += (c.misc[48 + e] + 255) >> 8; }
        c.misc[16 + NE] = cum; }
    __syncthreads();
}

struct FinRow { u32x4 x[2], s0[2], s1[2]; f32x4 g[4]; };
__device__ __forceinline__ void fin_load(FinRow& r, const bf16_t* XB, const bf16_t* SL, const float* G2, int row, int lane) {
#pragma unroll
    for (int k = 0; k < 2; ++k) { const int col = 8 * lane + 512 * k; r.x[k] = *(const u32x4*)(XB + (size_t)row * D + col); r.s0[k] = *(const u32x4*)(SL + (size_t)row * 2 * D + col); r.s1[k] = *(const u32x4*)(SL + (size_t)row * 2 * D + D + col); }
#pragma unroll
    for (int j = 0; j < 4; ++j) r.g[j] = *(const f32x4*)(G2 + (size_t)(row >> 12) * NMOD + ncol(lane, j));
}
__device__ __forceinline__ void fin_row(const FinRow& r, const f32x4 (&fg)[4], float* outp, int row, int lane) {
    f32x4 v[4]; float s = 0.f;
#pragma unroll
    for (int k = 0; k < 2; ++k) { f32x4 xa, xc, sa, sc, ta, tc2; pg8::unpack8(r.x[k], xa, xc); pg8::unpack8(r.s0[k], sa, sc); pg8::unpack8(r.s1[k], ta, tc2);
        v[2 * k] = xa + r.g[2 * k] * (sa + ta); v[2 * k + 1] = xc + r.g[2 * k + 1] * (sc + tc2); }
#pragma unroll
    for (int j = 0; j < 4; ++j) s += (v[j][0] * v[j][0] + v[j][1] * v[j][1]) + (v[j][2] * v[j][2] + v[j][3] * v[j][3]);
    const float rstd = 1.0f / sqrtf(wave_sum(s, lane) * (1.0f / D) + RMS_EPS);
#pragma unroll
    for (int j = 0; j < 4; ++j) *(f32x4*)(outp + (size_t)row * D + ncol(lane, j)) = v[j] * rstd * fg[j];
}
__device__ __forceinline__ void phase_fin(const Args& a, Ctx& c) {
    const int gw = c.bid * NWAVES + c.wave, NGW = c.G * NWAVES;
    const bf16_t* XB = (const bf16_t*)(c.ws + WS_XB); const bf16_t* SL = (const bf16_t*)(c.ws + WS_Z); const float* G2 = (const float*)(c.ws + WS_MODS) + (size_t)(DEPTH - 1) * 9 * NMOD + 5 * D;
    f32x4 fg[4];
#pragma unroll
    for (int j = 0; j < 4; ++j) fg[j] = *(const f32x4*)(a.in(29) + ncol(c.lane, j));
    float* outp = a.out();
    FinRow ra, rb;
    if (gw < TL) fin_load(ra, XB, SL, G2, gw, c.lane);
    for (int row = gw; row < TL; row += 2 * NGW) {
        const bool hb = row + NGW < TL;
        if (hb) fin_load(rb, XB, SL, G2, row + NGW, c.lane);
        fin_row(ra, fg, outp, row, c.lane);
        if (row + 2 * NGW < TL) fin_load(ra, XB, SL, G2, row + 2 * NGW, c.lane);
        if (hb) fin_row(rb, fg, outp, row + NGW, c.lane);
    }
}

constexpr int STEPS_PER_LAYER = 11, NSTEPS = 1 + DEPTH * STEPS_PER_LAYER + 1;
__device__ __forceinline__ Ctx mkctx(LAS unsigned char* lds, const Args& a, const int wv) {
    unsigned lb = (unsigned)(unsigned long long)lds; asm volatile("" : "+s"(lb));
    Ctx c; c.lds = (LAS unsigned char*)lb; c.misc = (volatile LAS int*)(c.lds + MISC_OFF);
    int g = gridDim.x, b = blockIdx.x; asm volatile("" : "+s"(g), "+s"(b));
    c.wave = wv; c.lane = lane_id_v(); c.tid = wv * 64 + c.lane; c.G = g; c.bid = b; c.ws = a.ws();
    return c;
}
__global__ void __launch_bounds__(NTHREADS, 2) mk_fwd(KArgs ka) {
    extern __shared__ __attribute__((aligned(16))) unsigned char lds_raw[];
    LAS unsigned char* lds = (LAS unsigned char*)lds_raw;
    volatile LAS int* misc = (volatile LAS int*)(lds + MISC_OFF);
#if (MK_DIAG_ZERO & 1)
    for (int i = MISC_OFF / 4 + threadIdx.x; i < LDS_BYTES / 4; i += NTHREADS) ((volatile LAS int*)lds)[i] = 0x7fc12345;
    __syncthreads();
#endif
    if (threadIdx.x < 16) misc[threadIdx.x] = 0;
    if ((threadIdx.x & 63) == 0) misc[WTAB + hw_key()] = (int)(threadIdx.x >> 6);
    if (threadIdx.x == 64) {
#pragma unroll
        for (int k = 0; k < 30; ++k) { const unsigned long long p = (unsigned long long)ka.in[k]; misc[PTAB + 2 * k] = (int)(unsigned)p; misc[PTAB + 2 * k + 1] = (int)(unsigned)(p >> 32); }
        { const unsigned long long p = (unsigned long long)ka.out; misc[PTAB + 60] = (int)(unsigned)p; misc[PTAB + 61] = (int)(unsigned)(p >> 32); }
        { const unsigned long long p = (unsigned long long)ka.ws; misc[PTAB + 62] = (int)(unsigned)p; misc[PTAB + 63] = (int)(unsigned)(p >> 32); }
        misc[PTAB + 64] = ka.lo; misc[PTAB + 65] = ka.hi;
    }
    __syncthreads();
    Args a; a.tab = misc + PTAB;
    int wv = __builtin_amdgcn_readfirstlane((int)(threadIdx.x >> 6)); asm volatile("" : "+s"(wv));
    const int lo = __builtin_amdgcn_readfirstlane(misc[PTAB + 64]), hi = __builtin_amdgcn_readfirstlane(misc[PTAB + 65]);
    XcdBarrier bar; bar.bar = (unsigned*)(a.ws() + WS_CTL) + CW_BAR; bar.x = 0; bar.st = (volatile LAS unsigned*)misc;
    if (hi - lo > 1) bar = xcd_barrier_post((unsigned*)(a.ws() + WS_CTL) + CW_BAR, (volatile LAS unsigned*)misc);
#define IN(s) (lo <= (s) && (s) < hi)
#define SEAM(s) do { if (IN(s) && IN((s) + 1)) { bar.bar = (unsigned*)(a.ws() + WS_CTL) + CW_BAR; xcd_barrier(bar, wv * 64 + lane_id_v()); } } while (0)
    if (IN(0)) { Ctx c = mkctx(lds, a, wv); phase_p0(a, c); __syncthreads(); tr_range(a, c, 0, 0, TR_NITEMS, c.bid * NWAVES + c.wave, c.G * NWAVES);
        if (MK_DBL & 1) { __syncthreads(); phase_p0(a, c); __syncthreads(); tr_range(a, c, 0, 0, TR_NITEMS, c.bid * NWAVES + c.wave, c.G * NWAVES); } } SEAM(0);
    for (int l = 0; l < DEPTH; ++l) {
        const int sb = 1 + l * STEPS_PER_LAYER;
        if (IN(sb + 0)) { Ctx c = mkctx(lds, a, wv); if (MK_DBL & (1 << 11)) { phase_a(a, c, l, true); __syncthreads(); } phase_a(a, c, l); } SEAM(sb + 0);
        if (IN(sb + 1)) {
            Ctx c = mkctx(lds, a, wv);
            pg8::StaticOrder S; S.init(T, NZ, c.G, c.bid); pg8::EpiIn E{(bf16_t*)(c.ws + WS_Z), (bf16_t*)(c.ws + WS_U)};
            pg8::gemm_phase<pg8::EpiIn, pg8::StaticOrder, false>(c.lds, c.tid, (const bf16_t*)(c.ws + WS_H), (const bf16_t*)(c.ws + wbuf_off(l) + WO_WIN), D, S, E);
            if (MK_DBL & (1 << 1)) { __syncthreads(); pg8::gemm_phase<pg8::EpiIn, pg8::StaticOrder, false>(c.lds, c.tid, (const bf16_t*)(c.ws + WS_H), (const bf16_t*)(c.ws + wbuf_off(l) + WO_WIN), D, S, E); }
            { const int tail0 = S.nwg % c.G; if (l + 1 < DEPTH && tail0 != 0 && c.bid >= tail0) tr_range(a, c, l + 1, 0, TR_SPLIT, (c.bid - tail0) * NWAVES + c.wave, (c.G - tail0) * NWAVES);
                if (l == 0) { Ctx c2 = mkctx(lds, a, wv); if (tail0 == 0) s3_tables(a, c2, c2.bid, c2.G); else if (c2.bid >= tail0) s3_tables(a, c2, c2.bid - tail0, c2.G - tail0); } }
        } SEAM(sb + 1);
        if (IN(sb + 2)) { Ctx c = mkctx(lds, a, wv); phase_s12(a, c, l);
            if (MK_DBL & (1 << 2)) { __syncthreads(); phase_s12(a, c, l); }
#if MK_SELFTEST
            if (l == 0) { asm volatile("" ::: "memory"); phase_s1(a, c, l, WS_HMID); bar.bar = (unsigned*)(a.ws() + WS_CTL) + CW_BAR; xcd_barrier(bar, c.tid);
                const u32x4* p = (const u32x4*)(c.ws + WS_CAR); const u32x4* q = (const u32x4*)(c.ws + WS_HMID); unsigned bad = 0;
                for (size_t i = (size_t)c.bid * NTHREADS + c.tid; i < (size_t)NB * 32 * 2 * NCH * 32; i += (size_t)c.G * NTHREADS) { const u32x4 x = p[i], y = q[i]; bad |= (x.x ^ y.x) | (x.y ^ y.y) | (x.z ^ y.z) | (x.w ^ y.w); }
                if (bad) __hip_atomic_fetch_or((unsigned*)(c.ws + WS_CTL) + 8, 1u, __ATOMIC_RELAXED, __HIP_MEMORY_SCOPE_AGENT); }
#endif
        } SEAM(sb + 2);
        if (IN(sb + 4)) { Ctx c = mkctx(lds, a, wv);
#pragma unroll 1
            for (int rep = 0; rep < ((MK_DBL & (1 << 4)) ? 2 : 1); ++rep) { phase_s3(a, c, l); __syncthreads(); }
            { const int nt3 = 32 * ((4 * (l == DEPTH - 1 ? NCH - 4 : NCH) + 7) >> 3), tail0 = nt3 % c.G;
                if (tail0 == 0) phase_pool(c, c.bid, c.G, 0, POOL_TASKS / 2, false); else if (c.bid >= tail0) phase_pool(c, c.bid - tail0, c.G - tail0, 0, POOL_TASKS / 2, false); }
        } SEAM(sb + 4);
        if (IN(sb + 5)) {
            Ctx c = mkctx(lds, a, wv);
            pg8::StaticOrder S; S.init(l == DEPTH - 1 ? TL : T, 512, c.G, c.bid); pg8::EpiGlu E{(const bf16_t*)(c.ws + WS_YG), (bf16_t*)(c.ws + WS_H) + (size_t)T * 512, a.in(20) + (size_t)l * 512};
            pg8::gemm_phase<pg8::EpiGlu, pg8::StaticOrder, false, true>(c.lds, c.tid, (const bf16_t*)(c.ws + WS_YG), (const bf16_t*)(c.ws + wbuf_off(l) + WO_GLU), 512, S, E);
            if (MK_DBL & (1 << 5)) { __syncthreads(); pg8::gemm_phase<pg8::EpiGlu, pg8::StaticOrder, false, true>(c.lds, c.tid, (const bf16_t*)(c.ws + WS_YG), (const bf16_t*)(c.ws + wbuf_off(l) + WO_GLU), 512, S, E); }
            { const int tail0 = S.nwg % c.G; Ctx c2 = mkctx(lds, a, wv);
                if (tail0 == 0) phase_pool(c2, c2.bid, c2.G, POOL_TASKS / 2, POOL_TASKS, l != DEPTH - 1); else if (c2.bid >= tail0) phase_pool(c2, c2.bid - tail0, c2.G - tail0, POOL_TASKS / 2, POOL_TASKS, l != DEPTH - 1); }
        } SEAM(sb + 5);
        if (IN(sb + 6)) {
            Ctx c = mkctx(lds, a, wv); pg8::PairOrder S; S.so.init(l == DEPTH - 1 ? TL : T, D, c.G, c.bid);
            pg8::EpiM12 E{(const bf16_t*)(c.ws + WS_Z), (bf16_t*)(c.ws + WS_HMID)};
            pg8::gemm_phase<pg8::EpiM12, pg8::PairOrder, false>(c.lds, c.tid, (const bf16_t*)(c.ws + WS_H), (const bf16_t*)(c.ws + wbuf_off(l) + WO_WC), 512, S, E);
            if (MK_DBL & (1 << 6)) { __syncthreads(); pg8::gemm_phase<pg8::EpiM12, pg8::PairOrder, false>(c.lds, c.tid, (const bf16_t*)(c.ws + WS_H), (const bf16_t*)(c.ws + wbuf_off(l) + WO_WC), 512, S, E); }
            { const int tail0 = S.so.nwg % c.G; if (l + 1 < DEPTH && tail0 != 0 && c.bid >= tail0) tr_range(a, c, l + 1, TR_SPLIT, TR_SPLIT2, (c.bid - tail0) * NWAVES + c.wave, (c.G - tail0) * NWAVES); }
        } SEAM(sb + 6);
        if (IN(sb + 7)) {
            Ctx c = mkctx(lds, a, wv);
            pg8::StaticOrder S; S.init(l == DEPTH - 1 ? TL : T, D, c.G, c.bid);
            pg8::EpiOut E{(bf16_t*)(c.ws + WS_XB), (const float*)(c.ws + WS_MODS) + (size_t)l * 9 * NMOD + 2 * D, (bf16_t*)(c.ws + WS_XB)};
            if (MK_DBL & (1 << 7)) { pg8::EpiOut E2{(bf16_t*)(c.ws + WS_XB), (const float*)(c.ws + WS_MODS) + (size_t)l * 9 * NMOD + 2 * D, (bf16_t*)(c.ws + WS_H)};
                pg8::gemm_phase<pg8::EpiOut, pg8::StaticOrder, false>(c.lds, c.tid, (const bf16_t*)(c.ws + WS_HMID), (const bf16_t*)(c.ws + wbuf_off(l) + WO_WOUT), D, S, E2); __syncthreads(); }
            pg8::gemm_phase<pg8::EpiOut, pg8::StaticOrder, false>(c.lds, c.tid, (const bf16_t*)(c.ws + WS_HMID), (const bf16_t*)(c.ws + wbuf_off(l) + WO_WOUT), D, S, E);
            { const int tail0 = S.nwg % c.G; if (l + 1 < DEPTH && tail0 != 0 && c.bid >= tail0) tr_range(a, c, l + 1, TR_SPLIT2, TR_NITEMS, (c.bid - tail0) * NWAVES + c.wave, (c.G - tail0) * NWAVES); }
        } SEAM(sb + 7);
        if (IN(sb + 8)) { Ctx c = mkctx(lds, a, wv); phase_i(a, c, l); if (MK_DBL & (1 << 8)) { __syncthreads(); phase_i(a, c, l, true); } } SEAM(sb + 8);
        if (IN(sb + 9)) {
            Ctx c = mkctx(lds, a, wv);
            moe_setup(c, l);
            pg8::MoeOrder S{(const LAS int*)(c.misc + 16), (const LAS int*)(c.misc + 48), (const int*)(c.ws + WS_LIST), c.G, c.bid}; pg8::EpiUp E{(bf16_t*)(c.ws + WS_HMID)};
            pg8::gemm_phase<pg8::EpiUp, pg8::MoeOrder, true>(c.lds, c.tid, (const bf16_t*)(c.ws + WS_H), (const bf16_t*)(c.ws + wbuf_off(l) + WO_W13), D, S, E);
            if (MK_DBL & (1 << 9)) { __syncthreads(); pg8::gemm_phase<pg8::EpiUp, pg8::MoeOrder, true>(c.lds, c.tid, (const bf16_t*)(c.ws + WS_H), (const bf16_t*)(c.ws + wbuf_off(l) + WO_W13), D, S, E); }
        } SEAM(sb + 9);
        if (IN(sb + 10)) {
            Ctx c = mkctx(lds, a, wv);
            moe_setup(c, l);
            pg8::MoeOrder S{(const LAS int*)(c.misc + 16), (const LAS int*)(c.misc + 48), (const int*)(c.ws + WS_LIST), c.G, c.bid};
            pg8::EpiDown E{(bf16_t*)(c.ws + WS_Z), (const int*)(c.ws + WS_LIST), (const float*)(c.ws + WS_GW), (const LAS int*)(c.misc + 16), (const LAS int*)(c.misc + 48)};
            pg8::gemm_phase<pg8::EpiDown, pg8::MoeOrder, false>(c.lds, c.tid, (const bf16_t*)(c.ws + WS_HMID), (const bf16_t*)(c.ws + wbuf_off(l) + WO_W2), DE, S, E);
            if (MK_DBL & (1 << 10)) { __syncthreads(); pg8::gemm_phase<pg8::EpiDown, pg8::MoeOrder, false>(c.lds, c.tid, (const bf16_t*)(c.ws + WS_HMID), (const bf16_t*)(c.ws + wbuf_off(l) + WO_W2), DE, S, E); }
        } SEAM(sb + 10);
    }
    if (IN(NSTEPS - 1)) { Ctx c = mkctx(lds, a, wv); phase_fin(a, c); }
#undef IN
#undef SEAM
}

extern "C" void kernel_launch(void* const* d_in, const int* in_sizes, int n_in, void* d_out, int out_size, void* d_ws, size_t ws_size, hipStream_t stream) {
    static int grid = 0;
    if (grid == 0) {
        if (n_in != 30 || out_size != TL * D || ws_size < WS_END) { fprintf(stderr, "kernel_launch: unexpected shapes (n_in %d out %d ws %zu)\n", n_in, out_size, ws_size); grid = -1; return; }
        int dev = 0, cus = 0, per_cu = 0;
        if (hipGetDevice(&dev) != hipSuccess || hipDeviceGetAttribute(&cus, hipDeviceAttributeMultiprocessorCount, dev) != hipSuccess) { grid = -1; return; }
        if (hipFuncSetAttribute((const void*)mk_fwd, hipFuncAttributeMaxDynamicSharedMemorySize, LDS_BYTES) != hipSuccess) { fprintf(stderr, "kernel_launch: hipFuncSetAttribute failed\n"); grid = -1; return; }
        if (hipOccupancyMaxActiveBlocksPerMultiprocessor(&per_cu, (const void*)mk_fwd, NTHREADS, LDS_BYTES) != hipSuccess || per_cu < 1) { fprintf(stderr, "kernel_launch: occupancy query says %d\n", per_cu); per_cu = 1; }
        (void)hipGetLastError();
        grid = cus;
    }
    if (grid < 0) return;
    (void)hipMemsetAsync((char*)d_ws + WS_CTL, 0, CTL_ZERO_BYTES, stream);
#if (MK_DIAG_ZERO & 2)
    (void)hipMemsetAsync((char*)d_ws, 0, WS_END, stream);
#endif
#if (MK_DIAG_ZERO & 4)
    (void)hipMemsetAsync((char*)d_out, 0, (size_t)TL * D * 4, stream);
#endif
    KArgs a{};
    for (int i = 0; i < 30; ++i) a.in[i] = (const float*)d_in[i];
    a.out = (float*)d_out; a.ws = (unsigned char*)d_ws;
#if MK_MULTI
    for (int s = 0; s < NSTEPS; ++s) { a.lo = s; a.hi = s + 1; hipLaunchKernelGGL(mk_fwd, dim3(grid), dim3(NTHREADS), LDS_BYTES, stream, a); }
#else
    a.lo = 0; a.hi = NSTEPS; hipLaunchKernelGGL(mk_fwd, dim3(grid), dim3(NTHREADS), LDS_BYTES, stream, a);
#endif
}
```

```cpp
#include <hip/hip_runtime.h>
#include <cstdio>

#ifndef MK_MULTI
#define MK_MULTI 0
#endif
#ifndef MK_SELFTEST
#ifndef MK_DBL
#define MK_DBL 0
#endif
#define MK_SELFTEST 0
#endif
#define MK_DIAG_ZERO 0

#define LAS __attribute__((address_space(3)))
#define GAS __attribute__((address_space(1)))
typedef unsigned short bf16_t;
typedef short bf16x8 __attribute__((ext_vector_type(8)));
typedef float f32x2 __attribute__((ext_vector_type(2)));
typedef float f32x4 __attribute__((ext_vector_type(4)));
typedef float f32x16 __attribute__((ext_vector_type(16)));
typedef unsigned u32x2 __attribute__((ext_vector_type(2)));
typedef unsigned u32x4 __attribute__((ext_vector_type(4)));

constexpr int D = 1024, NB = 8, SEQ = 4096, CTXL = 256, DEPTH = 4;
constexpr int TL = NB * SEQ, TC = NB * CTXL, T = TL + TC;
constexpr int NZ = 3072, NMOD = 6 * D;
constexpr int NE = 16, DE = 512;
constexpr int LCAP = 2 * T;
constexpr int HM_ROWS = 2 * T + NE * 256;
constexpr float RMS_EPS = 1e-6f;
constexpr int NCH = 68;
constexpr int IMG_STRIDE = 336;

constexpr size_t MiB = 1u << 20;
constexpr size_t WS_CTL = 0, CTL_ZERO_BYTES = 128 * 1024;
constexpr size_t WS_MODS = 2 * MiB;
constexpr size_t WS_AB = 3 * MiB;
constexpr size_t WS_BF = 4 * MiB;
constexpr size_t WS_CF = 5 * MiB;
constexpr size_t WS_LIST = 7 * MiB;
constexpr size_t WS_GW = 12 * MiB;
constexpr size_t WS_XCTX = 13 * MiB;
constexpr size_t WS_CAR = 21 * MiB;
constexpr size_t WS_W = 39 * MiB;
constexpr size_t WO_WIN = 0, WO_WC = 6 * MiB, WO_WBS = 7 * MiB, WO_WOUT = 8 * MiB, WO_GLU = 10 * MiB, WO_W13 = 11 * MiB, WO_W2 = 43 * MiB;
constexpr size_t WS_H = 98 * MiB;
constexpr size_t WS_YG = 166 * MiB;
constexpr size_t WS_HMID = 200 * MiB;
constexpr size_t WS_Z = 272 * MiB;
constexpr size_t WS_XB = 476 * MiB;
constexpr size_t WS_W2ND = 544 * MiB;
constexpr size_t WS_CAR2 = 604 * MiB;
constexpr size_t WS_S3T = 621 * MiB;
constexpr size_t WS_U = 631 * MiB;
constexpr size_t WS_END = 665 * MiB;
static_assert((size_t)HM_ROWS * 512 * 2 <= 72 * MiB && (size_t)T * NZ * 2 <= 204 * MiB && (size_t)T * D * 2 == 68 * MiB, "ws map");
constexpr int CW_TMO = 0, CW_BAR = 4096, CW_CNT = 16384;

__device__ __forceinline__ unsigned f2bf(float f) { unsigned u = __builtin_bit_cast(unsigned, f); return (u + 0x7fffu + ((u >> 16) & 1u)) >> 16; }
typedef __bf16 bf16v2 __attribute__((ext_vector_type(2)));
__device__ __forceinline__ unsigned pk2(float lo, float hi) { const f32x2 v = {lo, hi}; const bf16v2 b = __builtin_convertvector(v, bf16v2); return __builtin_bit_cast(unsigned, b); }
__device__ __forceinline__ float bflo(unsigned w) { return __builtin_bit_cast(float, w << 16); }
__device__ __forceinline__ float bfhi(unsigned w) { return __builtin_bit_cast(float, w & 0xffff0000u); }
__device__ __forceinline__ float sigm(float x) { return __builtin_amdgcn_rcpf(1.0f + __builtin_amdgcn_exp2f(-1.44269504f * x)); }
__device__ __forceinline__ float gelu_t(float x) { const float u = 1.5957691216f * (x + 0.044715f * x * x * x); return x * sigm(u); }
__device__ __forceinline__ int lane_id_v() { int l; asm volatile("v_mbcnt_lo_u32_b32 %0, -1, 0\n\tv_mbcnt_hi_u32_b32 %0, -1, %0" : "=v"(l)); return l; }
__device__ __forceinline__ int hw_key() { return (int)(__builtin_amdgcn_s_getreg((5 << 11) | 4) & 0x3fu); }
__device__ __forceinline__ float shflx(float v, int o, int lane) { return __builtin_bit_cast(float, __builtin_amdgcn_ds_bpermute((lane ^ o) << 2, __builtin_bit_cast(int, v))); }
__device__ __forceinline__ float wave_sum(float v, int lane) {
#pragma unroll
    for (int o = 1; o < 64; o <<= 1) v += shflx(v, o, lane);
    return v;
}
__device__ __forceinline__ f32x4 ld_bf4(const bf16_t* p) { const u32x2 w = *(const u32x2*)p; return (f32x4){bflo(w.x), bfhi(w.x), bflo(w.y), bfhi(w.y)}; }
__device__ __forceinline__ void st_bf4(bf16_t* p, f32x4 v) { u32x2 w; w.x = pk2(v[0], v[1]); w.y = pk2(v[2], v[3]); *(u32x2*)p = w; }
#define LDS_WAIT() asm volatile("s_waitcnt lgkmcnt(0)" ::: "memory")
#define VM_WAIT() asm volatile("s_waitcnt vmcnt(0)" ::: "memory")

namespace pg8 {
constexpr int BM = 256, BK = 64, HALF = 128, HTB = HALF * BK * 2, STAGE_BYTES = 8 * HTB, NXCD = 8, WGM = 8;
__host__ __device__ __forceinline__ int lds_byte(int r, int c) { const int st = (r >> 4) * 2 + (c >> 5), rr = r & 15, cc = c & 31, ob = rr * 64 + cc * 2; return st * 1024 + (ob ^ (((ob >> 9) & 1) << 5)); }
__host__ __device__ __forceinline__ void stage_rc(int b, int& R, int& C) { const int st = b / 1024, sb = b % 1024, swz = sb ^ (((sb >> 9) & 1) << 5); R = (st >> 1) * 16 + swz / 64; C = (st & 1) * 32 + (swz % 64) / 2; }
__host__ __device__ __forceinline__ int perm32(int rho) { const int n = rho >> 4, i = rho & 15; return 8 * (i >> 2) + 4 * n + (i & 3); }

struct Unit { int pm, pn, e, pnl; };

struct StaticOrder {
    int nM, nN, nwg, G, c;
    __device__ void init(int M, int N, int G_, int c_) { nM = M / BM; nN = N / BM; nwg = nM * nN; G = G_; c = c_; }
    __device__ bool next(int i, Unit& u) const {
        const long L = (long)i * G + c; if (L >= nwg) return false;
        int wgid = (int)L; { const int q = nwg / NXCD, r = nwg % NXCD, xcd = wgid % NXCD, off = wgid / NXCD; wgid = (xcd < r ? xcd * (q + 1) : r * (q + 1) + (xcd - r) * q) + off; }
        const int nig = WGM * nN, gid = wgid / nig, fm = gid * WGM, gsz = (nM - fm) < WGM ? (nM - fm) : WGM;
        u.pm = fm + ((wgid % nig) % gsz); u.pn = (wgid % nig) / gsz; u.pnl = u.pn; u.e = 0; return true;
    }
    __device__ __forceinline__ int arow(const Unit&, int) const { return 0; }
    __device__ __forceinline__ const int* arow_ptr(const Unit&, int) const { return nullptr; }
};
struct ComboOrder {
    int G, c;
    __device__ bool next(int i, Unit& u) const {
        const int L = i * G + c; constexpr int NM = (T / BM) * 4, NG = (T / BM) * 2;
        if (L >= NM + NG) return false;
        if (L < NM) { u.pm = L >> 2; u.pn = L & 3; u.pnl = L & 3; u.e = 0; }
        else { const int q = L - NM; u.pm = (q >> 1) + (int)((WS_YG - WS_H) / ((size_t)BM * 1024)); u.pn = (q & 1) + (int)((WO_GLU - WO_WC) / ((size_t)BM * 1024)); u.pnl = q & 1; u.e = 1; }
        return true;
    }
    __device__ __forceinline__ int arow(const Unit&, int) const { return 0; }
    __device__ __forceinline__ const int* arow_ptr(const Unit&, int) const { return nullptr; }
};
struct PairOrder {
    StaticOrder so;
    __device__ bool next(int i, Unit& u) const {
        if (!so.next(i >> 1, u)) return false;
        u.e = i & 1; u.pnl = u.pn;
        if (u.e == 0) { u.pm += T / BM; u.pn += 4; }
        return true;
    }
    __device__ __forceinline__ int arow(const Unit&, int) const { return 0; }
    __device__ __forceinline__ const int* arow_ptr(const Unit&, int) const { return nullptr; }
};
struct MoeOrder {
    const LAS int* cum; const LAS int* cnt; const int* list; int G, c;
    __device__ bool next(int i, Unit& u) const {
        const int ntot = cum[NE]; int L;
        if ((G & 7) == 0) { const int x = c & 7, k = i * (G >> 3) + (c >> 3); const int rt = x + 8 * (k >> 2); if (rt >= ntot) return false; L = rt * 4 + (k & 3); }
        else { L = i * G + c; if (L >= ntot * 4) return false; }
        const int rtg = L >> 2; int e = 0;
#pragma unroll
        for (int k = 1; k < NE; ++k) e += (rtg >= cum[k]) ? 1 : 0;
        u.pm = rtg; u.e = e; u.pnl = L & 3; u.pn = e * 4 + (L & 3); return true;
    }
    __device__ __forceinline__ int arow(const Unit& u, int rl) const {
        return *arow_ptr(u, rl) >> 1;
    }
    __device__ __forceinline__ const int* arow_ptr(const Unit& u, int rl) const {
        const int pos = (u.pm - cum[u.e]) * BM + rl, last = cnt[u.e] - 1;
        return list + (u.e * LCAP + (pos < last ? pos : last));
    }
};

template <class Epi, class Sched, bool GATHER, bool AGRP = false>
__device__ __forceinline__ void gemm_phase(LAS unsigned char* lds, const int tid_in, const bf16_t* A, const bf16_t* Bt, const int K, const Sched& S, const Epi& E) {
    const int tid = tid_in, wid = __builtin_amdgcn_readfirstlane(tid >> 6), lane = tid & 63, wr = wid >> 2, wc = wid & 3, fr = lane & 15, fq = lane >> 4;
    const int nt = K / BK;
    unsigned voffB[2];
#pragma unroll
    for (int i = 0; i < 2; ++i) { int R, C; stage_rc(tid * 16 + i * 8192, R, C); const int Rb = Epi::PERM ? ((R & ~31) + perm32(R & 31)) : R; voffB[i] = (unsigned)(Rb * K + C) * 2u; }
    const size_t kstep = (size_t)(BK * 2);
    const size_t kstepA = AGRP ? (size_t)(BK / 16) * T * 32 : kstep;
    const size_t hstep = (size_t)HALF * K * 2;
    const size_t tstep = 2 * hstep;
    const unsigned ldsw = (unsigned)wid * 1024u;
    const int aoff = lds_byte(wr * 64 + fr, fq * 8), boff = lds_byte(wc * 32 + fr, fq * 8);
#define PG8_SA(b, h) (((b) * 2 + (h)) * HTB)
#define PG8_SB(b, h) ((4 + (b) * 2 + (h)) * HTB)
#define PG8_STAGE(bufoff, gbase, voff) do { _Pragma("unroll") for (int _i = 0; _i < 2; ++_i) \
        __builtin_amdgcn_global_load_lds((const unsigned*)((const char*)(gbase) + (voff)[_i]), (LAS unsigned*)(lds + (bufoff) + ldsw + _i * 8192), 16, 0, 0); } while (0)
#define PG8_STAGEA(bufoff, kt, o0, o1) do { const char* _g = (const char*)A + (size_t)(kt) * kstepA; \
        __builtin_amdgcn_global_load_lds((const unsigned*)(_g + (o0)), (LAS unsigned*)(lds + (bufoff) + ldsw), 16, 0, 0); \
        __builtin_amdgcn_global_load_lds((const unsigned*)(_g + (o1)), (LAS unsigned*)(lds + (bufoff) + ldsw + 8192), 16, 0, 0); } while (0)
#define PG8_LDA(dst, b, h) do { _Pragma("unroll") for (int m = 0; m < 4; ++m) _Pragma("unroll") for (int k = 0; k < 2; ++k) dst[m][k] = *(const LAS bf16x8*)(lds + PG8_SA(b, h) + aoff + m * 2048 + k * 1024); } while (0)
#define PG8_LDB(dst, b, h) do { _Pragma("unroll") for (int n = 0; n < 2; ++n) _Pragma("unroll") for (int k = 0; k < 2; ++k) dst[n][k] = *(const LAS bf16x8*)(lds + PG8_SB(b, h) + boff + n * 2048 + k * 1024); } while (0)
#define PG8_MMA(ai, bj, At, Bt_) do { __builtin_amdgcn_s_setprio(1); _Pragma("unroll") for (int m = 0; m < 4; ++m) _Pragma("unroll") for (int n = 0; n < 2; ++n) _Pragma("unroll") for (int k = 0; k < 2; ++k) \
        acc[ai][bj][m][n] = __builtin_amdgcn_mfma_f32_16x16x32_bf16(Bt_[n][k], At[m][k], acc[ai][bj][m][n], 0, 0, 0); __builtin_amdgcn_s_setprio(0); } while (0)
#define PG8_WAIT_V(n) asm volatile("s_waitcnt vmcnt(" #n ")" ::: "memory")
#define PG8_WAIT_L(n) asm volatile("s_waitcnt lgkmcnt(" #n ")" ::: "memory")
#define PG8_BAR __builtin_amdgcn_s_barrier()
#define PG8_SCHED __builtin_amdgcn_sched_barrier(0)
#define PG8_CALC_OFF(dst, U) do { unsigned _rw[4]; \
        if (GATHER) { const int* _pp[4];   \
            _Pragma("unroll") for (int _h = 0; _h < 2; ++_h) _Pragma("unroll") for (int _i = 0; _i < 2; ++_i) { int _R, _C; stage_rc(tid * 16 + _i * 8192, _R, _C); _pp[_h * 2 + _i] = S.arow_ptr((U), _h * HALF + _R); } \
            __builtin_amdgcn_sched_barrier(0); \
            _Pragma("unroll") for (int _k = 0; _k < 4; ++_k) _rw[_k] = (unsigned)*_pp[_k]; \
            __builtin_amdgcn_sched_barrier(0); \
            _Pragma("unroll") for (int _k = 0; _k < 4; ++_k) _rw[_k] >>= 1; \
        } else { _Pragma("unroll") for (int _h = 0; _h < 2; ++_h) _Pragma("unroll") for (int _i = 0; _i < 2; ++_i) { int _R, _C; stage_rc(tid * 16 + _i * 8192, _R, _C); _rw[_h * 2 + _i] = (unsigned)((U).pm * BM + _h * HALF + _R); } } \
        _Pragma("unroll") for (int _h = 0; _h < 2; ++_h) _Pragma("unroll") for (int _i = 0; _i < 2; ++_i) { int _R, _C; stage_rc(tid * 16 + _i * 8192, _R, _C); const unsigned _row = _rw[_h * 2 + _i]; \
            dst[_h * 2 + _i] = AGRP ? (((unsigned)(_C >> 4) * (unsigned)T + _row) * 32u + (unsigned)((_C & 15) * 2)) : _row * (unsigned)(K * 2) + (unsigned)(_C * 2); } } while (0)
    Unit cur, nxt; int ui = 0;
    if (!S.next(0, cur)) return;
    f32x4 acc[2][2][4][2];
#pragma unroll
    for (int a = 0; a < 2; ++a)
#pragma unroll
        for (int b = 0; b < 2; ++b)
#pragma unroll
            for (int m = 0; m < 4; ++m)
#pragma unroll
                for (int n = 0; n < 2; ++n) acc[a][b][m][n] = (f32x4){0.f, 0.f, 0.f, 0.f};
    bf16x8 At[4][2], B0[2][2], B1[2][2];
    unsigned oc[4], on[4];
    PG8_CALC_OFF(oc, cur);
    const char* cB = (const char*)Bt + (size_t)cur.pn * tstep;
    PG8_STAGE(PG8_SB(0, 0), cB, voffB); PG8_STAGE(PG8_SB(0, 1), cB + hstep, voffB); PG8_STAGEA(PG8_SA(0, 0), 0, oc[0], oc[1]); PG8_STAGEA(PG8_SA(0, 1), 0, oc[2], oc[3]);
    if (wr == 1) PG8_BAR;
    PG8_WAIT_V(2); PG8_BAR;
    PG8_STAGE(PG8_SB(1, 0), cB + kstep, voffB); PG8_STAGEA(PG8_SA(1, 0), 1, oc[0], oc[1]); PG8_STAGE(PG8_SB(1, 1), cB + hstep + kstep, voffB);
    PG8_WAIT_V(6); PG8_BAR;
    for (;;) {
        const bool has_next = S.next(ui + 1, nxt);
        if (has_next) { PG8_CALC_OFF(on, nxt); } else {
#pragma unroll
            for (int q = 0; q < 4; ++q) on[q] = oc[q]; }
        const char* nB = has_next ? (const char*)Bt + (size_t)nxt.pn * tstep : cB;
        for (int t = 0; t < nt; t += 2) {
            const bool last = (t == nt - 2);
            const int k2 = last ? 0 : t + 2, k3 = k2 + 1;
            const unsigned s0 = last ? on[0] : oc[0], s1 = last ? on[1] : oc[1], s2 = last ? on[2] : oc[2], s3 = last ? on[3] : oc[3];
            const char* b2 = last ? nB : cB + (size_t)(t + 2) * kstep; const char* b3 = b2 + kstep;
            PG8_LDB(B0, 0, 0); PG8_LDB(B1, 0, 1); PG8_SCHED; PG8_LDA(At, 0, 0); PG8_STAGEA(PG8_SA(1, 1), t + 1, oc[2], oc[3]);
            PG8_WAIT_V(8); PG8_WAIT_L(0); PG8_BAR; PG8_MMA(0, 0, At, B0); PG8_MMA(0, 1, At, B1); PG8_BAR; PG8_SCHED;
            PG8_LDA(At, 0, 1); PG8_STAGE(PG8_SB(0, 0), b2, voffB); PG8_STAGE(PG8_SB(0, 1), b2 + hstep, voffB); PG8_STAGEA(PG8_SA(0, 0), k2, s0, s1);
            PG8_WAIT_V(8); PG8_WAIT_L(0); PG8_BAR; PG8_MMA(1, 0, At, B0); PG8_MMA(1, 1, At, B1); PG8_BAR; PG8_SCHED;
            PG8_LDB(B0, 1, 0); PG8_LDB(B1, 1, 1); PG8_SCHED; PG8_LDA(At, 1, 0); PG8_STAGEA(PG8_SA(0, 1), k2, s2, s3);
            PG8_WAIT_V(8); PG8_WAIT_L(0); PG8_BAR; PG8_MMA(0, 0, At, B0); PG8_MMA(0, 1, At, B1); PG8_BAR; PG8_SCHED;
            PG8_LDA(At, 1, 1); PG8_STAGE(PG8_SB(1, 0), b3, voffB); PG8_STAGE(PG8_SB(1, 1), b3 + hstep, voffB); PG8_STAGEA(PG8_SA(1, 0), k3, s0, s1);
            PG8_WAIT_V(8); PG8_WAIT_L(0); PG8_BAR; PG8_MMA(1, 0, At, B0); PG8_MMA(1, 1, At, B1); PG8_BAR; PG8_SCHED;
        }
        if (wr == 0) PG8_BAR;
        bool keep = false;
        if constexpr (Epi::KEEPS) keep = E.apply(acc, cur, wr, wc, fr, fq); else E(acc, cur, wr, wc, fr, fq);
        if (!has_next) break;
        if (!keep) {
#pragma unroll
        for (int a = 0; a < 2; ++a)
#pragma unroll
            for (int b = 0; b < 2; ++b)
#pragma unroll
                for (int m = 0; m < 4; ++m)
#pragma unroll
                    for (int n = 0; n < 2; ++n) acc[a][b][m][n] = (f32x4){0.f, 0.f, 0.f, 0.f};
        }
        cur = nxt; cB = nB; ++ui;
#pragma unroll
        for (int q = 0; q < 4; ++q) oc[q] = on[q];
        if (wr == 1) PG8_BAR;
    }
    PG8_WAIT_V(0);
    PG8_BAR;
#undef PG8_SA
#undef PG8_SB
#undef PG8_STAGE
#undef PG8_STAGEA
#undef PG8_LDA
#undef PG8_LDB
#undef PG8_MMA
#undef PG8_WAIT_V
#undef PG8_WAIT_L
#undef PG8_BAR
#undef PG8_SCHED
#undef PG8_CALC_OFF
}

typedef const f32x4 (&AccRef)[2][2][4][2];
__device__ __forceinline__ u32x4 pack8(f32x4 v0, f32x4 v1) { u32x4 w; w.x = pk2(v0[0], v0[1]); w.y = pk2(v0[2], v0[3]); w.z = pk2(v1[0], v1[1]); w.w = pk2(v1[2], v1[3]); return w; }
__device__ __forceinline__ void unpack8(u32x4 w, f32x4& v0, f32x4& v1) { v0 = (f32x4){bflo(w.x), bfhi(w.x), bflo(w.y), bfhi(w.y)}; v1 = (f32x4){bflo(w.z), bfhi(w.z), bflo(w.w), bfhi(w.w)}; }
__device__ __forceinline__ f32x4 sigm4(f32x4 v) { return (f32x4){sigm(v[0]), sigm(v[1]), sigm(v[2]), sigm(v[3])}; }

struct EpiIn {
    static constexpr bool PERM = true, KEEPS = false; bf16_t* Z; bf16_t* U;
    __device__ __forceinline__ void operator()(AccRef acc, const Unit& u, int wr, int wc, int fr, int fq) const {
        const int row0 = u.pm * BM + wr * 64 + fr; const bool gate = u.pnl >= 4;
        const int col0 = gate ? 1024 + (u.pnl - 4) * HALF + wc * 32 + 8 * fq : u.pnl * BM + wc * 32 + 8 * fq, cstep = gate ? 1024 : HALF;
#pragma unroll
        for (int ai = 0; ai < 2; ++ai)
#pragma unroll
            for (int m = 0; m < 4; ++m) { bf16_t* rowp = Z + (size_t)(row0 + ai * HALF + m * 16) * NZ + col0;
                f32x4 v0 = acc[ai][0][m][0], v1 = acc[ai][0][m][1], w0 = acc[ai][1][m][0], w1 = acc[ai][1][m][1];
                u32x4 pa = pack8(v0, v1);
                if (gate) {
#pragma unroll
                    for (int k = 0; k < 4; ++k) {
                        const float da0 = 1.0f + __builtin_amdgcn_exp2f(fminf(-1.44269504f * v0[k], 60.0f)), db0 = 1.0f + __builtin_amdgcn_exp2f(fminf(-1.44269504f * w0[k], 60.0f));
                        const float da1 = 1.0f + __builtin_amdgcn_exp2f(fminf(-1.44269504f * v1[k], 60.0f)), db1 = 1.0f + __builtin_amdgcn_exp2f(fminf(-1.44269504f * w1[k], 60.0f));
                        v0[k] = __builtin_amdgcn_rcpf(da0); w0[k] = da0 * __builtin_amdgcn_rcpf(db0); v1[k] = __builtin_amdgcn_rcpf(da1); w1[k] = da1 * __builtin_amdgcn_rcpf(db1); }
                    pa = pack8(v0, v1); }
                if (u.pnl == 2 || u.pnl == 3) {
                    const int uc = (u.pnl - 2) * BM + wc * 32 + 8 * fq; const size_t tok = (size_t)(row0 + ai * HALF + m * 16);
                    *(u32x4*)(U + ((size_t)(uc >> 4) * T + tok) * 16 + (uc & 8)) = pa; *(u32x4*)(U + ((size_t)((uc + HALF) >> 4) * T + tok) * 16 + (uc & 8)) = pack8(w0, w1);
                } else { *(u32x4*)rowp = pa; *(u32x4*)(rowp + cstep) = pack8(w0, w1); } }
    }
};
struct EpiGlu {
    static constexpr bool PERM = true, KEEPS = false; const bf16_t* YG; bf16_t* S; const float* gb;
    __device__ __forceinline__ void operator()(AccRef acc, const Unit& u, int wr, int wc, int fr, int fq) const {
        const int row0 = u.pm * BM + wr * 64 + fr, col0 = u.pnl * BM + wc * 32 + 8 * fq;
        f32x4 bv[2][2];
#pragma unroll
        for (int bj = 0; bj < 2; ++bj)
#pragma unroll
            for (int n = 0; n < 2; ++n) bv[bj][n] = *(const f32x4*)(gb + col0 + bj * HALF + 4 * n);
        u32x4 yv[2][4][2];
#pragma unroll
        for (int ai = 0; ai < 2; ++ai)
#pragma unroll
            for (int m = 0; m < 4; ++m)
#pragma unroll
                for (int bj = 0; bj < 2; ++bj) yv[ai][m][bj] = *(const u32x4*)(YG + ((size_t)((col0 + bj * HALF) >> 4) * T + (row0 + ai * HALF + m * 16)) * 16 + ((col0 + bj * HALF) & 8));
        __builtin_amdgcn_sched_barrier(0);
#pragma unroll
        for (int ai = 0; ai < 2; ++ai)
#pragma unroll
            for (int m = 0; m < 4; ++m) { const size_t off = (size_t)(row0 + ai * HALF + m * 16) * 512 + col0;
#pragma unroll
                for (int bj = 0; bj < 2; ++bj) { f32x4 y0, y1; unpack8(yv[ai][m][bj], y0, y1);
                    const f32x4 v0 = y0 * sigm4(acc[ai][bj][m][0] + bv[bj][0]), v1 = y1 * sigm4(acc[ai][bj][m][1] + bv[bj][1]);
                    *(u32x4*)(S + off + bj * HALF) = pack8(v0, v1); } }
    }
};
template <int MODE> struct EpiMerge {
    static constexpr bool PERM = true, KEEPS = false; bf16_t* Z; bf16_t* M;
    __device__ __forceinline__ void operator()(AccRef acc, const Unit& u, int wr, int wc, int fr, int fq) const {
        const int row0 = u.pm * BM + wr * 64 + fr, col0 = u.pnl * BM + wc * 32 + 8 * fq;
#pragma unroll
        for (int ai = 0; ai < 2; ++ai)
#pragma unroll
            for (int m = 0; m < 4; ++m) { bf16_t* rowp = Z + (size_t)(row0 + ai * HALF + m * 16) * NZ + col0;
#pragma unroll
                for (int bj = 0; bj < 2; ++bj) {
                    if (MODE == 0) { f32x4 g0, g1; unpack8(*(const u32x4*)(rowp + 1024 + bj * HALF), g0, g1);
                        *(u32x4*)(rowp + 1024 + bj * HALF) = pack8(g0 * acc[ai][bj][m][0], g1 * acc[ai][bj][m][1]); }
                    else { f32x4 g0, g1, t0, t1; unpack8(*(const u32x4*)(rowp + 2048 + bj * HALF), g0, g1); unpack8(*(const u32x4*)(rowp + 1024 + bj * HALF), t0, t1);
                        *(u32x4*)(M + (size_t)(row0 + ai * HALF + m * 16) * D + col0 + bj * HALF) = pack8(t0 + g0 * acc[ai][bj][m][0], t1 + g1 * acc[ai][bj][m][1]); } } }
    }
};
struct EpiM12 {
    static constexpr bool PERM = true, KEEPS = true; const bf16_t* Z; bf16_t* M;
    __device__ __forceinline__ bool apply(f32x4 (&acc)[2][2][4][2], const Unit& u, int wr, int wc, int fr, int fq) const {
        const int pmr = u.e == 0 ? u.pm - T / BM : u.pm; const int row0_ = pmr * BM + wr * 64 + fr, col0 = u.pnl * BM + wc * 32 + 8 * fq;
        if (u.e == 0) {
            const int row0 = row0_;
            u32x4 qv[2][4][2];
#pragma unroll
            for (int ai = 0; ai < 2; ++ai)
#pragma unroll
                for (int m = 0; m < 4; ++m)
#pragma unroll
                    for (int bj = 0; bj < 2; ++bj) qv[ai][m][bj] = *(const u32x4*)(Z + (size_t)(row0 + ai * HALF + m * 16) * NZ + col0 + bj * HALF + 2048);
            __builtin_amdgcn_sched_barrier(0);
#pragma unroll
            for (int ai = 0; ai < 2; ++ai)
#pragma unroll
                for (int m = 0; m < 4; ++m)
#pragma unroll
                    for (int bj = 0; bj < 2; ++bj) { f32x4 q0, q1; unpack8(qv[ai][m][bj], q0, q1); acc[ai][bj][m][0] *= q0; acc[ai][bj][m][1] *= q1; }
        } else {
            const int row0 = row0_;
            u32x4 pv[2][4][2];
#pragma unroll
            for (int ai = 0; ai < 2; ++ai)
#pragma unroll
                for (int m = 0; m < 4; ++m)
#pragma unroll
                    for (int bj = 0; bj < 2; ++bj) pv[ai][m][bj] = *(const u32x4*)(Z + (size_t)(row0 + ai * HALF + m * 16) * NZ + col0 + bj * HALF + 1024);
            __builtin_amdgcn_sched_barrier(0);
#pragma unroll
            for (int ai = 0; ai < 2; ++ai)
#pragma unroll
                for (int m = 0; m < 4; ++m)
#pragma unroll
                    for (int bj = 0; bj < 2; ++bj) { f32x4 p0, p1; unpack8(pv[ai][m][bj], p0, p1);
                        *(u32x4*)(M + (size_t)(row0 + ai * HALF + m * 16) * D + col0 + bj * HALF) = pack8(acc[ai][bj][m][0] * p0, acc[ai][bj][m][1] * p1); }
        }
        return u.e == 0;
    }
};
struct EpiCombo {
    static constexpr bool PERM = true, KEEPS = false; EpiMerge<0> em; EpiGlu eg;
    __device__ __forceinline__ void operator()(AccRef acc, const Unit& u, int wr, int wc, int fr, int fq) const {
        if (u.e == 0) em(acc, u, wr, wc, fr, fq);
        else { Unit v = u; v.pm = u.pm - (int)((WS_YG - WS_H) / ((size_t)BM * 1024)); eg(acc, v, wr, wc, fr, fq); }
    }
};
struct EpiOut {
    static constexpr bool PERM = true, KEEPS = false; bf16_t* XB; const float* g1; bf16_t* XBW;
    __device__ __forceinline__ void operator()(AccRef acc, const Unit& u, int wr, int wc, int fr, int fq) const {
        const bool lat = u.pm < TL / BM; const int brow = lat ? (u.pm >> 4) : 8;
        bf16_t* xb = XB + (size_t)u.pm * BM * D; bf16_t* xw = XBW + (size_t)u.pm * BM * D;
        const int row0 = wr * 64 + fr, col0 = u.pnl * BM + wc * 32 + 8 * fq;
        f32x4 gv[2][2];
#pragma unroll
        for (int bj = 0; bj < 2; ++bj)
#pragma unroll
            for (int n = 0; n < 2; ++n) gv[bj][n] = *(const f32x4*)(g1 + (size_t)brow * NMOD + col0 + bj * HALF + 4 * n);
#pragma unroll
        for (int ai = 0; ai < 2; ++ai) { u32x4 xv[4][2];
#pragma unroll
            for (int m = 0; m < 4; ++m)
#pragma unroll
                for (int bj = 0; bj < 2; ++bj) xv[m][bj] = *(const u32x4*)(xb + (size_t)(row0 + ai * HALF + m * 16) * D + col0 + bj * HALF);
            __builtin_amdgcn_sched_barrier(0);
#pragma unroll
            for (int m = 0; m < 4; ++m)
#pragma unroll
                for (int bj = 0; bj < 2; ++bj) { f32x4 p0, p1; unpack8(xv[m][bj], p0, p1);
                    *(u32x4*)(xw + (size_t)(row0 + ai * HALF + m * 16) * D + col0 + bj * HALF) = pack8(p0 + gv[bj][0] * acc[ai][bj][m][0], p1 + gv[bj][1] * acc[ai][bj][m][1]); } }
    }
};
struct EpiUp {
    static constexpr bool PERM = true, KEEPS = false; bf16_t* HM;
    __device__ __forceinline__ void operator()(AccRef acc, const Unit& u, int wr, int wc, int fr, int fq) const {
        const int row0 = u.pm * BM + wr * 64 + fr, col0 = u.pnl * HALF + wc * 32 + 8 * fq;
#pragma unroll
        for (int ai = 0; ai < 2; ++ai)
#pragma unroll
            for (int m = 0; m < 4; ++m) { f32x4 a0 = acc[ai][0][m][0], a1 = acc[ai][0][m][1]; const f32x4 b0 = acc[ai][1][m][0], b1 = acc[ai][1][m][1];
                a0 = a0 * sigm4(a0) * b0; a1 = a1 * sigm4(a1) * b1;
                *(u32x4*)(HM + (size_t)(row0 + ai * HALF + m * 16) * DE + col0) = pack8(a0, a1); }
    }
};
struct EpiDown {
    static constexpr bool PERM = true, KEEPS = false; bf16_t* SL; const int* list; const float* gw; const LAS int* cum; const LAS int* cnt;
    __device__ __forceinline__ void operator()(AccRef acc, const Unit& u, int wr, int wc, int fr, int fq) const {
        const int col0 = u.pnl * BM + wc * 32 + 8 * fq; const int pos0 = (u.pm - cum[u.e]) * BM + wr * 64 + fr, n_e = cnt[u.e];
        int ent[2][4]; float w[2][4];
#pragma unroll
        for (int ai = 0; ai < 2; ++ai)
#pragma unroll
            for (int m = 0; m < 4; ++m) { const int pos = pos0 + ai * HALF + m * 16; ent[ai][m] = pos < n_e ? list[u.e * LCAP + pos] : -1; }
#pragma unroll
        for (int ai = 0; ai < 2; ++ai)
#pragma unroll
            for (int m = 0; m < 4; ++m) { const int pos = pos0 + ai * HALF + m * 16; w[ai][m] = pos < n_e ? gw[u.e * LCAP + pos] : 0.f; }
#pragma unroll
        for (int ai = 0; ai < 2; ++ai)
#pragma unroll
            for (int m = 0; m < 4; ++m) asm volatile("" : "+v"(w[ai][m]));
#pragma unroll
        for (int ai = 0; ai < 2; ++ai)
#pragma unroll
            for (int m = 0; m < 4; ++m) if (ent[ai][m] >= 0) { bf16_t* rowp = SL + (size_t)ent[ai][m] * D + col0;
#pragma unroll
                for (int bj = 0; bj < 2; ++bj) *(u32x4*)(rowp + bj * HALF) = pack8(acc[ai][bj][m][0] * w[ai][m], acc[ai][bj][m][1] * w[ai][m]); }
    }
};
}

#define XB_TMO      128
#define XB_XCNT(j)  (256  + 64 * (j))
#define XB_XSUB(j)  (1280 + 64 * (j))
#define XB_XGEN(j)  (2304 + 64 * (j))
#define XB_TOP      3328
#define XB_TOPGEN   3392
#define XCD_BAR_WORDS 3456
#define XB_SPIN_CAP (1u << 22)

__device__ __forceinline__ unsigned xb_ld(unsigned* p)              { return __hip_atomic_load(p, __ATOMIC_RELAXED, __HIP_MEMORY_SCOPE_AGENT); }
__device__ __forceinline__ unsigned xb_add(unsigned* p, unsigned v) { return __hip_atomic_fetch_add(p, v, __ATOMIC_RELAXED, __HIP_MEMORY_SCOPE_AGENT); }
__device__ __forceinline__ unsigned xb_xcc_id() { return (unsigned)__builtin_amdgcn_s_getreg((3 << 11) | 20) & 0xFu; }
#define XB_SPIN(cond, bar) do { unsigned _sp = 0; while (cond) { __builtin_amdgcn_s_sleep(1); \
    if ((++_sp & 255u) == 0u) { if (xb_ld(&(bar)[XB_TMO])) break; if (_sp > XB_SPIN_CAP) { atomicAdd(&(bar)[XB_TMO], 1u); break; } } } } while (0)

struct XcdBarrier { unsigned* bar; unsigned x; volatile LAS unsigned* st; };
__device__ __forceinline__ XcdBarrier xcd_barrier_post(unsigned* bar, volatile LAS unsigned* st) {
    XcdBarrier b; b.bar = bar; b.x = xb_xcc_id(); b.st = st;
    if (threadIdx.x == 0) (void)xb_add(&bar[XB_XCNT(b.x)], 1u);
    return b;
}
__device__ __forceinline__ void xcd_barrier_complete(unsigned* bar, unsigned x_in, unsigned& nloc, unsigned& nx) {
    unsigned x = x_in;
    const unsigned G = gridDim.x * gridDim.y * gridDim.z;
    asm volatile("" : "+s"(x));
    unsigned sum, cnt, mine, sp = 0u;
    for (;;) {
        sum = 0u; cnt = 0u; mine = 0u;
#pragma unroll
        for (unsigned j = 0; j < 16; ++j) { const unsigned c = xb_ld(&bar[XB_XCNT(j)]); sum += c; cnt += (c > 0u) ? 1u : 0u; mine = (j == x) ? c : mine; }
        if (sum == G) break;
        __builtin_amdgcn_s_sleep(1);
        if ((++sp & 255u) == 0u) { if (xb_ld(&bar[XB_TMO])) break; if (sp > XB_SPIN_CAP) { atomicAdd(&bar[XB_TMO], 1u); break; } }
    }
    nloc = mine > 0u ? mine : 1u; nx = cnt > 0u ? cnt : 1u;
}
__device__ __forceinline__ void xcd_barrier(const XcdBarrier& b, const int tid) {
    asm volatile("s_waitcnt vmcnt(0)" ::: "memory");
    __syncthreads();
    if (tid == 0) {
        unsigned* bar = b.bar;
        __builtin_amdgcn_s_waitcnt(0);
        unsigned nloc = b.st[0], nx = b.st[1];
        if (nloc == 0u) { xcd_barrier_complete(bar, b.x, nloc, nx); b.st[0] = nloc; b.st[1] = nx; }
        const unsigned old = xb_add(&bar[XB_XSUB(b.x)], 1u);
        const unsigned gen = old / nloc;
        if (old + 1u == (gen + 1u) * nloc) {
            __builtin_amdgcn_fence(__ATOMIC_RELEASE, "agent");
            asm volatile("s_waitcnt vmcnt(0)" ::: "memory");
            const unsigned og = xb_add(&bar[XB_TOP], 1u);
            const unsigned tg = og / nx;
            if (og + 1u == (tg + 1u) * nx) xb_add(&bar[XB_TOPGEN], 1u);
            else XB_SPIN(xb_ld(&bar[XB_TOPGEN]) == tg, bar);
            __builtin_amdgcn_fence(__ATOMIC_ACQUIRE, "agent");
            xb_add(&bar[XB_XGEN(b.x)], 1u);
            asm volatile("s_waitcnt vmcnt(0)" ::: "memory");
        } else {
            XB_SPIN(xb_ld(&bar[XB_XGEN(b.x)]) == gen, bar);
            __builtin_amdgcn_fence(__ATOMIC_ACQUIRE, "agent");
            asm volatile("s_waitcnt vmcnt(0)" ::: "memory");
        }
    }
    __syncthreads();
}

constexpr int NWAVES = 8, NTHREADS = 512;
constexpr int RING_BYTES = 131072, MISC_OFF = RING_BYTES, LDS_BYTES = 163840;

struct KArgs {
    const float* in[30]; float* out; unsigned char* ws; int lo, hi;
};
constexpr int PTAB = 3072, WTAB = 3200;
constexpr int PTAB_DUMMY = 0;
struct Args {
    volatile LAS int* tab;
    __device__ __forceinline__ unsigned long long ld(int k) const { const unsigned lo = (unsigned)__builtin_amdgcn_readfirstlane(tab[2 * k]), hi = (unsigned)__builtin_amdgcn_readfirstlane(tab[2 * k + 1]); return ((unsigned long long)hi << 32) | lo; }
    __device__ __forceinline__ const float* in(int k) const { return (const float*)(const GAS float*)ld(k); }
    __device__ __forceinline__ float* out() const { return (float*)(GAS float*)ld(30); }
    __device__ __forceinline__ unsigned char* ws() const { return (unsigned char*)(GAS unsigned char*)ld(31); }
};

struct Ctx {
    LAS unsigned char* lds; volatile LAS int* misc;
    int tid, lane, wave, G, bid;
    unsigned char* ws;
};

__device__ __forceinline__ const float* xrow_in(const Args& a, int row) { return row < TL ? a.in(0) + (size_t)row * D : a.in(2) + (size_t)(row - TL) * D; }
__device__ __forceinline__ int brow_of(int row) { return row < TL ? (row >> 12) : 8; }

__device__ __forceinline__ void zoh(const Args& a, int idx  , float& abr, float& abi, float& fr_, float& fi_) {
    const float are = a.in(11)[idx], aim = a.in(12)[idx]; const float dt = expf(a.in(13)[idx >> 6]);
    const float mag = expf(are * dt); abr = mag * cosf(aim * dt); abi = mag * sinf(aim * dt);
    const float nr = abr - 1.0f, ni = abi, den = are * are + aim * aim;
    fr_ = (nr * are + ni * aim) / den; fi_ = (ni * are - nr * aim) / den;
}
__device__ __forceinline__ void zoh_fast(const Args& a, int idx, float& abr, float& abi, float& fr_, float& fi_) {
    const float are = a.in(11)[idx], aim = a.in(12)[idx]; const float dt = __expf(a.in(13)[idx >> 6]);
    const float mag = __expf(are * dt); abr = mag * __cosf(aim * dt); abi = mag * __sinf(aim * dt);
    const float nr = abr - 1.0f, ni = abi, den = __builtin_amdgcn_rcpf(are * are + aim * aim);
    fr_ = (nr * are + ni * aim) * den; fi_ = (ni * are - nr * aim) * den;
}
__device__ __forceinline__ void phase_p0(const Args& a, Ctx& c) {
    LAS float* sl = (LAS float*)c.lds;
    LAS float* part = (LAS float*)(c.lds + 9 * 1024 * 4);
    for (int i = c.tid; i < 9 * 1024; i += NTHREADS) { const float v = i < 8 * 1024 ? a.in(1)[i] : a.in(3)[i - 8 * 1024]; sl[i] = v * sigm(v); }
    __syncthreads();
    float* mods = (float*)(c.ws + WS_MODS);
    for (int it = c.bid; it < DEPTH * 96; it += c.G) {
        const int l = it / 96, lg = c.lane >> 4, lc = 4 * (c.lane & 15);
        const float* bmp = a.in(5) + (size_t)l * NMOD + (it % 96) * 64;
        const float bm0 = bmp[c.tid & 63], bm1 = bmp[c.tid & 63];
        const float* w = a.in(4) + (size_t)l * D * NMOD + (it % 96) * 64 + lc;
        f32x4 acc[9];
#pragma unroll
        for (int r = 0; r < 9; ++r) acc[r] = (f32x4){0.f, 0.f, 0.f, 0.f};
#pragma unroll 1
        for (int kb = 0; kb < 32; kb += 8) {
            f32x4 wv[8];
#pragma unroll
            for (int i = 0; i < 8; ++i) wv[i] = *(const f32x4*)(w + (size_t)(c.wave * 128 + 4 * (kb + i) + lg) * NMOD);
            __builtin_amdgcn_sched_barrier(0);
#pragma unroll
            for (int i = 0; i < 8; ++i) { const int k = c.wave * 128 + 4 * (kb + i) + lg;
#pragma unroll
                for (int r = 0; r < 9; ++r) acc[r] += sl[r * 1024 + k] * wv[i]; } }
#pragma unroll
        for (int r = 0; r < 9; ++r)
#pragma unroll
            for (int e = 0; e < 4; ++e) { float v = acc[r][e]; v += shflx(v, 16, c.lane); v += shflx(v, 32, c.lane); acc[r][e] = v; }
        if (lg == 0) {
#pragma unroll
            for (int r = 0; r < 9; ++r) *(LAS f32x4*)(part + (c.wave * 9 + r) * 64 + lc) = acc[r]; }
        __syncthreads();
        for (int o = c.tid; o < 9 * 64; o += NTHREADS) { float s = 0.f;
#pragma unroll
            for (int w8 = 0; w8 < 8; ++w8) s += part[w8 * 576 + o];
            const int r = o >> 6, cc = (it % 96) * 64 + (o & 63); mods[((size_t)l * 9 + r) * NMOD + cc] = s + (o < NTHREADS ? bm0 : bm1); }
        __syncthreads();
    }
    const int gt = c.bid * NTHREADS + c.tid, GT = c.G * NTHREADS;
    f32x2* AB = (f32x2*)(c.ws + WS_AB);
    for (int i = gt; i < DEPTH * 2 * 32 * 64; i += GT) { float abr, abi, fr_, fi_; zoh(a, i, abr, abi, fr_, fi_); AB[i] = (f32x2){abr, abi}; }
    u32x4* BF = (u32x4*)(c.ws + WS_BF);
    for (int i = gt; i < DEPTH * 2 * 32 * 4 * 64; i += GT) {
        const int ln = i & 63, f = (i >> 6) & 3, ldg = i >> 8; const int ri = f >> 1, tile = f & 1, p = tile * 32 + (ln & 31), hh = ln >> 5;
        float abr, abi, fr_, fi_; zoh(a, ldg * 64 + p, abr, abi, fr_, fi_);
        const float* bre = a.in(14) + ((size_t)ldg * 64 + p) * 16 + 8 * hh; const float* bim = a.in(15) + ((size_t)ldg * 64 + p) * 16 + 8 * hh;
        const f32x4 r0 = *(const f32x4*)bre, r1 = *(const f32x4*)(bre + 4), q0 = *(const f32x4*)bim, q1 = *(const f32x4*)(bim + 4);
        float v[8];
#pragma unroll
        for (int j = 0; j < 4; ++j) { v[j] = ri == 0 ? fr_ * r0[j] - fi_ * q0[j] : fr_ * q0[j] + fi_ * r0[j]; v[4 + j] = ri == 0 ? fr_ * r1[j] - fi_ * q1[j] : fr_ * q1[j] + fi_ * r1[j]; }
        u32x4 o; o.x = f2bf(v[0]) | (f2bf(v[1]) << 16); o.y = f2bf(v[2]) | (f2bf(v[3]) << 16); o.z = f2bf(v[4]) | (f2bf(v[5]) << 16); o.w = f2bf(v[6]) | (f2bf(v[7]) << 16);
        BF[i] = o;
    }
    u32x4* CF = (u32x4*)(c.ws + WS_CF);
    for (int i = gt; i < DEPTH * 2 * 32 * 5 * 64; i += GT) {
        const int ln = i & 63, ks = (i >> 6) % 5, ldg = (i >> 6) / 5; const int j = ln & 15, q = ln >> 4; const int l = ldg >> 6, g = ldg & 31;
        const float* cre = a.in(16) + ((size_t)ldg * 16 + j) * 64; const float* cim = a.in(17) + ((size_t)ldg * 16 + j) * 64;
        float v[8];
        if (ks < 4) { const int n0 = 8 * ks + 2 * q;
            const float a0 = cre[n0], a1 = cre[n0 + 1], a2 = cre[n0 + 32], a3 = cre[n0 + 33], b0 = cim[n0], b1 = cim[n0 + 1], b2 = cim[n0 + 32], b3 = cim[n0 + 33];
            v[0] = a0; v[1] = -b0; v[2] = a2; v[3] = -b2; v[4] = a1; v[5] = -b1; v[6] = a3; v[7] = -b3;
        } else { const float dv = a.in(18)[l * 512 + g * 16 + j];
#pragma unroll
            for (int e = 0; e < 8; ++e) v[e] = (8 * q + e == j) ? dv : 0.f; }
        u32x4 o; o.x = f2bf(v[0]) | (f2bf(v[1]) << 16); o.y = f2bf(v[2]) | (f2bf(v[3]) << 16); o.z = f2bf(v[4]) | (f2bf(v[5]) << 16); o.w = f2bf(v[6]) | (f2bf(v[7]) << 16);
        CF[i] = o;
    }
}

__device__ __forceinline__ void s3_tables(const Args& a, Ctx& c, const int wi, const int nw) {
    u32x4* TB = (u32x4*)(c.ws + WS_S3T);
    __syncthreads();
    LAS float* sC = (LAS float*)c.lds;
    LAS float* sB = sC + 2 * 16 * 65;
    LAS float* sA = sB + 2048;
    LAS float* sK = sA + 256;
    for (int ldg = wi; ldg < DEPTH * 2 * 32; ldg += nw) {
        const int l = ldg >> 6, dir = (ldg >> 5) & 1, g = ldg & 31;
        __syncthreads();
        static_assert(NTHREADS == 512, "two elements per thread");
        const float* pcr = a.in(16) + (size_t)ldg * 1024 + c.tid; const float* pci = a.in(17) + (size_t)ldg * 1024 + c.tid; const float* pbr = a.in(14) + (size_t)ldg * 1024 + c.tid; const float* pbi = a.in(15) + (size_t)ldg * 1024 + c.tid;
        const float c0r = pcr[0], c1r = pcr[512], c0i = pci[0], c1i = pci[512], b0r = pbr[0], b1r = pbr[512], b0i = pbi[0], b1i = pbi[512];
        if (c.tid < 64) { float abr, abi, fr_, fi_; zoh(a, ldg * 64 + c.tid, abr, abi, fr_, fi_); sA[4 * c.tid] = abr; sA[4 * c.tid + 1] = abi; sA[4 * c.tid + 2] = fr_; sA[4 * c.tid + 3] = fi_; }
        { const int i0 = c.tid, i1 = c.tid + 512; sC[(i0 >> 6) * 65 + (i0 & 63)] = c0r; sC[16 * 65 + (i0 >> 6) * 65 + (i0 & 63)] = c0i; sC[(i1 >> 6) * 65 + (i1 & 63)] = c1r; sC[16 * 65 + (i1 >> 6) * 65 + (i1 & 63)] = c1i; }
        __syncthreads();
        { const int i0 = c.tid, i1 = c.tid + 512; const float f0r = sA[4 * (i0 >> 4) + 2], f0i = sA[4 * (i0 >> 4) + 3], f1r = sA[4 * (i1 >> 4) + 2], f1i = sA[4 * (i1 >> 4) + 3];
            sB[i0] = f0r * b0r - f0i * b0i; sB[1024 + i0] = f0r * b0i + f0i * b0r; sB[i1] = f1r * b1r - f1i * b1i; sB[1024 + i1] = f1r * b1i + f1i * b1r; }
        __syncthreads();
        for (int idx = c.tid; idx < 1024; idx += NTHREADS) { const int dd = idx >> 8, o = (idx >> 4) & 15, j = idx & 15; float acc = 0.f;
#pragma unroll 1
            for (int n0 = 0; n0 < 64; n0 += 8) {
                f32x4 ab[8]; float cr[8], ci[8], br[8], bi[8];
#pragma unroll
                for (int q = 0; q < 8; ++q) { const int n = n0 + q; ab[q] = *(const LAS f32x4*)(sA + 4 * n); cr[q] = sC[o * 65 + n]; ci[q] = sC[16 * 65 + o * 65 + n]; br[q] = sB[n * 16 + j]; bi[q] = sB[1024 + n * 16 + j]; }
                __builtin_amdgcn_sched_barrier(0);
#pragma unroll
                for (int q = 0; q < 8; ++q) { float pr = 1.f, pi = 0.f;
#pragma unroll
                    for (int e = 0; e < 3; ++e) if (e < dd) { const float t = pr * ab[q][0] - pi * ab[q][1], u = pr * ab[q][1] + pi * ab[q][0]; pr = t; pi = u; }
                    const float Gr = cr[q] * pr - ci[q] * pi, Gi = cr[q] * pi + ci[q] * pr; acc += Gr * br[q] - Gi * bi[q]; } }
            sK[idx] = acc; }
        __syncthreads();
        for (int en = c.tid; en < 40 * 64; en += NTHREADS) {
        const int ln = en & 63, f = en >> 6; const int col = ln & 31, kh = ln >> 5;
        float v[8];
#pragma unroll
        for (int j = 0; j < 8; ++j) v[j] = 0.f;
        if (f < 24) { const int ks = f / 6, nb = f % 6;
            if (nb < 4) { const int pst = (nb & 1) * 32 + col, comp = nb >> 1; const f32x4 ab = *(const LAS f32x4*)(sA + 4 * pst);
                const f32x4 br0 = *(const LAS f32x4*)(sB + pst * 16 + 8 * kh), br1 = *(const LAS f32x4*)(sB + pst * 16 + 8 * kh + 4), bi0 = *(const LAS f32x4*)(sB + 1024 + pst * 16 + 8 * kh), bi1 = *(const LAS f32x4*)(sB + 1024 + pst * 16 + 8 * kh + 4);
                float pr = 1.f, pi = 0.f; for (int e = 0; e < 3 - ks; ++e) { const float t = pr * ab[0] - pi * ab[1], u = pr * ab[1] + pi * ab[0]; pr = t; pi = u; }
#pragma unroll
                for (int j = 0; j < 4; ++j) { v[j] = comp == 0 ? pr * br0[j] - pi * bi0[j] : pr * bi0[j] + pi * br0[j]; v[4 + j] = comp == 0 ? pr * br1[j] - pi * bi1[j] : pr * bi1[j] + pi * br1[j]; }
            } else { const int sp = 2 * (nb - 4) + (col >> 4), o = col & 15, s1 = dir == 0 ? sp : 3 - sp;
                const int dd = s1 - ks;
                if (dd >= 0) { const f32x4 k0 = *(const LAS f32x4*)(sK + (dd * 16 + o) * 16 + 8 * kh), k1 = *(const LAS f32x4*)(sK + (dd * 16 + o) * 16 + 8 * kh + 4);
#pragma unroll
                    for (int j = 0; j < 4; ++j) { v[j] = k0[j]; v[4 + j] = k1[j]; } }
                if (dir == 0 && dd == 0) { const float dv = a.in(18)[l * 512 + g * 16 + o];
#pragma unroll
                    for (int j = 0; j < 8; ++j) v[j] += (8 * kh + j == o) ? dv : 0.f; } }
        } else { const int kk = (f - 24) >> 1, nb = (f - 24) & 1; const int sp = 2 * nb + (col >> 4), o = col & 15, s1 = dir == 0 ? sp : 3 - sp;
            f32x4 ab[4]; float cr[4], ci[4];
#pragma unroll
            for (int q = 0; q < 4; ++q) { const int n = 8 * kk + 4 * kh + q; ab[q] = *(const LAS f32x4*)(sA + 4 * n); cr[q] = sC[o * 65 + n]; ci[q] = sC[16 * 65 + o * 65 + n]; }
            __builtin_amdgcn_sched_barrier(0);
#pragma unroll
            for (int q = 0; q < 4; ++q) { float pr = ab[q][0], pi = ab[q][1];
#pragma unroll
                for (int e = 0; e < 3; ++e) if (e < s1) { const float t = pr * ab[q][0] - pi * ab[q][1], u = pr * ab[q][1] + pi * ab[q][0]; pr = t; pi = u; }
                const float Gr = cr[q] * pr - ci[q] * pi, Gi = cr[q] * pi + ci[q] * pr; v[2 * q] = Gr; v[2 * q + 1] = -Gi; } }
        u32x4 o4; o4.x = f2bf(v[0]) | (f2bf(v[1]) << 16); o4.y = f2bf(v[2]) | (f2bf(v[3]) << 16); o4.z = f2bf(v[4]) | (f2bf(v[5]) << 16); o4.w = f2bf(v[6]) | (f2bf(v[7]) << 16);
        TB[(size_t)ldg * 2560 + en] = o4;
        }
    }
    __syncthreads();
}

template <class RowMap>
__device__ __forceinline__ void tr_item(const float* W, int ldn, int K, bf16_t* WT, const RowMap& rm, LAS bf16_t* scr, int kb, int nb, int lane) {
    const int k0 = 64 * kb, n0 = 64 * nb;
    f32x4 x[16];
#pragma unroll
    for (int i = 0; i < 16; ++i) x[i] = __builtin_nontemporal_load((const f32x4*)(W + (size_t)(k0 + 4 * i + (lane >> 4)) * ldn + n0 + (lane & 15) * 4));
#pragma unroll
    for (int i = 0; i < 16; ++i) { u32x2 w; w.x = pk2(x[i][0], x[i][1]); w.y = pk2(x[i][2], x[i][3]); *(LAS u32x2*)(scr + (4 * i + (lane >> 4)) * 72 + (lane & 15) * 4) = w; }
    LDS_WAIT(); asm volatile("" ::: "memory");
    const int cch = lane & 7;
#pragma unroll
    for (int j = 0; j < 8; ++j) { const int n = (lane >> 3) + 8 * j; const LAS bf16_t* sp = scr + (8 * cch) * 72 + n;
        u32x4 o; o.x = (unsigned)sp[0] | ((unsigned)sp[72] << 16); o.y = (unsigned)sp[2 * 72] | ((unsigned)sp[3 * 72] << 16); o.z = (unsigned)sp[4 * 72] | ((unsigned)sp[5 * 72] << 16); o.w = (unsigned)sp[6 * 72] | ((unsigned)sp[7 * 72] << 16);
        *(u32x4*)(WT + (size_t)rm(n0 + n) * K + k0 + 8 * cch) = o; }
    LDS_WAIT(); asm volatile("" ::: "memory");
}
struct RmId { int off; __device__ __forceinline__ int operator()(int n) const { return off + n; } };
struct RmW13 { int off; __device__ __forceinline__ int operator()(int n) const { return off + 256 * (n >> 7) + (n & 127); } };

__device__ __forceinline__ void norm_row(const Args& a, Ctx& c, int l, int row, int which  , f32x4 (&v)[4]) {
    float s = 0.f;
#pragma unroll
    for (int j = 0; j < 4; ++j) s += (v[j][0] * v[j][0] + v[j][1] * v[j][1]) + (v[j][2] * v[j][2] + v[j][3] * v[j][3]);
    const float rstd = 1.0f / sqrtf(wave_sum(s, c.lane) * (1.0f / D) + RMS_EPS);
    const float* gn = a.in(which ? 7 : 6) + (size_t)l * D; const float* md = (const float*)(c.ws + WS_MODS) + ((size_t)l * 9 + brow_of(row)) * NMOD + (which ? 3 * D : 0);
#pragma unroll
    for (int j = 0; j < 4; ++j) { const int col = 4 * c.lane + 256 * j; const f32x4 g = *(const f32x4*)(gn + col), sh = *(const f32x4*)(md + col), sc = *(const f32x4*)(md + D + col);
        v[j] = v[j] * rstd * g * (1.0f + sc) + sh; }
}
__device__ __forceinline__ void store_row_bf16(bf16_t* dst, int lane, const f32x4 (&v)[4]) {
#pragma unroll
    for (int j = 0; j < 4; ++j) { u32x2 w; w.x = pk2(v[j][0], v[j][1]); w.y = pk2(v[j][2], v[j][3]); *(u32x2*)(dst + 4 * lane + 256 * j) = w; }
}
__device__ __forceinline__ void load_x_row(const Args& a, Ctx& c, int l, int row, f32x4 (&v)[4]) {
    if (l == 0) { const float* xs = xrow_in(a, row); bf16_t* xb = (bf16_t*)(c.ws + WS_XB) + (size_t)row * D;
#pragma unroll
        for (int j = 0; j < 4; ++j) { v[j] = *(const f32x4*)(xs + 4 * c.lane + 256 * j); st_bf4(xb + 4 * c.lane + 256 * j, v[j]); }
    } else {
        bf16_t* xb = (bf16_t*)(c.ws + WS_XB) + (size_t)row * D;
        const bf16_t* sl = (const bf16_t*)(c.ws + WS_Z) + (size_t)row * 2 * D; const float* g2 = (const float*)(c.ws + WS_MODS) + ((size_t)(l - 1) * 9 + brow_of(row)) * NMOD + 5 * D;
#pragma unroll
        for (int j = 0; j < 4; ++j) { const int col = 4 * c.lane + 256 * j; const f32x4 g = *(const f32x4*)(g2 + col);
            v[j] = ld_bf4(xb + col) + g * (ld_bf4(sl + col) + ld_bf4(sl + D + col)); }
#pragma unroll
        for (int j = 0; j < 4; ++j) st_bf4(xb + 4 * c.lane + 256 * j, v[j]);
    }
}
constexpr int TR_I_IN = 16 * 48, TR_I_BS = 8 * 16, TR_I_OUT = 16 * 16, TR_I_GLU = 8 * 8, TR_I_W1 = 16 * 16 * 8, TR_I_W3 = TR_I_W1, TR_I_W2 = 16 * 8 * 16, TR_I_WC = 512;
constexpr int TR_NITEMS = TR_I_IN + TR_I_BS + TR_I_OUT + TR_I_GLU + TR_I_W1 + TR_I_W3 + TR_I_W2 + TR_I_WC;
struct RmGen { int off, w13; __device__ __forceinline__ int operator()(int n) const { return off + (w13 == 1 ? 256 * (n >> 7) + (n & 127) : (w13 == 2 && n >= 1024) ? 1024 + 256 * (((n - 1024) & 1023) >> 7) + 128 * ((n - 1024) >> 10) + (n & 127) : n); } };
__device__ __forceinline__ size_t wbuf_off(int l) { return (l & 1) ? WS_W2ND : WS_W; }
__device__ __forceinline__ void tr_one(const Args& a, Ctx& c, int l, int it, LAS bf16_t* scr) {
    bf16_t* WB = (bf16_t*)(c.ws + wbuf_off(l));
    int r = it;
    if (r < TR_NITEMS - TR_I_WC) {
        const float* src; int ldn, K, kb, nb; bf16_t* dst; RmGen rm{0, 0};
        if (r < TR_I_IN) { src = a.in(8) + (size_t)l * D * NZ; ldn = NZ; K = D; dst = WB + WO_WIN / 2; rm = RmGen{0, 2}; kb = r % 16; nb = r / 16; }
        else if ((r -= TR_I_IN) < TR_I_BS) { src = a.in(22) + (size_t)l * 512 * D; ldn = D; K = 512; dst = WB + WO_WBS / 2; kb = r % 8; nb = r / 8; }
        else if ((r -= TR_I_BS) < TR_I_OUT) { src = a.in(23) + (size_t)l * D * D; ldn = D; K = D; dst = WB + WO_WOUT / 2; kb = r % 16; nb = r / 16; }
        else if ((r -= TR_I_OUT) < TR_I_GLU) { src = a.in(19) + (size_t)l * 512 * 512; ldn = 512; K = 512; dst = WB + WO_GLU / 2; kb = r % 8; nb = r / 8; }
        else if ((r -= TR_I_GLU) < TR_I_W1) { const int e = r >> 7, q = r & 127; src = a.in(26) + ((size_t)l * NE + e) * D * DE; ldn = DE; K = D; dst = WB + WO_W13 / 2; rm = RmGen{e * 1024, 1}; kb = q % 16; nb = q / 16; }
        else if ((r -= TR_I_W1) < TR_I_W3) { const int e = r >> 7, q = r & 127; src = a.in(27) + ((size_t)l * NE + e) * D * DE; ldn = DE; K = D; dst = WB + WO_W13 / 2; rm = RmGen{e * 1024 + 128, 1}; kb = q % 16; nb = q / 16; }
        else { r -= TR_I_W3; const int e = r >> 7, q = r & 127; src = a.in(28) + ((size_t)l * NE + e) * DE * D; ldn = D; K = DE; dst = WB + WO_W2 / 2; rm = RmGen{e * 1024, 0}; kb = q % 8; nb = q / 8; }
        tr_item(src, ldn, K, dst, rm, scr, kb, nb, c.lane);
    } else {
        r -= TR_NITEMS - TR_I_WC;
        {
            const int g = r >> 7, cb = (r >> 4) & 7, db = r & 15, lg = c.lane >> 4, ld = c.lane & 15, b4 = lg & 1, b5 = lg >> 1, d = db * 64 + 4 * ld + 2 * b4 + b5;
            const float* pw = a.in(9) + ((size_t)l * 4 + g) * 128 * 128 + (size_t)(cb * 16) * 128; const float* ps = a.in(10) + (size_t)l * 512 + g * 128;
            const float* wb = a.in(21) + ((size_t)l * 512 + g * 128) * D + db * 64 + 4 * ld;
            LAS float* pl = (LAS float*)scr;
#pragma unroll
            for (int i = 0; i < 8; ++i) { const int e = i * 256 + c.lane * 4, q = e >> 7, c2 = e & 127; const f32x4 x = *(const f32x4*)(pw + e), sc4 = *(const f32x4*)(ps + c2);
                pl[(c2 + 0) * 16 + q] = x[0] * sc4[0]; pl[(c2 + 1) * 16 + q] = x[1] * sc4[1]; pl[(c2 + 2) * 16 + q] = x[2] * sc4[2]; pl[(c2 + 3) * 16 + q] = x[3] * sc4[3]; }
            LDS_WAIT(); asm volatile("" ::: "memory");
            f32x4 acc[16];
#pragma unroll
            for (int q = 0; q < 16; ++q) acc[q] = (f32x4){0.f, 0.f, 0.f, 0.f};
#pragma unroll 1
            for (int kb = 0; kb < 32; kb += 8) {
                f32x4 xq[8];
#pragma unroll
                for (int i = 0; i < 8; ++i) xq[i] = *(const f32x4*)(wb + (size_t)(4 * (kb + i) + lg) * D);
                __builtin_amdgcn_sched_barrier(0);
#pragma unroll
                for (int i = 0; i < 8; ++i) { const int c2 = 4 * (kb + i) + lg; const f32x4 x = xq[i]; const LAS f32x4* p4 = (const LAS f32x4*)(pl + c2 * 16);
#pragma unroll
                    for (int q4 = 0; q4 < 4; ++q4) { const f32x4 w4 = p4[q4]; acc[q4 * 4 + 0] += w4[0] * x; acc[q4 * 4 + 1] += w4[1] * x; acc[q4 * 4 + 2] += w4[2] * x; acc[q4 * 4 + 3] += w4[3] * x; } } }
            float av[16];
#pragma unroll
            for (int q = 0; q < 16; ++q) {
                const float k0 = b4 ? acc[q][2] : acc[q][0], s0 = b4 ? acc[q][0] : acc[q][2], k1 = b4 ? acc[q][3] : acc[q][1], s1 = b4 ? acc[q][1] : acc[q][3];
                const float t0 = k0 + shflx(s0, 16, c.lane), t1 = k1 + shflx(s1, 16, c.lane);
                const float kk2 = b5 ? t1 : t0, ss2 = b5 ? t0 : t1; av[q] = kk2 + shflx(ss2, 32, c.lane); }
            u32x4 o0, o1; o0.x = pk2(av[0], av[1]); o0.y = pk2(av[2], av[3]); o0.z = pk2(av[4], av[5]); o0.w = pk2(av[6], av[7]);
            o1.x = pk2(av[8], av[9]); o1.y = pk2(av[10], av[11]); o1.z = pk2(av[12], av[13]); o1.w = pk2(av[14], av[15]);
            bf16_t* dst = WB + WO_WC / 2 + (size_t)d * 512 + g * 128 + cb * 16; *(u32x4*)dst = o0; *(u32x4*)(dst + 8) = o1;
            LDS_WAIT(); asm volatile("" ::: "memory");
        }
    }
}
__device__ __forceinline__ void tr_range(const Args& a, Ctx& c, int l, int first, int last, int w, int nw) {
    LAS bf16_t* scr = (LAS bf16_t*)(c.lds + c.wave * 16384);
#pragma unroll 1
    for (int it = first + w; it < last; it += nw) tr_one(a, c, l, it, scr);
}
constexpr int TR_SPLIT = 3000, TR_SPLIT2 = 5500;
__device__ __forceinline__ int ncol(int lane, int j) { return 8 * lane + 512 * (j >> 1) + 4 * (j & 1); }
__device__ __forceinline__ void phase_a(const Args& a, Ctx& c, int l, const bool dummy = false) {
    bf16_t* H = (bf16_t*)(c.ws + (dummy ? WS_HMID : WS_H)); bf16_t* XB = (bf16_t*)(c.ws + WS_XB); bf16_t* XBW = (bf16_t*)(c.ws + (dummy ? WS_HMID : WS_XB));
    const int rpb = (T + c.G - 1) / c.G, rbeg = c.bid * rpb + c.wave, rend = (c.bid + 1) * rpb < T ? (c.bid + 1) * rpb : T;
    f32x4 pg[4], psh[4], pg2[4], nf[4]; int cur_b = -1; u32x4 nx[2], ns0[2], ns1[2];
    for (int row = rbeg; row < rend; row += NWAVES) {
        const int br = brow_of(row);
        if (br != cur_b) { cur_b = br;
            const float* gn = a.in(6) + (size_t)l * D; const float* md = (const float*)(c.ws + WS_MODS) + ((size_t)l * 9 + br) * NMOD;
            const float* g2 = (const float*)(c.ws + WS_MODS) + ((size_t)(l > 0 ? l - 1 : 0) * 9 + br) * NMOD + 5 * D;
#pragma unroll
            for (int j = 0; j < 4; ++j) { const int col = ncol(c.lane, j); pg[j] = *(const f32x4*)(gn + col) * (1.0f + *(const f32x4*)(md + D + col)); psh[j] = *(const f32x4*)(md + col); pg2[j] = *(const f32x4*)(g2 + col); } }
        f32x4 v[4];
        if (l == 0) {
            if (row == rbeg) { const float* xs = xrow_in(a, row);
#pragma unroll
                for (int j = 0; j < 4; ++j) nf[j] = *(const f32x4*)(xs + ncol(c.lane, j)); }
#pragma unroll
            for (int j = 0; j < 4; ++j) v[j] = nf[j];
            if (row + NWAVES < rend) { const float* xs = xrow_in(a, row + NWAVES);
#pragma unroll
                for (int j = 0; j < 4; ++j) nf[j] = *(const f32x4*)(xs + ncol(c.lane, j)); }
        } else {
            if (row == rbeg) { const bf16_t* xb = XB + (size_t)row * D; const bf16_t* sl = (const bf16_t*)(c.ws + WS_Z) + (size_t)row * 2 * D;
#pragma unroll
                for (int k = 0; k < 2; ++k) { const int col = 8 * c.lane + 512 * k; nx[k] = *(const u32x4*)(xb + col); ns0[k] = *(const u32x4*)(sl + col); ns1[k] = *(const u32x4*)(sl + D + col); } }
            u32x4 cx[2], cs0[2], cs1[2];
#pragma unroll
            for (int k = 0; k < 2; ++k) { cx[k] = nx[k]; cs0[k] = ns0[k]; cs1[k] = ns1[k]; }
            if (row + NWAVES < rend) { const bf16_t* xb = XB + (size_t)(row + NWAVES) * D; const bf16_t* sl = (const bf16_t*)(c.ws + WS_Z) + (size_t)(row + NWAVES) * 2 * D;
#pragma unroll
                for (int k = 0; k < 2; ++k) { const int col = 8 * c.lane + 512 * k; nx[k] = *(const u32x4*)(xb + col); ns0[k] = *(const u32x4*)(sl + col); ns1[k] = *(const u32x4*)(sl + D + col); } }
#pragma unroll
            for (int k = 0; k < 2; ++k) { f32x4 xa, xc, sa, sc, ta, tc2; pg8::unpack8(cx[k], xa, xc); pg8::unpack8(cs0[k], sa, sc); pg8::unpack8(cs1[k], ta, tc2);
                v[2 * k] = xa + pg2[2 * k] * (sa + ta); v[2 * k + 1] = xc + pg2[2 * k + 1] * (sc + tc2); } }
        float ss = 0.f;
#pragma unroll
        for (int k = 0; k < 2; ++k) { *(u32x4*)(XBW + (size_t)row * D + 8 * c.lane + 512 * k) = pg8::pack8(v[2 * k], v[2 * k + 1]); }
#pragma unroll
        for (int j = 0; j < 4; ++j) ss += (v[j][0] * v[j][0] + v[j][1] * v[j][1]) + (v[j][2] * v[j][2] + v[j][3] * v[j][3]);
        const float rstd = 1.0f / sqrtf(wave_sum(ss, c.lane) * (1.0f / D) + RMS_EPS);
#pragma unroll
        for (int j = 0; j < 4; ++j) v[j] = v[j] * rstd * pg[j] + psh[j];
#pragma unroll
        for (int k = 0; k < 2; ++k) *(u32x4*)(H + (size_t)row * D + 8 * c.lane + 512 * k) = pg8::pack8(v[2 * k], v[2 * k + 1]);
    }
}

__device__ __forceinline__ float fma_v(float a, float b, float c) { float d; asm("v_fma_f32 %0, %1, %2, %3" : "=v"(d) : "v"(a), "v"(b), "v"(c)); return d; }
__device__ __forceinline__ int tok_row(int b, int tc, int i) { return tc < 4 ? TL + b * CTXL + tc * 64 + i : b * SEQ + (tc - 4) * 64 + i; }
__device__ __forceinline__ int scan_chunk(int tc, int dir) { return dir == 0 ? tc : (tc < 4 ? 3 - tc : 71 - tc); }
__device__ __forceinline__ size_t car_idx(int b, int g, int dir, int cc, int n) { return ((((size_t)b * 32 + g) * 2 + dir) * NCH + cc) * 32 + n; }

#define S5_TILE(READ, dirv, tau)                                                                                                               \
    {                                                                                                                                          \
        const int r_ = lane & 31, sq_ = (r_ >> 2) & 1, stp_ = (r_ & 3) + 4 * (r_ >> 3);                                                        \
        const int ti_ = (dirv) == 0 ? 16 * (tau) + stp_ : 16 * (tau) + 15 - stp_;                                                              \
        const bf16x8 af_ = *(const bf16x8*)(Z + (size_t)tok_row(2 * bp + sq_, tc, ti_) * NZ + 512 + 16 * g + 8 * hh);                          \
        __builtin_amdgcn_sched_barrier(0);                                                                                                     \
        const f32x16 z16_ = {0.f, 0.f, 0.f, 0.f, 0.f, 0.f, 0.f, 0.f, 0.f, 0.f, 0.f, 0.f, 0.f, 0.f, 0.f, 0.f};                                  \
        f32x16 ur0_ = __builtin_amdgcn_mfma_f32_32x32x16_bf16(af_, bfr[0], z16_, 0, 0, 0);                                               \
        f32x16 ur1_ = __builtin_amdgcn_mfma_f32_32x32x16_bf16(af_, bfr[1], z16_, 0, 0, 0);                                               \
        f32x16 ui0_ = __builtin_amdgcn_mfma_f32_32x32x16_bf16(af_, bfr[2], z16_, 0, 0, 0);                                               \
        f32x16 ui1_ = __builtin_amdgcn_mfma_f32_32x32x16_bf16(af_, bfr[3], z16_, 0, 0, 0);                                                     \
        __builtin_amdgcn_sched_barrier(0);                                                                                                     \
        asm volatile("s_nop 15\n\ts_nop 15" : "+v"(ur0_), "+v"(ur1_), "+v"(ui0_), "+v"(ui1_) : "v"(af_), "v"(bfr[0]), "v"(bfr[1]), "v"(bfr[2]), "v"(bfr[3]));   \
        __builtin_amdgcn_sched_barrier(0);                                                                                                     \
        _Pragma("unroll") for (int i_ = 0; i_ < 16; ++i_) {                                                                                    \
              \
            const float n0_ = fma_v(ar0, hr0, fma_v(nai0, hi0, ur0_[i_])), m0_ = fma_v(ar0, hi0, fma_v(ai0, hr0, ui0_[i_]));                    \
            const float n1_ = fma_v(ar1, hr1, fma_v(nai1, hi1, ur1_[i_])), m1_ = fma_v(ar1, hi1, fma_v(ai1, hr1, ui1_[i_]));                    \
            hr0 = n0_; hi0 = m0_; hr1 = n1_; hi1 = m1_;                                                                                        \
            if (READ) { u32x2 w_; w_.x = pk2(hr0, hi0); w_.y = pk2(hr1, hi1); *(LAS u32x2*)(img + (hh * 16 + i_) * IMG_STRIDE + (lane & 31) * 8) = w_; } \
        }                                                                                                                                      \
        if (READ && (dirv) == 0) *(LAS bf16x8*)(img + (sq_ * 16 + stp_) * IMG_STRIDE + 256 + hh * 16) = af_;                                   \
    }

#define S5_TILEP(READ, dirv, tau, afv)                                                                                                               \
    {                                                                                                                                          \
        const int r_ = lane & 31, sq_ = (r_ >> 2) & 1, stp_ = (r_ & 3) + 4 * (r_ >> 3);                                                        \
        const int ti_ = (dirv) == 0 ? 16 * (tau) + stp_ : 16 * (tau) + 15 - stp_;                                                              \
        const bf16x8 af_ = (afv);                          \
        __builtin_amdgcn_sched_barrier(0);                                                                                                     \
        const f32x16 z16_ = {0.f, 0.f, 0.f, 0.f, 0.f, 0.f, 0.f, 0.f, 0.f, 0.f, 0.f, 0.f, 0.f, 0.f, 0.f, 0.f};                                  \
        f32x16 ur0_ = __builtin_amdgcn_mfma_f32_32x32x16_bf16(af_, bfr[0], z16_, 0, 0, 0);                                               \
        f32x16 ur1_ = __builtin_amdgcn_mfma_f32_32x32x16_bf16(af_, bfr[1], z16_, 0, 0, 0);                                               \
        f32x16 ui0_ = __builtin_amdgcn_mfma_f32_32x32x16_bf16(af_, bfr[2], z16_, 0, 0, 0);                                               \
        f32x16 ui1_ = __builtin_amdgcn_mfma_f32_32x32x16_bf16(af_, bfr[3], z16_, 0, 0, 0);                                                     \
        __builtin_amdgcn_sched_barrier(0);                                                                                                     \
        asm volatile("s_nop 15\n\ts_nop 15" : "+v"(ur0_), "+v"(ur1_), "+v"(ui0_), "+v"(ui1_) : "v"(af_), "v"(bfr[0]), "v"(bfr[1]), "v"(bfr[2]), "v"(bfr[3]));   \
        __builtin_amdgcn_sched_barrier(0);                                                                                                     \
        _Pragma("unroll") for (int i_ = 0; i_ < 16; ++i_) {                                                                                    \
              \
            const float n0_ = fma_v(ar0, hr0, fma_v(nai0, hi0, ur0_[i_])), m0_ = fma_v(ar0, hi0, fma_v(ai0, hr0, ui0_[i_]));                    \
            const float n1_ = fma_v(ar1, hr1, fma_v(nai1, hi1, ur1_[i_])), m1_ = fma_v(ar1, hi1, fma_v(ai1, hr1, ui1_[i_]));                    \
            hr0 = n0_; hi0 = m0_; hr1 = n1_; hi1 = m1_;                                                                                        \
            if (READ) { u32x2 w_; w_.x = pk2(hr0, hi0); w_.y = pk2(hr1, hi1); *(LAS u32x2*)(img + (hh * 16 + i_) * IMG_STRIDE + (lane & 31) * 8) = w_; } \
        }                                                                                                                                      \
        if (READ && (dirv) == 0) *(LAS bf16x8*)(img + (sq_ * 16 + stp_) * IMG_STRIDE + 256 + hh * 16) = af_;                                   \
    }

__device__ __forceinline__ bf16x8 s5_afrag(const bf16_t* Z, int bp, int tc, int g, int dir, int tau, int lane) {
    const int r = lane & 31, sq = (r >> 2) & 1, stp = (r & 3) + 4 * (r >> 3), hh = lane >> 5;
    const int ti = dir == 0 ? 16 * tau + stp : 16 * tau + 15 - stp;
    return *(const bf16x8*)(Z + ((size_t)g * T + tok_row(2 * bp + sq, tc, ti)) * 16 + 8 * hh);
}
__device__ __forceinline__ bf16x8 s1_afrag(const bf16_t* Z, int bp, int tc, int g, int dir, int ks, int lane) {
    const int r = lane & 31, sq = (r >> 2) & 1, b4 = (r & 3) + 4 * (r >> 3), hh = lane >> 5;
    const int sg = 4 * b4 + ks, ti = dir == 0 ? sg : 63 - sg;
    return *(const bf16x8*)(Z + ((size_t)g * T + tok_row(2 * bp + sq, tc, ti)) * 16 + 8 * hh);
}
__device__ __forceinline__ void phase_s1(const Args& a, Ctx& c, int l, size_t dst_off = WS_CAR) {
    const bf16_t* Z = (const bf16_t*)(c.ws + WS_U); f32x4* CAR = (f32x4*)(c.ws + dst_off);
    const f32x2* AB = (const f32x2*)(c.ws + WS_AB); const bf16x8* BF = (const bf16x8*)(c.ws + WS_BF);
    const int lane = c.lane, hh = lane >> 5;
    constexpr int NT1 = 4 * NCH * 8;
    const int dir = c.wave & 1;
    int cur_ldg = -1; float qr0 = 0.f, qi0 = 0.f, qr1 = 0.f, qi1 = 0.f, nqi0 = 0.f, nqi1 = 0.f; bf16x8 W[4][4], afc[4], afn[4];
#pragma unroll
    for (int f = 0; f < 4; ++f) { afc[f] = (bf16x8){0, 0, 0, 0, 0, 0, 0, 0}; afn[f] = afc[f];
#pragma unroll
        for (int k = 0; k < 4; ++k) W[k][f] = afc[f]; }
    if (c.bid < NT1) { const int bt = c.bid, rest = bt >> 3, tc = rest % NCH, bp = rest / NCH, g = (bt & 7) * 4 + (c.wave >> 1);
#pragma unroll
        for (int ks = 0; ks < 4; ++ks) afc[ks] = s1_afrag(Z, bp, tc, g, dir, ks, lane); }
    for (int bt = c.bid; bt < NT1; bt += c.G) {
        const int gq = bt & 7, rest = bt >> 3, tc = rest % NCH, bp = rest / NCH; const int g = gq * 4 + (c.wave >> 1);
        const int ldg = (l * 2 + dir) * 32 + g;
        if (ldg != cur_ldg) { cur_ldg = ldg;
            const f32x2 a0 = AB[ldg * 64 + (lane & 31)], a1 = AB[ldg * 64 + 32 + (lane & 31)];
            u32x4 bw[4];
#pragma unroll
            for (int f = 0; f < 4; ++f) bw[f] = __builtin_bit_cast(u32x4, BF[(ldg * 4 + f) * 64 + lane]);
            f32x4 br0a, br0b, br1a, br1b, bi0a, bi0b, bi1a, bi1b; pg8::unpack8(bw[0], br0a, br0b); pg8::unpack8(bw[1], br1a, br1b); pg8::unpack8(bw[2], bi0a, bi0b); pg8::unpack8(bw[3], bi1a, bi1b);
            float pr0 = 1.f, pi0 = 0.f, pr1 = 1.f, pi1 = 0.f;
#pragma unroll
            for (int ks = 3; ks >= 0; --ks) {
                W[ks][0] = __builtin_bit_cast(bf16x8, pg8::pack8(br0a * pr0 - bi0a * pi0, br0b * pr0 - bi0b * pi0));
                W[ks][1] = __builtin_bit_cast(bf16x8, pg8::pack8(br1a * pr1 - bi1a * pi1, br1b * pr1 - bi1b * pi1));
                W[ks][2] = __builtin_bit_cast(bf16x8, pg8::pack8(bi0a * pr0 + br0a * pi0, bi0b * pr0 + br0b * pi0));
                W[ks][3] = __builtin_bit_cast(bf16x8, pg8::pack8(bi1a * pr1 + br1a * pi1, bi1b * pr1 + br1b * pi1));
                const float t0 = pr0 * a0.x - pi0 * a0.y, u0 = pr0 * a0.y + pi0 * a0.x, t1 = pr1 * a1.x - pi1 * a1.y, u1 = pr1 * a1.y + pi1 * a1.x; pr0 = t0; pi0 = u0; pr1 = t1; pi1 = u1; }
            qr0 = pr0; qi0 = pi0; nqi0 = -pi0; qr1 = pr1; qi1 = pi1; nqi1 = -pi1; }
        const int nb = bt + c.G;
        if (nb < NT1) { const int nrest = nb >> 3, ntc = nrest % NCH, nbp = nrest / NCH, ng = (nb & 7) * 4 + (c.wave >> 1);
#pragma unroll
            for (int ks = 0; ks < 4; ++ks) afn[ks] = s1_afrag(Z, nbp, ntc, ng, dir, ks, lane); }
        const f32x16 z16 = {0.f, 0.f, 0.f, 0.f, 0.f, 0.f, 0.f, 0.f, 0.f, 0.f, 0.f, 0.f, 0.f, 0.f, 0.f, 0.f};
        f32x16 cr0 = z16, cr1 = z16, ci0 = z16, ci1 = z16;
        __builtin_amdgcn_sched_barrier(0);
#pragma unroll
        for (int ks = 0; ks < 4; ++ks) {
            cr0 = __builtin_amdgcn_mfma_f32_32x32x16_bf16(afc[ks], W[ks][0], cr0, 0, 0, 0);
            cr1 = __builtin_amdgcn_mfma_f32_32x32x16_bf16(afc[ks], W[ks][1], cr1, 0, 0, 0);
            ci0 = __builtin_amdgcn_mfma_f32_32x32x16_bf16(afc[ks], W[ks][2], ci0, 0, 0, 0);
            ci1 = __builtin_amdgcn_mfma_f32_32x32x16_bf16(afc[ks], W[ks][3], ci1, 0, 0, 0); }
        __builtin_amdgcn_sched_barrier(0);
        asm volatile("s_nop 15\n\ts_nop 15" : "+v"(cr0), "+v"(cr1), "+v"(ci0), "+v"(ci1) : "v"(afc[0]), "v"(afc[1]), "v"(afc[2]), "v"(afc[3]));
        __builtin_amdgcn_sched_barrier(0);
        float hr0 = 0.f, hi0 = 0.f, hr1 = 0.f, hi1 = 0.f;
#pragma unroll
        for (int i = 0; i < 16; ++i) {
            const float n0 = fma_v(qr0, hr0, fma_v(nqi0, hi0, cr0[i])), m0 = fma_v(qr0, hi0, fma_v(qi0, hr0, ci0[i]));
            const float n1 = fma_v(qr1, hr1, fma_v(nqi1, hi1, cr1[i])), m1 = fma_v(qr1, hi1, fma_v(qi1, hr1, ci1[i]));
            hr0 = n0; hi0 = m0; hr1 = n1; hi1 = m1; }
#pragma unroll
        for (int ks = 0; ks < 4; ++ks) afc[ks] = afn[ks];
        CAR[car_idx(2 * bp + hh, g, dir, scan_chunk(tc, dir), lane & 31)] = (f32x4){hr0, hi0, hr1, hi1};
    }
}
__device__ __forceinline__ void phase_s12(const Args& a, Ctx& c, int l) {
    const bf16_t* Z = (const bf16_t*)(c.ws + WS_U); f32x4* HIN = (f32x4*)(c.ws + WS_CAR2);
    const f32x2* AB = (const f32x2*)(c.ws + WS_AB); const bf16x8* BF = (const bf16x8*)(c.ws + WS_BF);
    const int lane = c.lane, hh = lane >> 5;
    LAS f32x4* pre = (LAS f32x4*)(c.lds + c.wave * (9 * 1024));
    LAS f32x4* exch = (LAS f32x4*)(c.lds + 8 * 9 * 1024);
    const int s0 = c.wave < 4 ? 9 * c.wave : 36 + 8 * (c.wave - 4), len = c.wave < 4 ? 9 : 8;
    for (int ct = c.bid; ct < 4 * 32 * 2; ct += c.G) {
        const int bp = ct >> 6, g = (ct >> 1) & 31, dir = ct & 1; const int ldg = (l * 2 + dir) * 32 + g;
        bf16x8 W[4][4]; float qr0, qi0, qr1, qi1, nqi0, nqi1;
        {   const f32x2 a0 = AB[ldg * 64 + (lane & 31)], a1 = AB[ldg * 64 + 32 + (lane & 31)];
            u32x4 bw[4];
#pragma unroll
            for (int f = 0; f < 4; ++f) bw[f] = __builtin_bit_cast(u32x4, BF[(ldg * 4 + f) * 64 + lane]);
            f32x4 br0a, br0b, br1a, br1b, bi0a, bi0b, bi1a, bi1b; pg8::unpack8(bw[0], br0a, br0b); pg8::unpack8(bw[1], br1a, br1b); pg8::unpack8(bw[2], bi0a, bi0b); pg8::unpack8(bw[3], bi1a, bi1b);
            float pr0 = 1.f, pi0 = 0.f, pr1 = 1.f, pi1 = 0.f;
#pragma unroll
            for (int ks = 3; ks >= 0; --ks) {
                W[ks][0] = __builtin_bit_cast(bf16x8, pg8::pack8(br0a * pr0 - bi0a * pi0, br0b * pr0 - bi0b * pi0));
                W[ks][1] = __builtin_bit_cast(bf16x8, pg8::pack8(br1a * pr1 - bi1a * pi1, br1b * pr1 - bi1b * pi1));
                W[ks][2] = __builtin_bit_cast(bf16x8, pg8::pack8(bi0a * pr0 + br0a * pi0, bi0b * pr0 + br0b * pi0));
                W[ks][3] = __builtin_bit_cast(bf16x8, pg8::pack8(bi1a * pr1 + br1a * pi1, bi1b * pr1 + br1b * pi1));
                const float t0 = pr0 * a0.x - pi0 * a0.y, u0 = pr0 * a0.y + pi0 * a0.x, t1 = pr1 * a1.x - pi1 * a1.y, u1 = pr1 * a1.y + pi1 * a1.x; pr0 = t0; pi0 = u0; pr1 = t1; pi1 = u1; }
            qr0 = pr0; qi0 = pi0; nqi0 = -pi0; qr1 = pr1; qi1 = pi1; nqi1 = -pi1; }
        bf16x8 afc[4], afn[4];
        { const int cc = s0, tc = dir == 0 ? cc : (cc < 4 ? 3 - cc : 71 - cc), cc1 = s0 + 1, tc1 = dir == 0 ? cc1 : (cc1 < 4 ? 3 - cc1 : 71 - cc1);
#pragma unroll
            for (int ks = 0; ks < 4; ++ks) { afc[ks] = s1_afrag(Z, bp, tc, g, dir, ks, lane); afn[ks] = s1_afrag(Z, bp, tc1, g, dir, ks, lane); } }
        float hr0 = 0.f, hi0 = 0.f, hr1 = 0.f, hi1 = 0.f;
        __syncthreads();
#define S12_STEP(AF, kk) do {                                                                                                                              \
            const f32x16 z16 = {0.f, 0.f, 0.f, 0.f, 0.f, 0.f, 0.f, 0.f, 0.f, 0.f, 0.f, 0.f, 0.f, 0.f, 0.f, 0.f};                                          \
            f32x16 cr0 = z16, cr1 = z16, ci0 = z16, ci1 = z16;                                                                                             \
            asm volatile("" : "+v"(cr0), "+v"(cr1), "+v"(ci0), "+v"(ci1));                                                                                 \
            __builtin_amdgcn_sched_barrier(0);                                                                                                             \
            _Pragma("unroll") for (int ks = 0; ks < 4; ++ks) {                                                                                             \
                cr0 = __builtin_amdgcn_mfma_f32_32x32x16_bf16(AF[ks], W[ks][0], cr0, 0, 0, 0); cr1 = __builtin_amdgcn_mfma_f32_32x32x16_bf16(AF[ks], W[ks][1], cr1, 0, 0, 0);   \
                ci0 = __builtin_amdgcn_mfma_f32_32x32x16_bf16(AF[ks], W[ks][2], ci0, 0, 0, 0); ci1 = __builtin_amdgcn_mfma_f32_32x32x16_bf16(AF[ks], W[ks][3], ci1, 0, 0, 0); } \
            __builtin_amdgcn_sched_barrier(0);                                                                                                             \
            asm volatile("s_nop 15\n\ts_nop 15" : "+v"(cr0), "+v"(cr1), "+v"(ci0), "+v"(ci1) : "v"(AF[0]), "v"(AF[1]), "v"(AF[2]), "v"(AF[3]));          \
            __builtin_amdgcn_sched_barrier(0);                                                                                                             \
            if ((kk) + 2 < len) { const int cc_ = s0 + (kk) + 2, tc_ = dir == 0 ? cc_ : (cc_ < 4 ? 3 - cc_ : 71 - cc_);                                      \
                _Pragma("unroll") for (int ks = 0; ks < 4; ++ks) AF[ks] = s1_afrag(Z, bp, tc_, g, dir, ks, lane); }                                        \
            pre[(kk) * 64 + lane] = (f32x4){hr0, hi0, hr1, hi1};                                                                                           \
            _Pragma("unroll") for (int i = 0; i < 16; ++i) {                                                                                               \
                const float n0 = fma_v(qr0, hr0, fma_v(nqi0, hi0, cr0[i])), m0 = fma_v(qr0, hi0, fma_v(qi0, hr0, ci0[i]));                                   \
                const float n1 = fma_v(qr1, hr1, fma_v(nqi1, hi1, cr1[i])), m1 = fma_v(qr1, hi1, fma_v(qi1, hr1, ci1[i]));                                   \
                hr0 = n0; hi0 = m0; hr1 = n1; hi1 = m1; } } while (0)
#pragma unroll 1
        for (int k = 0; k < len; k += 2) {
            S12_STEP(afc, k);
            if (k + 1 < len) S12_STEP(afn, k + 1);
        }
#undef S12_STEP
        exch[c.wave * 64 + lane] = (f32x4){hr0, hi0, hr1, hi1};
        float p0r = qr0, p0i = qi0, p1r = qr1, p1i = qi1;
#pragma unroll
        for (int sq = 0; sq < 4; ++sq) { const float t0 = p0r * p0r - p0i * p0i, u0 = 2.0f * p0r * p0i, t1 = p1r * p1r - p1i * p1i, u1 = 2.0f * p1r * p1i; p0r = t0; p0i = u0; p1r = t1; p1i = u1; }
        float e0r = p0r, e0i = p0i, e1r = p1r, e1i = p1i;
#pragma unroll
        for (int sq = 0; sq < 3; ++sq) { const float t0 = e0r * e0r - e0i * e0i, u0 = 2.0f * e0r * e0i, t1 = e1r * e1r - e1i * e1i, u1 = 2.0f * e1r * e1i; e0r = t0; e0i = u0; e1r = t1; e1i = u1; }
        const float n0r = e0r * p0r - e0i * p0i, n0i = e0r * p0i + e0i * p0r, n1r = e1r * p1r - e1i * p1i, n1i = e1r * p1i + e1i * p1r;
        __syncthreads();
        float c0r = 0.f, c0i = 0.f, c1r = 0.f, c1i = 0.f;
        for (int v = 0; v < c.wave; ++v) { const f32x4 e = exch[v * 64 + lane]; const bool nine = v < 4;
            const float m0r = nine ? n0r : e0r, m0i = nine ? n0i : e0i, m1r = nine ? n1r : e1r, m1i = nine ? n1i : e1i;
            const float t0 = m0r * c0r - m0i * c0i + e[0], u0 = m0r * c0i + m0i * c0r + e[1], t1 = m1r * c1r - m1i * c1i + e[2], u1 = m1r * c1i + m1i * c1r + e[3];
            c0r = t0; c0i = u0; c1r = t1; c1i = u1; }
#pragma unroll 1
        for (int k = 0; k < len; ++k) { const f32x4 pv = pre[k * 64 + lane]; const int cc = s0 + k;
            HIN[car_idx(2 * bp + hh, g, dir, cc, lane & 31)] = (f32x4){pv[0] + c0r, pv[1] + c0i, pv[2] + c1r, pv[3] + c1i};
            const float t0 = p0r * c0r - p0i * c0i, u0 = p0r * c0i + p0i * c0r, t1 = p1r * c1r - p1i * c1i, u1 = p1r * c1i + p1i * c1r; c0r = t0; c0i = u0; c1r = t1; c1i = u1; }
    }
    __syncthreads();
}
__device__ __forceinline__ void phase_s2(const Args& a, Ctx& c, int l) {
    if (c.tid >= 128) return;
    for (int gid = c.bid * 128 + c.tid; gid < NB * 32 * 2 * 32 * 2; gid += c.G * 128) {
    const int tile = gid & 1, n = (gid >> 1) & 31, dir = (gid >> 6) & 1, g = (gid >> 7) & 31, b = gid >> 12;
    const f32x2* AB = (const f32x2*)(c.ws + WS_AB); const f32x2* __restrict__ E = (const f32x2*)(c.ws + WS_CAR); f32x2* __restrict__ HIN = (f32x2*)(c.ws + WS_CAR2);
    f32x2 p = AB[((l * 2 + dir) * 32 + g) * 64 + tile * 32 + n];
#pragma unroll
    for (int s = 0; s < 6; ++s) { const float pr = p.x * p.x - p.y * p.y, pi = 2.0f * p.x * p.y; p.x = pr; p.y = pi; }
    float hr = 0.f, hi = 0.f; const size_t base = car_idx(b, g, dir, 0, n) * 2 + tile;
#pragma unroll 1
    for (int c0 = 0; c0 < NCH; c0 += 17) {
        f32x2 e[17];
#pragma unroll
        for (int k = 0; k < 17; ++k) e[k] = E[base + (size_t)(c0 + k) * 64];
#pragma unroll
        for (int k = 0; k < 17; ++k) { HIN[base + (size_t)(c0 + k) * 64] = (f32x2){hr, hi};
            const float nr = p.x * hr - p.y * hi + e[k].x, ni = p.x * hi + p.y * hr + e[k].y; hr = nr; hi = ni; }
    }
    }
}
__device__ __forceinline__ bf16x8 s3_afrag(const bf16_t* Z, int bp, int tc, int g, int dir, int ks, int lane) {
    const int r = lane & 31, sq = (r >> 2) & 1, i = (r & 3) + 4 * (r >> 3), hh = lane >> 5;
    const int ti = dir == 0 ? 4 * i + ks : 4 * i + 3 - ks;
    return *(const bf16x8*)(Z + ((size_t)g * T + tok_row(2 * bp + sq, tc, ti)) * 16 + 8 * hh);
}
constexpr int S3_IMG = 272;
__device__ __forceinline__ constexpr int s3_skip(int dir, int f) { return f == (dir == 0 ? 16 : 17) || f == (dir == 0 ? 22 : 23); }
__device__ __forceinline__ constexpr int s3_pidx(int dir, int f) { return f - (f > (dir == 0 ? 16 : 17) ? 1 : 0) - (f > (dir == 0 ? 22 : 23) ? 1 : 0); }
constexpr int S3_TB = 38 * 1024;
__device__ __forceinline__ void phase_s3(const Args& a, Ctx& c, int l) {
    const bf16_t* Z = (const bf16_t*)(c.ws + WS_U); const f32x4* CAR = (const f32x4*)(c.ws + WS_CAR2); bf16_t* YG = (bf16_t*)(c.ws + WS_YG);
    const f32x2* AB = (const f32x2*)(c.ws + WS_AB); const u32x4* TB = (const u32x4*)(c.ws + WS_S3T);
    const int lane = c.lane, hh = lane >> 5, col = lane & 31;
    LAS unsigned char* tbl = c.lds;
    LAS unsigned char* img = c.lds + (c.wave < 6 ? 2 * S3_TB + c.wave * (32 * S3_IMG) : c.wave == 6 ? MISC_OFF + 1024 : LDS_BYTES - 16384);
    const int tc0 = (l == DEPTH - 1) ? 4 : 0, ntc = NCH - tc0, ncombo = 4 * ntc, ngrp = (ncombo + 7) >> 3;
    int cur_g = -1;
    const f32x16 z16 = {0.f, 0.f, 0.f, 0.f, 0.f, 0.f, 0.f, 0.f, 0.f, 0.f, 0.f, 0.f, 0.f, 0.f, 0.f, 0.f};
    float qq[2][6];
    bf16x8 af[2][4]; f32x4 hc[2], hq[2];
#pragma unroll
    for (int d = 0; d < 2; ++d) { hc[d] = (f32x4){0.f, 0.f, 0.f, 0.f}; hq[d] = hc[d];
#pragma unroll
        for (int k = 0; k < 6; ++k) qq[d][k] = 0.f;
#pragma unroll
        for (int ks = 0; ks < 4; ++ks) af[d][ks] = (bf16x8){0, 0, 0, 0, 0, 0, 0, 0}; }
    const bool worker = true;
    if (c.bid < 32 * ngrp) { const int wt = c.bid, g = ((wt >> 3) & 3) | ((wt & 7) << 2), combo = (wt >> 5) * 8 + c.wave;
        if (combo < ncombo) { const int tc = tc0 + combo % ntc, bp = combo / ntc;
#pragma unroll
            for (int d = 0; d < 2; ++d) hc[d] = CAR[car_idx(2 * bp + hh, g, d, scan_chunk(tc, d), col)];
#pragma unroll
            for (int ks = 0; ks < 4; ++ks) af[0][ks] = s3_afrag(Z, bp, tc, g, 0, ks, lane); } }
    for (int wt = c.bid; wt < 32 * ngrp; wt += c.G) {
        const int g = ((wt >> 3) & 3) | ((wt & 7) << 2), grp = wt >> 5;
        if (g != cur_g) { cur_g = g; __syncthreads();
            {
                static_assert(NTHREADS == 512, "ten fragments per thread");
#pragma unroll 1
                for (int kb = 0; kb < 10; kb += 5) { u32x4 tv[5];
#pragma unroll
                    for (int k = 0; k < 5; ++k) { const int i = c.tid + 512 * (kb + k), d = i / 2560, r = i - d * 2560; tv[k] = TB[(size_t)((l * 2 + d) * 32 + g) * 2560 + r]; }
                    __builtin_amdgcn_sched_barrier(0);
#pragma unroll
                    for (int k = 0; k < 5; ++k) { const int i = c.tid + 512 * (kb + k), d = i / 2560, r = i - d * 2560, f = r >> 6; if (!s3_skip(d, f)) *(LAS u32x4*)(tbl + d * S3_TB + (s3_pidx(d, f) * 64 + (r & 63)) * 16) = tv[k]; } } }
#pragma unroll
            for (int d = 0; d < 2; ++d) { const int ldg = (l * 2 + d) * 32 + g; const f32x2 a0 = AB[ldg * 64 + col], a1 = AB[ldg * 64 + 32 + col];
                const float s0r = a0.x * a0.x - a0.y * a0.y, s0i = 2.0f * a0.x * a0.y, s1r = a1.x * a1.x - a1.y * a1.y, s1i = 2.0f * a1.x * a1.y;
                qq[d][0] = s0r * s0r - s0i * s0i; qq[d][1] = 2.0f * s0r * s0i; qq[d][2] = -qq[d][1]; qq[d][3] = s1r * s1r - s1i * s1i; qq[d][4] = 2.0f * s1r * s1i; qq[d][5] = -qq[d][4]; }
            __syncthreads(); }
        const int combo = grp * 8 + c.wave;
        if (worker && combo < ncombo) {
            const int tc = tc0 + combo % ntc, bp = combo / ntc;
            { const int nwt = wt + c.G;
                if (nwt < 32 * ngrp) { const int ng = ((nwt >> 3) & 3) | ((nwt & 7) << 2), ncmb = (nwt >> 5) * 8 + c.wave;
                    if (ncmb < ncombo) { const int ntcc = tc0 + ncmb % ntc, nbp = ncmb / ntc;
#pragma unroll
                        for (int d = 0; d < 2; ++d) hq[d] = CAR[car_idx(2 * nbp + hh, ng, d, scan_chunk(ntcc, d), col)];
#pragma unroll
                        for (int ks = 0; ks < 4; ++ks) af[1][ks] = s3_afrag(Z, nbp, ntcc, ng, 0, ks, lane); } } }
            f32x16 y0 = z16, y1 = z16;
            asm volatile("" : "+v"(y0), "+v"(y1));
#pragma unroll
            for (int dir = 0; dir < 2; ++dir) {
                const LAS unsigned char* tb = tbl + dir * S3_TB + lane * 16;
                if (dir == 1) {
#pragma unroll
                    for (int ks = 0; ks < 2; ++ks) { const bf16x8 t = af[0][ks]; af[0][ks] = af[0][3 - ks]; af[0][3 - ks] = t; } }
                const f32x4 h0 = hc[dir];
                f32x16 cr0 = z16, cr1 = z16, ci0 = z16, ci1 = z16;
                asm volatile("" : "+v"(cr0), "+v"(cr1), "+v"(ci0), "+v"(ci1));
                __builtin_amdgcn_sched_barrier(0);
                {
                    bf16x8 bq[2][6];
#pragma unroll
                    for (int nb = 0; nb < 6; ++nb) bq[0][nb] = *(const LAS bf16x8*)(tb + s3_pidx(dir, nb) * 1024);
#pragma unroll
                    for (int ks = 0; ks < 4; ++ks) {
                        if (ks < 3) {
#pragma unroll
                            for (int nb = 0; nb < 6; ++nb) if (!s3_skip(dir, (ks + 1) * 6 + nb)) bq[(ks + 1) & 1][nb] = *(const LAS bf16x8*)(tb + s3_pidx(dir, (ks + 1) * 6 + nb) * 1024); }
                        __builtin_amdgcn_sched_barrier(0);
                        cr0 = __builtin_amdgcn_mfma_f32_32x32x16_bf16(af[0][ks], bq[ks & 1][0], cr0, 0, 0, 0); cr1 = __builtin_amdgcn_mfma_f32_32x32x16_bf16(af[0][ks], bq[ks & 1][1], cr1, 0, 0, 0);
                        ci0 = __builtin_amdgcn_mfma_f32_32x32x16_bf16(af[0][ks], bq[ks & 1][2], ci0, 0, 0, 0); ci1 = __builtin_amdgcn_mfma_f32_32x32x16_bf16(af[0][ks], bq[ks & 1][3], ci1, 0, 0, 0);
                        if (!s3_skip(dir, ks * 6 + 4)) y0 = __builtin_amdgcn_mfma_f32_32x32x16_bf16(af[0][ks], bq[ks & 1][4], y0, 0, 0, 0);
                        if (!s3_skip(dir, ks * 6 + 5)) y1 = __builtin_amdgcn_mfma_f32_32x32x16_bf16(af[0][ks], bq[ks & 1][5], y1, 0, 0, 0);
                        __builtin_amdgcn_sched_barrier(0); } }
                __builtin_amdgcn_sched_barrier(0);
                asm volatile("s_nop 15\n\ts_nop 15" : "+v"(cr0), "+v"(cr1), "+v"(ci0), "+v"(ci1) : "v"(af[0][0]), "v"(af[0][1]), "v"(af[0][2]), "v"(af[0][3]));
                __builtin_amdgcn_sched_barrier(0);
                const float q0r = qq[dir][0], q0i = qq[dir][1], nq0i = qq[dir][2], q1r = qq[dir][3], q1i = qq[dir][4], nq1i = qq[dir][5];
                float hr0 = h0[0], hi0 = h0[1], hr1 = h0[2], hi1 = h0[3];
#pragma unroll
                for (int be = 0; be < 16; ++be) { const int i = dir == 0 ? be : 15 - be; const int rho = (i & 3) + 4 * hh + 8 * (i >> 2);
                    *(LAS unsigned*)(img + rho * S3_IMG + 4 * col) = pk2(hr0, hi0); *(LAS unsigned*)(img + rho * S3_IMG + 128 + 4 * col) = pk2(hr1, hi1);
                    const float n0 = fma_v(q0r, hr0, fma_v(nq0i, hi0, cr0[i])), m0 = fma_v(q0r, hi0, fma_v(q0i, hr0, ci0[i]));
                    const float n1 = fma_v(q1r, hr1, fma_v(nq1i, hi1, cr1[i])), m1 = fma_v(q1r, hi1, fma_v(q1i, hr1, ci1[i]));
                    hr0 = n0; hi0 = m0; hr1 = n1; hi1 = m1; }
                asm volatile("" ::: "memory");
                {
                    bf16x8 hq[2][2][3];
#pragma unroll
                    for (int e = 0; e < 2; ++e) { hq[0][e][0] = *(const LAS bf16x8*)(img + col * S3_IMG + 32 * e + 16 * hh); hq[0][e][1] = *(const LAS bf16x8*)(tb + (22 + 2 * e) * 1024); hq[0][e][2] = *(const LAS bf16x8*)(tb + (23 + 2 * e) * 1024); }
#pragma unroll
                    for (int k2 = 0; k2 < 4; ++k2) {
                        if (k2 < 3) {
#pragma unroll
                            for (int e = 0; e < 2; ++e) { const int kk = 2 * (k2 + 1) + e; hq[(k2 + 1) & 1][e][0] = *(const LAS bf16x8*)(img + col * S3_IMG + 32 * kk + 16 * hh);
                                hq[(k2 + 1) & 1][e][1] = *(const LAS bf16x8*)(tb + (22 + 2 * kk) * 1024); hq[(k2 + 1) & 1][e][2] = *(const LAS bf16x8*)(tb + (23 + 2 * kk) * 1024); } }
                        __builtin_amdgcn_sched_barrier(0);
#pragma unroll
                        for (int e = 0; e < 2; ++e) { y0 = __builtin_amdgcn_mfma_f32_32x32x16_bf16(hq[k2 & 1][e][0], hq[k2 & 1][e][1], y0, 0, 0, 0); y1 = __builtin_amdgcn_mfma_f32_32x32x16_bf16(hq[k2 & 1][e][0], hq[k2 & 1][e][2], y1, 0, 0, 0); }
                        __builtin_amdgcn_sched_barrier(0); } }
                asm volatile("" ::: "memory");
            }
#pragma unroll
            for (int d = 0; d < 2; ++d) hc[d] = hq[d];
#pragma unroll
            for (int ks = 0; ks < 4; ++ks) af[0][ks] = af[1][ks];
            __builtin_amdgcn_sched_barrier(0);
            asm volatile("s_nop 15\n\ts_nop 15" : "+v"(y0), "+v"(y1));
            __builtin_amdgcn_sched_barrier(0);
#pragma unroll
            for (int nb = 0; nb < 2; ++nb)
#pragma unroll
                for (int i = 0; i < 16; ++i) { const float v = gelu_t(nb == 0 ? y0[i] : y1[i]);
                    const int tok = 4 * i + 2 * nb + (col >> 4);
                    *(LAS bf16_t*)(img + ((hh * 64 + tok) * 16 + (col & 15)) * 2) = (bf16_t)(pk2(v, v) & 0xffffu); }
            asm volatile("" ::: "memory");
#pragma unroll
            for (int k = 0; k < 4; ++k) { const int chunk = lane + 64 * k, row = chunk >> 1, half = chunk & 1;
                const u32x4 w = *(const LAS u32x4*)(img + chunk * 16);
                *(u32x4*)(YG + ((size_t)g * T + tok_row(2 * bp + (row >> 6), tc, row & 63)) * 16 + 8 * half) = w; }
            asm volatile("" ::: "memory");
        }
    }
    __syncthreads();
}

__device__ __forceinline__ void acc8(float (&s)[8], u32x4 w) { s[0] += bflo(w.x); s[1] += bfhi(w.x); s[2] += bflo(w.y); s[3] += bfhi(w.y); s[4] += bflo(w.z); s[5] += bfhi(w.z); s[6] += bflo(w.w); s[7] += bfhi(w.w); }
__device__ __forceinline__ void sub8(float (&s)[8], u32x4 w) { s[0] -= bflo(w.x); s[1] -= bfhi(w.x); s[2] -= bflo(w.y); s[3] -= bfhi(w.y); s[4] -= bflo(w.z); s[5] -= bfhi(w.z); s[6] -= bflo(w.w); s[7] -= bfhi(w.w); }
constexpr int POOL_TASKS = NB * 8 * 4 * 2;
constexpr int PV_CSTR = 144, PV_RSTR = 64 * PV_CSTR;
__device__ __forceinline__ void phase_pool(Ctx& c, const int wi, const int nw, const int t0, const int t1, const bool ctx) {
    const bf16_t* Z = (const bf16_t*)(c.ws + WS_Z); bf16_t* PD = (bf16_t*)(c.ws + WS_H);
    LAS unsigned char* V = c.lds;
    __syncthreads();
    for (int task = t0 + wi; task < t1; task += nw) {
        const int half = task & 1, g = (task >> 1) & 3, band = (task >> 3) & 7, b = task >> 6, hw = 1 << g, r0 = band * 8;
        const int ck = c.tid & 7, chn = 128 * g + 64 * half + 8 * ck;
        {
            const int cc = c.tid >> 3; const bf16_t* base = Z + (size_t)(b * SEQ + cc) * NZ + chn; const size_t rstep = (size_t)64 * NZ;
            float sm[8];
#pragma unroll
            for (int j = 0; j < 8; ++j) sm[j] = 0.f;
            const int lo0 = r0 - hw < 0 ? 0 : r0 - hw, hi0 = r0 + hw > 64 ? 64 : r0 + hw;
            const u32x4 zz = {0u, 0u, 0u, 0u};
            u32x4 wi[16], wa[7], wb[7];
#pragma unroll
            for (int j = 0; j < 16; ++j) { const int rr = lo0 + j < hi0 ? lo0 + j : hi0 - 1; wi[j] = *(const u32x4*)(base + (size_t)rr * rstep); }
#pragma unroll
            for (int i = 1; i < 8; ++i) { const int ra = r0 + i + hw - 1 < 64 ? r0 + i + hw - 1 : 63, rs = r0 + i - hw - 1 >= 0 ? r0 + i - hw - 1 : 0;
                wa[i - 1] = *(const u32x4*)(base + (size_t)ra * rstep); wb[i - 1] = *(const u32x4*)(base + (size_t)rs * rstep); }
            __builtin_amdgcn_sched_barrier(0);
#pragma unroll
            for (int j = 0; j < 16; ++j) acc8(sm, lo0 + j < hi0 ? wi[j] : zz);
#pragma unroll
            for (int i = 0; i < 8; ++i) { const int r = r0 + i;
                if (i > 0) { acc8(sm, r + hw - 1 < 64 ? wa[i - 1] : zz); sub8(sm, r - hw - 1 >= 0 ? wb[i - 1] : zz); }
                const int lo = r - hw < 0 ? 0 : r - hw, hi = r + hw > 64 ? 64 : r + hw; const float inv = 1.0f / (float)(hi - lo);
                u32x4 o; o.x = pk2(sm[0] * inv, sm[1] * inv); o.y = pk2(sm[2] * inv, sm[3] * inv); o.z = pk2(sm[4] * inv, sm[5] * inv); o.w = pk2(sm[6] * inv, sm[7] * inv);
                *(LAS u32x4*)(V + i * PV_RSTR + cc * PV_CSTR + ck * 16) = o; }
        }
        __syncthreads();
        {
            const int cseg = (c.tid >> 3) & 7, i = c.tid >> 6, c0 = cseg * 8, r = r0 + i; const LAS unsigned char* vrow = V + i * PV_RSTR + ck * 16;
            float sm[8];
#pragma unroll
            for (int j = 0; j < 8; ++j) sm[j] = 0.f;
            const int lo0 = c0 - hw < 0 ? 0 : c0 - hw, hi0 = c0 + hw > 64 ? 64 : c0 + hw;
            for (int cc = lo0; cc < hi0; ++cc) acc8(sm, *(const LAS u32x4*)(vrow + cc * PV_CSTR));
            const size_t tok0 = (size_t)b * SEQ + r * 64 + c0;
            u32x4 vv[8];
#pragma unroll
            for (int st = 0; st < 8; ++st) vv[st] = *(const u32x4*)(Z + (tok0 + st) * NZ + chn);
#pragma unroll
            for (int st = 0; st < 8; ++st) { const int cc = c0 + st;
                if (st > 0) { if (cc + hw - 1 < 64) acc8(sm, *(const LAS u32x4*)(vrow + (cc + hw - 1) * PV_CSTR)); if (cc - hw - 1 >= 0) sub8(sm, *(const LAS u32x4*)(vrow + (cc - hw - 1) * PV_CSTR)); }
                const int lo = cc - hw < 0 ? 0 : cc - hw, hi = cc + hw > 64 ? 64 : cc + hw; const float inv = 1.0f / (float)(hi - lo); const u32x4 v0 = vv[st];
                u32x4 o; o.x = pk2(sm[0] * inv - bflo(v0.x), sm[1] * inv - bfhi(v0.x)); o.y = pk2(sm[2] * inv - bflo(v0.y), sm[3] * inv - bfhi(v0.y));
                o.z = pk2(sm[4] * inv - bflo(v0.z), sm[5] * inv - bfhi(v0.z)); o.w = pk2(sm[6] * inv - bflo(v0.w), sm[7] * inv - bfhi(v0.w));
                *(u32x4*)(PD + (tok0 + st) * 512 + chn) = o; }
        }
        __syncthreads();
    }
    if (!ctx) return;
    const int gw = wi * NWAVES + c.wave, NGW = nw * NWAVES;
    for (int it = gw; it < (TC / 4) * 4; it += NGW) {
        const int g = it & 3, row = TL + (it >> 2) * 4 + (c.lane >> 4), ck = c.lane & 15, w = 2 << g;
        const int pos = (row - TL) & 255, n = 256;
        const bf16_t* src = Z + (size_t)(row - pos) * NZ + 128 * g + 8 * ck;
        const int lo = pos - w / 2 < 0 ? 0 : pos - w / 2, hi = pos + w / 2 > n ? n : pos + w / 2;
        float sm[8];
#pragma unroll
        for (int j = 0; j < 8; ++j) sm[j] = 0.f;
        { const u32x4 zz = {0u, 0u, 0u, 0u}; u32x4 wv[16];
#pragma unroll
            for (int k = 0; k < 16; ++k) { const int p = pos - w / 2 + k; const int pc = p < 0 ? 0 : (p > n - 1 ? n - 1 : p); wv[k] = *(const u32x4*)(src + (size_t)pc * NZ); }
            __builtin_amdgcn_sched_barrier(0);
#pragma unroll
            for (int k = 0; k < 16; ++k) { const int p = pos - w / 2 + k; acc8(sm, (k < w && p >= 0 && p < n) ? wv[k] : zz); } }
        const float inv = 1.0f / (float)(hi - lo);
        const u32x4 vv = *(const u32x4*)(Z + (size_t)row * NZ + 128 * g + 8 * ck);
        u32x4 o; o.x = pk2(sm[0] * inv - bflo(vv.x), sm[1] * inv - bfhi(vv.x)); o.y = pk2(sm[2] * inv - bflo(vv.y), sm[3] * inv - bfhi(vv.y));
        o.z = pk2(sm[4] * inv - bflo(vv.z), sm[5] * inv - bfhi(vv.z)); o.w = pk2(sm[6] * inv - bflo(vv.w), sm[7] * inv - bfhi(vv.w));
        *(u32x4*)(PD + (size_t)row * 512 + 128 * g + 8 * ck) = o;
    }
}

__device__ __forceinline__ void phase_i(const Args& a, Ctx& c, int l, const bool dummy = false) {
    LAS u32x4* bh = (LAS u32x4*)c.lds; LAS u32x4* bl = bh + 2048;
    {
        static_assert(NTHREADS == 512, "four fragments per thread");
        const float* rw = a.in(24); float rv[4][8];
#pragma unroll
        for (int it = 0; it < 4; ++it) { const int i = c.tid + 512 * it, st = i >> 6, ln = i & 63, n = ln & 15, q = ln >> 4; const float* rp = rw + (size_t)(32 * st + 8 * q) * 16 + n;
#pragma unroll
            for (int e = 0; e < 8; ++e) rv[it][e] = rp[e * 16]; }
        __builtin_amdgcn_sched_barrier(0);
#pragma unroll
        for (int it = 0; it < 4; ++it) { const int i = c.tid + 512 * it; unsigned hi[4], lo[4];
#pragma unroll
            for (int e = 0; e < 4; ++e) { const float v0 = rv[it][2 * e], v1 = rv[it][2 * e + 1]; const unsigned h2 = pk2(v0, v1); hi[e] = h2; lo[e] = pk2(v0 - bflo(h2), v1 - bfhi(h2)); }
            bh[i] = (u32x4){hi[0], hi[1], hi[2], hi[3]}; bl[i] = (u32x4){lo[0], lo[1], lo[2], lo[3]}; } }
    volatile LAS int* bcnt = c.misc + 64; volatile LAS int* bbase = c.misc + 80; LAS float* lgt = (LAS float*)(c.lds + 65536);
    if (c.tid < 16) bcnt[c.tid] = 0;
    const int Te = l == DEPTH - 1 ? TL : T;
    const int rpb = (Te + c.G - 1) / c.G, r0 = c.bid * rpb, nrows = (r0 + rpb <= Te) ? rpb : (Te - r0 > 0 ? Te - r0 : 0);
    LAS float* par = (LAS float*)(c.lds + 81920); const int b0 = brow_of(r0);
    {
        const float* gn2 = a.in(7) + (size_t)l * D; const float* mods = (const float*)(c.ws + WS_MODS); float pgn[4], psc[4], psh2[4];
#pragma unroll
        for (int it = 0; it < 4; ++it) { const int i = c.tid + 512 * it, bb = i >> 10, col = i & (D - 1), bt = b0 + bb < 8 ? b0 + bb : 8; const float* md = mods + ((size_t)l * 9 + bt) * NMOD + 3 * D;
            pgn[it] = gn2[col]; psc[it] = md[D + col]; psh2[it] = md[col]; }
        __builtin_amdgcn_sched_barrier(0);
#pragma unroll
        for (int it = 0; it < 4; ++it) { const int i = c.tid + 512 * it, bb = i >> 10, col = i & (D - 1); par[bb * 2 * D + col] = pgn[it] * (1.0f + psc[it]); par[bb * 2 * D + D + col] = psh2[it]; } }
    __syncthreads();
    bf16_t* H = (bf16_t*)(c.ws + WS_H);
    const bf16_t* XB = (const bf16_t*)(c.ws + WS_XB);
    const int m = c.lane & 15, q = c.lane >> 4;
    for (int tile = c.wave; tile * 16 < nrows; tile += NWAVES) {
        const int rowl = tile * 16 + m; const bool valid = rowl < nrows; const int row = r0 + (valid ? rowl : nrows - 1);
        const bf16_t* xb = XB + (size_t)row * D + 8 * q;
        u32x4 w[32];
#pragma unroll
        for (int st = 0; st < 32; ++st) w[st] = *(const u32x4*)(xb + 32 * st);
        __builtin_amdgcn_sched_barrier(0);
        float ss = 0.f;
#pragma unroll
        for (int st = 0; st < 32; ++st) { const float x0 = bflo(w[st].x), x1 = bfhi(w[st].x), x2 = bflo(w[st].y), x3 = bfhi(w[st].y), x4 = bflo(w[st].z), x5 = bfhi(w[st].z), x6 = bflo(w[st].w), x7 = bfhi(w[st].w);
            ss += (x0 * x0 + x1 * x1) + (x2 * x2 + x3 * x3) + (x4 * x4 + x5 * x5) + (x6 * x6 + x7 * x7);
            if ((st & 3) == 3) __builtin_amdgcn_sched_barrier(0); }
        ss += shflx(ss, 16, c.lane); ss += shflx(ss, 32, c.lane);
#pragma unroll
        for (int st = 0; st < 32; ++st) asm volatile("" : "+v"(w[st].x), "+v"(w[st].y), "+v"(w[st].z), "+v"(w[st].w));
        const float rstd = 1.0f / sqrtf(ss * (1.0f / D) + RMS_EPS);
        const LAS float* pa = par + (brow_of(row) - b0) * 2 * D + 8 * q;
        bf16_t* hrow = H + (size_t)row * D + 8 * q;
        f32x4 acc = {0.f, 0.f, 0.f, 0.f};
#pragma unroll
        for (int st = 0; st < 32; ++st) {
            const int co = 32 * st;
            const f32x4 g0 = *(const LAS f32x4*)(pa + co), g1 = *(const LAS f32x4*)(pa + co + 4), s0 = *(const LAS f32x4*)(pa + D + co), s1 = *(const LAS f32x4*)(pa + D + co + 4);
            const f32x4 xa = {bflo(w[st].x), bfhi(w[st].x), bflo(w[st].y), bfhi(w[st].y)}, xc = {bflo(w[st].z), bfhi(w[st].z), bflo(w[st].w), bfhi(w[st].w)};
            const f32x4 ha = xa * rstd * g0 + s0, hc = xc * rstd * g1 + s1;
            u32x4 hi4; hi4.x = pk2(ha[0], ha[1]); hi4.y = pk2(ha[2], ha[3]); hi4.z = pk2(hc[0], hc[1]); hi4.w = pk2(hc[2], hc[3]);
            u32x4 lo4; lo4.x = pk2(ha[0] - bflo(hi4.x), ha[1] - bfhi(hi4.x)); lo4.y = pk2(ha[2] - bflo(hi4.y), ha[3] - bfhi(hi4.y));
            lo4.z = pk2(hc[0] - bflo(hi4.z), hc[1] - bfhi(hi4.z)); lo4.w = pk2(hc[2] - bflo(hi4.w), hc[3] - bfhi(hi4.w));
            if (valid) *(u32x4*)(hrow + co) = hi4;
            const bf16x8 ahi = __builtin_bit_cast(bf16x8, hi4), alo = __builtin_bit_cast(bf16x8, lo4);
            const bf16x8 bhi = __builtin_bit_cast(bf16x8, bh[st * 64 + c.lane]), blo = __builtin_bit_cast(bf16x8, bl[st * 64 + c.lane]);
            acc = __builtin_amdgcn_mfma_f32_16x16x32_bf16(ahi, bhi, acc, 0, 0, 0);
            acc = __builtin_amdgcn_mfma_f32_16x16x32_bf16(alo, bhi, acc, 0, 0, 0);
            acc = __builtin_amdgcn_mfma_f32_16x16x32_bf16(ahi, blo, acc, 0, 0, 0);
            __builtin_amdgcn_sched_barrier(0);
        }
#pragma unroll
        for (int j = 0; j < 4; ++j) lgt[(tile * 16 + 4 * q + j) * 16 + m] = acc[j];
    }
    __syncthreads();
    int e1 = 0, e2 = 0, p1 = 0, p2 = 0; float gw1 = 0.f, gw2 = 0.f; const int myrow = c.tid;
    if (myrow < nrows) {
        float rb[16]; { const float* rbp = a.in(25);
#pragma unroll
            for (int q4 = 0; q4 < 4; ++q4) { const f32x4 r4 = *(const f32x4*)(rbp + 4 * q4); rb[4 * q4] = r4[0]; rb[4 * q4 + 1] = r4[1]; rb[4 * q4 + 2] = r4[2]; rb[4 * q4 + 3] = r4[3]; } }
        float sc[16], bi[16];
#pragma unroll
        for (int q4 = 0; q4 < 4; ++q4) { const f32x4 l4 = *(const LAS f32x4*)(lgt + myrow * 16 + q4 * 4);
#pragma unroll
            for (int k = 0; k < 4; ++k) { sc[q4 * 4 + k] = sigm(l4[k]); bi[q4 * 4 + k] = sc[q4 * 4 + k] + rb[q4 * 4 + k]; } }
        float gs[4];
#pragma unroll
        for (int gq = 0; gq < 4; ++gq) { const float x0 = bi[4 * gq], x1 = bi[4 * gq + 1], x2 = bi[4 * gq + 2], x3 = bi[4 * gq + 3];
            const float h1 = fmaxf(x0, x1), l1 = fminf(x0, x1), h2 = fmaxf(x2, x3), l2 = fminf(x2, x3);
            gs[gq] = fmaxf(h1, h2) + fmaxf(fminf(h1, h2), fmaxf(l1, l2)); }
        int bg = 0; float best = gs[0];
#pragma unroll
        for (int gq = 1; gq < 4; ++gq) if (gs[gq] > best) { best = gs[gq]; bg = gq; }
        float vb[4], vs[4];
#pragma unroll
        for (int i = 0; i < 4; ++i) { vb[i] = bg == 0 ? bi[i] : bg == 1 ? bi[4 + i] : bg == 2 ? bi[8 + i] : bi[12 + i]; vs[i] = bg == 0 ? sc[i] : bg == 1 ? sc[4 + i] : bg == 2 ? sc[8 + i] : sc[12 + i]; }
        int i1 = 0; float m1 = vb[0];
#pragma unroll
        for (int i = 1; i < 4; ++i) if (vb[i] > m1) { m1 = vb[i]; i1 = i; }
        int i2 = -1; float m2 = 0.f;
#pragma unroll
        for (int i = 0; i < 4; ++i) if (i != i1 && (i2 < 0 || vb[i] > m2)) { m2 = vb[i]; i2 = i; }
        const float s1 = i1 == 0 ? vs[0] : i1 == 1 ? vs[1] : i1 == 2 ? vs[2] : vs[3], s2 = i2 == 0 ? vs[0] : i2 == 1 ? vs[1] : i2 == 2 ? vs[2] : vs[3];
        const float inv = 1.0f / (s1 + s2);
        e1 = bg * 4 + i1; e2 = bg * 4 + i2;
        p1 = __hip_atomic_fetch_add((LAS int*)(bcnt + e1), 1, __ATOMIC_RELAXED, __HIP_MEMORY_SCOPE_WORKGROUP);
        p2 = __hip_atomic_fetch_add((LAS int*)(bcnt + e2), 1, __ATOMIC_RELAXED, __HIP_MEMORY_SCOPE_WORKGROUP);
        gw1 = s1 * inv; gw2 = s2 * inv;
    }
    __syncthreads();
    unsigned* cntw = (unsigned*)(c.ws + WS_CTL) + CW_CNT + (dummy ? l + 4 : l) * 1024;
    if (c.tid < 16) bbase[c.tid] = (int)__hip_atomic_fetch_add(cntw + c.tid * 64, (unsigned)bcnt[c.tid], __ATOMIC_RELAXED, __HIP_MEMORY_SCOPE_AGENT);
    __syncthreads();
    int* list = (int*)(c.ws + (dummy ? WS_HMID : WS_LIST));
    float* lw = (float*)(c.ws + (dummy ? WS_HMID + 8 * MiB : WS_XCTX));
    if (myrow < nrows) { const int row = r0 + myrow; const size_t i1 = (size_t)e1 * LCAP + bbase[e1] + p1, i2 = (size_t)e2 * LCAP + bbase[e2] + p2; list[i1] = row * 2; list[i2] = row * 2 + 1; lw[i1] = gw1; lw[i2] = gw2; }
}
__device__ __forceinline__ void moe_setup(Ctx& c, int l) {
    const unsigned* cntw = (const unsigned*)(c.ws + WS_CTL) + CW_CNT + l * 1024;
    if (c.tid < NE) c.misc[48 + c.tid] = (int)__hip_atomic_load(cntw + c.tid * 64, __ATOMIC_RELAXED, __HIP_MEMORY_SCOPE_AGENT);
    __syncthreads();
    if (c.tid == 0) { int cum = 0;
        for (int e = 0; e < NE; ++e) { c.misc[16 + e] = cum; cum += (c.misc[48 + e] + 255) >> 8; }
        c.misc[16 + NE] = cum; }
    __syncthreads();
}

struct FinRow { u32x4 x[2], s0[2], s1[2]; f32x4 g[4]; };
__device__ __forceinline__ void fin_load(FinRow& r, const bf16_t* XB, const bf16_t* SL, const float* G2, int row, int lane) {
#pragma unroll
    for (int k = 0; k < 2; ++k) { const int col = 8 * lane + 512 * k; r.x[k] = *(const u32x4*)(XB + (size_t)row * D + col); r.s0[k] = *(const u32x4*)(SL + (size_t)row * 2 * D + col); r.s1[k] = *(const u32x4*)(SL + (size_t)row * 2 * D + D + col); }
#pragma unroll
    for (int j = 0; j < 4; ++j) r.g[j] = *(const f32x4*)(G2 + (size_t)(row >> 12) * NMOD + ncol(lane, j));
}
__device__ __forceinline__ void fin_row(const FinRow& r, const f32x4 (&fg)[4], float* outp, int row, int lane) {
    f32x4 v[4]; float s = 0.f;
#pragma unroll
    for (int k = 0; k < 2; ++k) { f32x4 xa, xc, sa, sc, ta, tc2; pg8::unpack8(r.x[k], xa, xc); pg8::unpack8(r.s0[k], sa, sc); pg8::unpack8(r.s1[k], ta, tc2);
        v[2 * k] = xa + r.g[2 * k] * (sa + ta); v[2 * k + 1] = xc + r.g[2 * k + 1] * (sc + tc2); }
#pragma unroll
    for (int j = 0; j < 4; ++j) s += (v[j][0] * v[j][0] + v[j][1] * v[j][1]) + (v[j][2] * v[j][2] + v[j][3] * v[j][3]);
    const float rstd = 1.0f / sqrtf(wave_sum(s, lane) * (1.0f / D) + RMS_EPS);
#pragma unroll
    for (int j = 0; j < 4; ++j) *(f32x4*)(outp + (size_t)row * D + ncol(lane, j)) = v[j] * rstd * fg[j];
}
__device__ __forceinline__ void phase_fin(const Args& a, Ctx& c) {
    const int gw = c.bid * NWAVES + c.wave, NGW = c.G * NWAVES;
    const bf16_t* XB = (const bf16_t*)(c.ws + WS_XB); const bf16_t* SL = (const bf16_t*)(c.ws + WS_Z); const float* G2 = (const float*)(c.ws + WS_MODS) + (size_t)(DEPTH - 1) * 9 * NMOD + 5 * D;
    f32x4 fg[4];
#pragma unroll
    for (int j = 0; j < 4; ++j) fg[j] = *(const f32x4*)(a.in(29) + ncol(c.lane, j));
    float* outp = a.out();
    FinRow ra, rb;
    if (gw < TL) fin_load(ra, XB, SL, G2, gw, c.lane);
    for (int row = gw; row < TL; row += 2 * NGW) {
        const bool hb = row + NGW < TL;
        if (hb) fin_load(rb, XB, SL, G2, row + NGW, c.lane);
        fin_row(ra, fg, outp, row, c.lane);
        if (row + 2 * NGW < TL) fin_load(ra, XB, SL, G2, row + 2 * NGW, c.lane);
        if (hb) fin_row(rb, fg, outp, row + NGW, c.lane);
    }
}

constexpr int STEPS_PER_LAYER = 11, NSTEPS = 1 + DEPTH * STEPS_PER_LAYER + 1;
__device__ __forceinline__ Ctx mkctx(LAS unsigned char* lds, const Args& a, const int wv) {
    unsigned lb = (unsigned)(unsigned long long)lds; asm volatile("" : "+s"(lb));
    Ctx c; c.lds = (LAS unsigned char*)lb; c.misc = (volatile LAS int*)(c.lds + MISC_OFF);
    int g = gridDim.x, b = blockIdx.x; asm volatile("" : "+s"(g), "+s"(b));
    c.wave = wv; c.lane = lane_id_v(); c.tid = wv * 64 + c.lane; c.G = g; c.bid = b; c.ws = a.ws();
    return c;
}
__global__ void __launch_bounds__(NTHREADS, 2) mk_fwd(KArgs ka) {
    extern __shared__ __attribute__((aligned(16))) unsigned char lds_raw[];
    LAS unsigned char* lds = (LAS unsigned char*)lds_raw;
    volatile LAS int* misc = (volatile LAS int*)(lds + MISC_OFF);
#if (MK_DIAG_ZERO & 1)
    for (int i = MISC_OFF / 4 + threadIdx.x; i < LDS_BYTES / 4; i += NTHREADS) ((volatile LAS int*)lds)[i] = 0x7fc12345;
    __syncthreads();
#endif
    if (threadIdx.x < 16) misc[threadIdx.x] = 0;
    if ((threadIdx.x & 63) == 0) misc[WTAB + hw_key()] = (int)(threadIdx.x >> 6);
    if (threadIdx.x == 64) {
#pragma unroll
        for (int k = 0; k < 30; ++k) { const unsigned long long p = (unsigned long long)ka.in[k]; misc[PTAB + 2 * k] = (int)(unsigned)p; misc[PTAB + 2 * k + 1] = (int)(unsigned)(p >> 32); }
        { const unsigned long long p = (unsigned long long)ka.out; misc[PTAB + 60] = (int)(unsigned)p; misc[PTAB + 61] = (int)(unsigned)(p >> 32); }
        { const unsigned long long p = (unsigned long long)ka.ws; misc[PTAB + 62] = (int)(unsigned)p; misc[PTAB + 63] = (int)(unsigned)(p >> 32); }
        misc[PTAB + 64] = ka.lo; misc[PTAB + 65] = ka.hi;
    }
    __syncthreads();
    Args a; a.tab = misc + PTAB;
    int wv = __builtin_amdgcn_readfirstlane((int)(threadIdx.x >> 6)); asm volatile("" : "+s"(wv));
    const int lo = __builtin_amdgcn_readfirstlane(misc[PTAB + 64]), hi = __builtin_amdgcn_readfirstlane(misc[PTAB + 65]);
    XcdBarrier bar; bar.bar = (unsigned*)(a.ws() + WS_CTL) + CW_BAR; bar.x = 0; bar.st = (volatile LAS unsigned*)misc;
    if (hi - lo > 1) bar = xcd_barrier_post((unsigned*)(a.ws() + WS_CTL) + CW_BAR, (volatile LAS unsigned*)misc);
#define IN(s) (lo <= (s) && (s) < hi)
#define SEAM(s) do { if (IN(s) && IN((s) + 1)) { bar.bar = (unsigned*)(a.ws() + WS_CTL) + CW_BAR; xcd_barrier(bar, wv * 64 + lane_id_v()); } } while (0)
    if (IN(0)) { Ctx c = mkctx(lds, a, wv); phase_p0(a, c); __syncthreads(); tr_range(a, c, 0, 0, TR_NITEMS, c.bid * NWAVES + c.wave, c.G * NWAVES);
        if (MK_DBL & 1) { __syncthreads(); phase_p0(a, c); __syncthreads(); tr_range(a, c, 0, 0, TR_NITEMS, c.bid * NWAVES + c.wave, c.G * NWAVES); } } SEAM(0);
    for (int l = 0; l < DEPTH; ++l) {
        const int sb = 1 + l * STEPS_PER_LAYER;
        if (IN(sb + 0)) { Ctx c = mkctx(lds, a, wv); if (MK_DBL & (1 << 11)) { phase_a(a, c, l, true); __syncthreads(); } phase_a(a, c, l); } SEAM(sb + 0);
        if (IN(sb + 1)) {
            Ctx c = mkctx(lds, a, wv);
            pg8::StaticOrder S; S.init(T, NZ, c.G, c.bid); pg8::EpiIn E{(bf16_t*)(c.ws + WS_Z), (bf16_t*)(c.ws + WS_U)};
            pg8::gemm_phase<pg8::EpiIn, pg8::StaticOrder, false>(c.lds, c.tid, (const bf16_t*)(c.ws + WS_H), (const bf16_t*)(c.ws + wbuf_off(l) + WO_WIN), D, S, E);
            if (MK_DBL & (1 << 1)) { __syncthreads(); pg8::gemm_phase<pg8::EpiIn, pg8::StaticOrder, false>(c.lds, c.tid, (const bf16_t*)(c.ws + WS_H), (const bf16_t*)(c.ws + wbuf_off(l) + WO_WIN), D, S, E); }
            { const int tail0 = S.nwg % c.G; if (l + 1 < DEPTH && tail0 != 0 && c.bid >= tail0) tr_range(a, c, l + 1, 0, TR_SPLIT, (c.bid - tail0) * NWAVES + c.wave, (c.G - tail0) * NWAVES);
                if (l == 0) { Ctx c2 = mkctx(lds, a, wv); if (tail0 == 0) s3_tables(a, c2, c2.bid, c2.G); else if (c2.bid >= tail0) s3_tables(a, c2, c2.bid - tail0, c2.G - tail0); } }
        } SEAM(sb + 1);
        if (IN(sb + 2)) { Ctx c = mkctx(lds, a, wv); phase_s12(a, c, l);
            if (MK_DBL & (1 << 2)) { __syncthreads(); phase_s12(a, c, l); }
#if MK_SELFTEST
            if (l == 0) { asm volatile("" ::: "memory"); phase_s1(a, c, l, WS_HMID); bar.bar = (unsigned*)(a.ws() + WS_CTL) + CW_BAR; xcd_barrier(bar, c.tid);
                const u32x4* p = (const u32x4*)(c.ws + WS_CAR); const u32x4* q = (const u32x4*)(c.ws + WS_HMID); unsigned bad = 0;
                for (size_t i = (size_t)c.bid * NTHREADS + c.tid; i < (size_t)NB * 32 * 2 * NCH * 32; i += (size_t)c.G * NTHREADS) { const u32x4 x = p[i], y = q[i]; bad |= (x.x ^ y.x) | (x.y ^ y.y) | (x.z ^ y.z) | (x.w ^ y.w); }
                if (bad) __hip_atomic_fetch_or((unsigned*)(c.ws + WS_CTL) + 8, 1u, __ATOMIC_RELAXED, __HIP_MEMORY_SCOPE_AGENT); }
#endif
        } SEAM(sb + 2);
        if (IN(sb + 4)) { Ctx c = mkctx(lds, a, wv);
#pragma unroll 1
            for (int rep = 0; rep < ((MK_DBL & (1 << 4)) ? 2 : 1); ++rep) { phase_s3(a, c, l); __syncthreads(); }
            { const int nt3 = 32 * ((4 * (l == DEPTH - 1 ? NCH - 4 : NCH) + 7) >> 3), tail0 = nt3 % c.G;
                if (tail0 == 0) phase_pool(c, c.bid, c.G, 0, POOL_TASKS / 2, false); else if (c.bid >= tail0) phase_pool(c, c.bid - tail0, c.G - tail0, 0, POOL_TASKS / 2, false); }
        } SEAM(sb + 4);
        if (IN(sb + 5)) {
            Ctx c = mkctx(lds, a, wv);
            pg8::StaticOrder S; S.init(l == DEPTH - 1 ? TL : T, 512, c.G, c.bid); pg8::EpiGlu E{(const bf16_t*)(c.ws + WS_YG), (bf16_t*)(c.ws + WS_H) + (size_t)T * 512, a.in(20) + (size_t)l * 512};
            pg8::gemm_phase<pg8::EpiGlu, pg8::StaticOrder, false, true>(c.lds, c.tid, (const bf16_t*)(c.ws + WS_YG), (const bf16_t*)(c.ws + wbuf_off(l) + WO_GLU), 512, S, E);
            if (MK_DBL & (1 << 5)) { __syncthreads(); pg8::gemm_phase<pg8::EpiGlu, pg8::StaticOrder, false, true>(c.lds, c.tid, (const bf16_t*)(c.ws + WS_YG), (const bf16_t*)(c.ws + wbuf_off(l) + WO_GLU), 512, S, E); }
            { const int tail0 = S.nwg % c.G; Ctx c2 = mkctx(lds, a, wv);
                if (tail0 == 0) phase_pool(c2, c2.bid, c2.G, POOL_TASKS / 2, POOL_TASKS, l != DEPTH - 1); else if (c2.bid >= tail0) phase_pool(c2, c2.bid - tail0, c2.G - tail0, POOL_TASKS / 2, POOL_TASKS, l != DEPTH - 1); }
        } SEAM(sb + 5);
        if (IN(sb + 6)) {
            Ctx c = mkctx(lds, a, wv); pg8::PairOrder S; S.so.init(l == DEPTH - 1 ? TL : T, D, c.G, c.bid);
            pg8::EpiM12 E{(const bf16_t*)(c.ws + WS_Z), (bf16_t*)(c.ws + WS_HMID)};
            pg8::gemm_phase<pg8::EpiM12, pg8::PairOrder, false>(c.lds, c.tid, (const bf16_t*)(c.ws + WS_H), (const bf16_t*)(c.ws + wbuf_off(l) + WO_WC), 512, S, E);
            if (MK_DBL & (1 << 6)) { __syncthreads(); pg8::gemm_phase<pg8::EpiM12, pg8::PairOrder, false>(c.lds, c.tid, (const bf16_t*)(c.ws + WS_H), (const bf16_t*)(c.ws + wbuf_off(l) + WO_WC), 512, S, E); }
            { const int tail0 = S.so.nwg % c.G; if (l + 1 < DEPTH && tail0 != 0 && c.bid >= tail0) tr_range(a, c, l + 1, TR_SPLIT, TR_SPLIT2, (c.bid - tail0) * NWAVES + c.wave, (c.G - tail0) * NWAVES); }
        } SEAM(sb + 6);
        if (IN(sb + 7)) {
            Ctx c = mkctx(lds, a, wv);
            pg8::StaticOrder S; S.init(l == DEPTH - 1 ? TL : T, D, c.G, c.bid);
            pg8::EpiOut E{(bf16_t*)(c.ws + WS_XB), (const float*)(c.ws + WS_MODS) + (size_t)l * 9 * NMOD + 2 * D, (bf16_t*)(c.ws + WS_XB)};
            if (MK_DBL & (1 << 7)) { pg8::EpiOut E2{(bf16_t*)(c.ws + WS_XB), (const float*)(c.ws + WS_MODS) + (size_t)l * 9 * NMOD + 2 * D, (bf16_t*)(c.ws + WS_H)};
                pg8::gemm_phase<pg8::EpiOut, pg8::StaticOrder, false>(c.lds, c.tid, (const bf16_t*)(c.ws + WS_HMID), (const bf16_t*)(c.ws + wbuf_off(l) + WO_WOUT), D, S, E2); __syncthreads(); }
            pg8::gemm_phase<pg8::EpiOut, pg8::StaticOrder, false>(c.lds, c.tid, (const bf16_t*)(c.ws + WS_HMID), (const bf16_t*)(c.ws + wbuf_off(l) + WO_WOUT), D, S, E);
            { const int tail0 = S.nwg % c.G; if (l + 1 < DEPTH && tail0 != 0 && c.bid >= tail0) tr_range(a, c, l + 1, TR_SPLIT2, TR_NITEMS, (c.bid - tail0) * NWAVES + c.wave, (c.G - tail0) * NWAVES); }
        } SEAM(sb + 7);
        if (IN(sb + 8)) { Ctx c = mkctx(lds, a, wv); phase_i(a, c, l); if (MK_DBL & (1 << 8)) { __syncthreads(); phase_i(a, c, l, true); } } SEAM(sb + 8);
        if (IN(sb + 9)) {
            Ctx c = mkctx(lds, a, wv);
            moe_setup(c, l);
            pg8::MoeOrder S{(const LAS int*)(c.misc + 16), (const LAS int*)(c.misc + 48), (const int*)(c.ws + WS_LIST), c.G, c.bid}; pg8::EpiUp E{(bf16_t*)(c.ws + WS_HMID)};
            pg8::gemm_phase<pg8::EpiUp, pg8::MoeOrder, true>(c.lds, c.tid, (const bf16_t*)(c.ws + WS_H), (const bf16_t*)(c.ws + wbuf_off(l) + WO_W13), D, S, E);
            if (MK_DBL & (1 << 9)) { __syncthreads(); pg8::gemm_phase<pg8::EpiUp, pg8::MoeOrder, true>(c.lds, c.tid, (const bf16_t*)(c.ws + WS_H), (const bf16_t*)(c.ws + wbuf_off(l) + WO_W13), D, S, E); }
        } SEAM(sb + 9);
        if (IN(sb + 10)) {
            Ctx c = mkctx(lds, a, wv);
            pg8::MoeOrder S{(const LAS int*)(c.misc + 16), (const LAS int*)(c.misc + 48), (const int*)(c.ws + WS_LIST), c.G, c.bid};
            pg8::EpiDown E{(bf16_t*)(c.ws + WS_Z), (const int*)(c.ws + WS_LIST), (const float*)(c.ws + WS_XCTX), (const LAS int*)(c.misc + 16), (const LAS int*)(c.misc + 48)};
            pg8::gemm_phase<pg8::EpiDown, pg8::MoeOrder, false>(c.lds, c.tid, (const bf16_t*)(c.ws + WS_HMID), (const bf16_t*)(c.ws + wbuf_off(l) + WO_W2), DE, S, E);
            if (MK_DBL & (1 << 10)) { __syncthreads(); pg8::gemm_phase<pg8::EpiDown, pg8::MoeOrder, false>(c.lds, c.tid, (const bf16_t*)(c.ws + WS_HMID), (const bf16_t*)(c.ws + wbuf_off(l) + WO_W2), DE, S, E); }
        } SEAM(sb + 10);
    }
    if (IN(NSTEPS - 1)) { Ctx c = mkctx(lds, a, wv); phase_fin(a, c); }
#undef IN
#undef SEAM
}

extern "C" void kernel_launch(void* const* d_in, const int* in_sizes, int n_in, void* d_out, int out_size, void* d_ws, size_t ws_size, hipStream_t stream) {
    static int grid = 0;
    if (grid == 0) {
        if (n_in != 30 || out_size != TL * D || ws_size < WS_END) { fprintf(stderr, "kernel_launch: unexpected shapes (n_in %d out %d ws %zu)\n", n_in, out_size, ws_size); grid = -1; return; }
        int dev = 0, cus = 0, per_cu = 0;
        if (hipGetDevice(&dev) != hipSuccess || hipDeviceGetAttribute(&cus, hipDeviceAttributeMultiprocessorCount, dev) != hipSuccess) { grid = -1; return; }
        if (hipFuncSetAttribute((const void*)mk_fwd, hipFuncAttributeMaxDynamicSharedMemorySize, LDS_BYTES) != hipSuccess) { fprintf(stderr, "kernel_launch: hipFuncSetAttribute failed\n"); grid = -1; return; }
        if (hipOccupancyMaxActiveBlocksPerMultiprocessor(&per_cu, (const void*)mk_fwd, NTHREADS, LDS_BYTES) != hipSuccess || per_cu < 1) { fprintf(stderr, "kernel_launch: occupancy query says %d\n", per_cu); per_cu = 1; }
        (void)hipGetLastError();
        grid = cus;
    }
    if (grid < 0) return;
    (void)hipMemsetAsync((char*)d_ws + WS_CTL, 0, CTL_ZERO_BYTES, stream);
#if (MK_DIAG_ZERO & 2)
    (void)hipMemsetAsync((char*)d_ws, 0, WS_END, stream);
#endif
#if (MK_DIAG_ZERO & 4)
    (void)hipMemsetAsync((char*)d_out, 0, (size_t)TL * D * 4, stream);
#endif
    KArgs a{};
    for (int i = 0; i < 30; ++i) a.in[i] = (const float*)d_in[i];
    a.out = (float*)d_out; a.ws = (unsigned char*)d_ws;
#if MK_MULTI
    for (int s = 0; s < NSTEPS; ++s) { a.lo = s; a.hi = s + 1; hipLaunchKernelGGL(mk_fwd, dim3(grid), dim3(NTHREADS), LDS_BYTES, stream, a); }
#else
    a.lo = 0; a.hi = NSTEPS; hipLaunchKernelGGL(mk_fwd, dim3(grid), dim3(NTHREADS), LDS_BYTES, stream, a);
#endif
}
```
